# Optimizing an MI355X kernel written in HIP

```python
import math
import numpy as np
import jax
import jax.numpy as jnp
from jax import lax

D_MODEL = 1024
BATCH = 32
SEQ = 2048
DEPTH = 2

HEAD_DIM = 64
Q_BLOCK = 128
SB_HEADS = 8
SB_WIDTH = SB_HEADS * HEAD_DIM
NSA_HEADS = 8
NSA_KV_GROUPS = 2
NSA_REP = NSA_HEADS // NSA_KV_GROUPS
NSA_WIDTH = NSA_HEADS * HEAD_DIM
NSA_KV_WIDTH = NSA_KV_GROUPS * HEAD_DIM
NSA_N_BRANCH = 3
CMP_LEN = 32
CMP_STRIDE = 16
CMP_HIDDEN = 256
SLC_LEN = 64
SLC_TOPN = 8
SLC_LOCAL = 2
SLC_FORCE_BONUS = 1e4
WINDOW = 512
ROPE_THETA = 500000.0
ROPE_DIM = HEAD_DIM // 4
SSM_GROUP = 16
SSM_GROUPS = D_MODEL // SSM_GROUP
SSM_STATE = 64
DT_MIN = 1e-3
DT_MAX = 1e-1
N_EXPERTS = 64
N_EXPERT_GROUPS = 8
TOPK_GROUPS = 4
TOP_K = 6
EXPERT_HIDDEN = 256
SHARED_HIDDEN = 256
ROUTED_SCALE = 2.5
MOE_BLOCK = 128
DN_ALPHA = (2 * DEPTH) ** 0.25
DN_BETA = (8 * DEPTH) ** -0.25
LN_EPS = 1e-5
NEG_INF = -1e30

kernel_name = "hybrid_sb_nsa_s5_moe_deepnorm"


def _mix0_layout():
    sizes = [SB_WIDTH] * 3 + [NSA_WIDTH] + [NSA_KV_WIDTH] * 6 + [NSA_HEADS * NSA_N_BRANCH]
    value_cols = (2, 5, 7, 9)
    scales = [DN_BETA if i in value_cols else 1.0 for i in range(len(sizes))]
    return sizes, scales


def layer_norm(x, g, b):
    xf = x.astype(jnp.float32)
    mu = jnp.mean(xf, axis=-1, keepdims=True)
    var = jnp.mean(jnp.square(xf - mu), axis=-1, keepdims=True)
    y = (xf - mu) * lax.rsqrt(var + LN_EPS)
    return (y * g.astype(jnp.float32) + b.astype(jnp.float32)).astype(x.dtype)


def masked_softmax(s, mask):
    s = jnp.where(mask, s.astype(jnp.float32), NEG_INF)
    p = jax.nn.softmax(s, axis=-1)
    return jnp.where(mask, p, 0.0)


def rope_tables(S):
    inv = jnp.power(ROPE_THETA, -jnp.arange(0, ROPE_DIM, 2, dtype=jnp.float32) / ROPE_DIM)
    ang = jnp.arange(S, dtype=jnp.float32)[:, None] * inv[None, :]
    return jnp.cos(ang), jnp.sin(ang)


def rope_partial(x, cos, sin):
    half = ROPE_DIM // 2
    c = cos.astype(x.dtype)
    s = sin.astype(x.dtype)
    x1 = x[..., :half]
    x2 = x[..., half:ROPE_DIM]
    return jnp.concatenate([x1 * c - x2 * s, x2 * c + x1 * s, x[..., ROPE_DIM:]], axis=-1)


def hybrid_attention_mixer(x, w_in, cmp_pos_k, cmp_pos_v, cmp_k_w1, cmp_k_w2,
                           cmp_v_w1, cmp_v_w2, w_out):
    B, S, _ = x.shape
    dt = x.dtype
    G, R, d = NSA_KV_GROUPS, NSA_REP, HEAD_DIM
    nq = S // Q_BLOCK
    scale = HEAD_DIM ** -0.5
    sizes, _ = _mix0_layout()
    splits = np.cumsum(sizes)[:-1].tolist()
    proj = x @ w_in
    (q_a, k_a, v_a, q_b, kc, vc, ks, vs, kw, vw, g_raw) = jnp.split(proj, splits, axis=-1)

    def heads(t, n):
        return t.reshape(B, S, n, d).transpose(0, 2, 1, 3)

    q_a, k_a, v_a = heads(q_a, SB_HEADS), heads(k_a, SB_HEADS), heads(v_a, SB_HEADS)
    qa_blocks = q_a.reshape(B, SB_HEADS, nq, Q_BLOCK, d).transpose(2, 0, 1, 3, 4)
    key_idx = jnp.arange(S)

    def sb_block(args):
        q_blk, i = args
        t = i * Q_BLOCK + jnp.arange(Q_BLOCK)
        z = jnp.einsum('bhqd,bhkd->bhqk', q_blk, k_a).astype(jnp.float32) * scale
        causal = key_idx[None, :] < t[:, None]
        log_1m = jnp.where(causal, -jax.nn.softplus(z), 0.0)
        suffix = lax.cumsum(log_1m, axis=z.ndim - 1, reverse=True) - log_1m
        w = jnp.where(causal, jnp.exp(jax.nn.log_sigmoid(z) + suffix), 0.0)
        return jnp.einsum('bhqk,bhkd->bhqd', w.astype(dt), v_a)

    o_a = lax.map(sb_block, (qa_blocks, jnp.arange(nq)))
    o_a = o_a.transpose(1, 0, 3, 2, 4).reshape(B, S, SB_WIDTH)

    cos, sin = rope_tables(S)
    qn = rope_partial(heads(q_b, NSA_HEADS), cos, sin).reshape(B, G, R, S, d)
    qn_blocks = qn.reshape(B, G, R, nq, Q_BLOCK, d).transpose(3, 0, 1, 2, 4, 5)
    gates = jax.nn.sigmoid(g_raw).reshape(B, S, NSA_HEADS, NSA_N_BRANCH).transpose(0, 2, 1, 3)
    gate_blocks = gates.reshape(B, G, R, nq, Q_BLOCK, NSA_N_BRANCH).transpose(3, 0, 1, 2, 4, 5)

    n_cmp = (S - CMP_LEN) // CMP_STRIDE + 1
    n_slc = S // SLC_LEN
    cmp_start = np.arange(n_cmp) * CMP_STRIDE
    cmp_stop = cmp_start + CMP_LEN - 1
    slc_start = np.arange(n_slc) * SLC_LEN
    slc_stop = slc_start + SLC_LEN - 1
    cmp_idx = cmp_start[:, None] + np.arange(CMP_LEN)[None, :]
    overlap = jnp.asarray(((cmp_start[:, None] <= slc_stop[None, :]) &
                           (cmp_stop[:, None] >= slc_start[None, :])).astype(np.float32))
    cmp_end = jnp.asarray(cmp_stop)
    kc_tok = rope_partial(heads(kc, G), cos, sin)
    vc_tok = heads(vc, G)
    kc_blk = (kc_tok[:, :, cmp_idx] + cmp_pos_k).reshape(B, G, n_cmp, CMP_LEN * d)
    vc_blk = (vc_tok[:, :, cmp_idx] + cmp_pos_v).reshape(B, G, n_cmp, CMP_LEN * d)
    k_cmp = jax.nn.gelu(kc_blk @ cmp_k_w1) @ cmp_k_w2
    v_cmp = jax.nn.gelu(vc_blk @ cmp_v_w1) @ cmp_v_w2

    k_slc = rope_partial(heads(ks, G), cos, sin).reshape(B, G, n_slc, SLC_LEN, d)
    v_slc = heads(vs, G).reshape(B, G, n_slc, SLC_LEN, d)
    n_top = min(SLC_TOPN, n_slc)
    blk_ids = jnp.arange(n_slc)
    bi = jnp.arange(B)[:, None, None, None]
    gi = jnp.arange(G)[None, :, None, None]

    pad = ((0, 0), (0, 0), (WINDOW, 0), (0, 0))
    k_win_pad = jnp.pad(rope_partial(heads(kw, G), cos, sin), pad)
    v_win_pad = jnp.pad(heads(vw, G), pad)

    def nsa_block(args):
        q_blk, g_blk, i = args
        t = i * Q_BLOCK + jnp.arange(Q_BLOCK)
        s_c = jnp.einsum('bgrqd,bgnd->bgrqn', q_blk, k_cmp) * scale
        p_c = masked_softmax(s_c, cmp_end[None, :] <= t[:, None])
        o_c = jnp.einsum('bgrqn,bgnd->bgrqd', p_c.astype(dt), v_cmp)
        imp = jnp.einsum('bgrqn,nm->bgqm', p_c, overlap)
        cur = t // SLC_LEN
        valid = blk_ids[None, :] <= cur[:, None]
        forced = (blk_ids[None, :] == 0) | (valid & (blk_ids[None, :] > cur[:, None] - SLC_LOCAL))
        imp = jnp.where(forced, imp + SLC_FORCE_BONUS, jnp.where(valid, imp, NEG_INF))
        _, sel = lax.top_k(imp, n_top)
        k_sel = k_slc[bi, gi, sel]
        v_sel = v_slc[bi, gi, sel]
        s_s = jnp.einsum('bgrqd,bgqnld->bgrqnl', q_blk, k_sel) * scale
        key_pos = sel[..., None] * SLC_LEN + jnp.arange(SLC_LEN)
        m_s = (key_pos <= t[None, None, :, None, None]).reshape(B, G, 1, Q_BLOCK, n_top * SLC_LEN)
        p_s = masked_softmax(s_s.reshape(B, G, R, Q_BLOCK, n_top * SLC_LEN), m_s)
        p_s = p_s.reshape(B, G, R, Q_BLOCK, n_top, SLC_LEN).astype(dt)
        o_s = jnp.einsum('bgrqnl,bgqnld->bgrqd', p_s, v_sel)
        k_w = lax.dynamic_slice_in_dim(k_win_pad, i * Q_BLOCK, Q_BLOCK + WINDOW, axis=2)
        v_w = lax.dynamic_slice_in_dim(v_win_pad, i * Q_BLOCK, Q_BLOCK + WINDOW, axis=2)
        kp = i * Q_BLOCK - WINDOW + jnp.arange(Q_BLOCK + WINDOW)
        m_w = (kp[None, :] <= t[:, None]) & (kp[None, :] > t[:, None] - WINDOW) & (kp[None, :] >= 0)
        s_w = jnp.einsum('bgrqd,bgkd->bgrqk', q_blk, k_w) * scale
        p_w = masked_softmax(s_w, m_w)
        o_w = jnp.einsum('bgrqk,bgkd->bgrqd', p_w.astype(dt), v_w)
        return g_blk[..., 0:1] * o_c + g_blk[..., 1:2] * o_s + g_blk[..., 2:3] * o_w

    o_b = lax.map(nsa_block, (qn_blocks, gate_blocks, jnp.arange(nq)))
    o_b = o_b.transpose(1, 0, 4, 2, 3, 5).reshape(B, S, NSA_WIDTH)

    return jnp.concatenate([o_a, o_b], axis=-1) @ w_out


def s5_mixer(x, w_in, lambda_re, lambda_im, b_re, b_im, c_re, c_im, d_skip, log_dt,
             w_glu, w_out):
    B, S, _ = x.shape
    f32 = jnp.float32
    u = (x @ w_in).astype(f32).reshape(B, S, SSM_GROUPS, SSM_GROUP)
    lre = lambda_re.astype(f32)
    lim = lambda_im.astype(f32)
    step = jnp.exp(log_dt.astype(f32))[:, None]
    mag = jnp.exp(lre * step)
    abar_re = mag * jnp.cos(lim * step)
    abar_im = mag * jnp.sin(lim * step)
    den = lre * lre + lim * lim
    zoh_re = ((abar_re - 1.0) * lre + abar_im * lim) / den
    zoh_im = (abar_im * lre - (abar_re - 1.0) * lim) / den
    bre, bim = b_re.astype(f32), b_im.astype(f32)
    bbar_re = zoh_re[..., None] * bre - zoh_im[..., None] * bim
    bbar_im = zoh_re[..., None] * bim + zoh_im[..., None] * bre
    cre, cim = c_re.astype(f32), c_im.astype(f32)
    dsk = d_skip.astype(f32)

    def combine(e1, e2):
        a1r, a1i, b1r, b1i = e1
        a2r, a2i, b2r, b2i = e2
        return (a2r * a1r - a2i * a1i, a2r * a1i + a2i * a1r,
                a2r * b1r - a2i * b1i + b2r, a2r * b1i + a2i * b1r + b2i)

    def scan_one(u_b):
        bu_re = jnp.einsum('sgh,gph->sgp', u_b, bbar_re)
        bu_im = jnp.einsum('sgh,gph->sgp', u_b, bbar_im)
        a_re = jnp.broadcast_to(abar_re, bu_re.shape)
        a_im = jnp.broadcast_to(abar_im, bu_im.shape)
        _, _, h_re, h_im = lax.associative_scan(combine, (a_re, a_im, bu_re, bu_im), axis=0)
        return (jnp.einsum('ghp,sgp->sgh', cre, h_re) - jnp.einsum('ghp,sgp->sgh', cim, h_im)
                + dsk * u_b)

    y = lax.map(scan_one, u).reshape(B, S, D_MODEL)
    y = jax.nn.gelu(y).astype(x.dtype)
    y = y * jax.nn.sigmoid(y @ w_glu)
    return y @ w_out


def moe_ffn(x, router, router_bias, w_gate, w_up, w_down, sh_gate, sh_up, sh_down):
    B, S, D = x.shape
    T = B * S
    xf = x.reshape(T, D)
    scores = jax.nn.sigmoid((xf @ router).astype(jnp.float32))
    biased = scores + router_bias.astype(jnp.float32)
    per_grp = N_EXPERTS // N_EXPERT_GROUPS
    grp_score = lax.top_k(biased.reshape(T, N_EXPERT_GROUPS, per_grp), 2)[0].sum(-1)
    _, top_grp = lax.top_k(grp_score, TOPK_GROUPS)
    grp_keep = jnp.any(top_grp[:, :, None] == jnp.arange(N_EXPERT_GROUPS)[None, None, :], axis=1)
    expert_keep = jnp.repeat(grp_keep, per_grp, axis=1)
    _, eidx = lax.top_k(jnp.where(expert_keep, biased, -jnp.inf), TOP_K)
    gate = jnp.take_along_axis(scores, eidx, axis=1)
    gate = gate / jnp.sum(gate, axis=-1, keepdims=True) * ROUTED_SCALE

    n_assign = T * TOP_K
    flat_e = eidx.reshape(-1)
    flat_tok = jnp.repeat(jnp.arange(T, dtype=jnp.int32), TOP_K)
    flat_g = gate.reshape(-1)
    order = jnp.argsort(flat_e)
    se, stok, sg = flat_e[order], flat_tok[order], flat_g[order]
    counts = jnp.bincount(flat_e, length=N_EXPERTS)
    padded = (counts + MOE_BLOCK - 1) // MOE_BLOCK * MOE_BLOCK
    pad_end = jnp.cumsum(padded)
    pad_start = pad_end - padded
    start = jnp.cumsum(counts) - counts
    dest = pad_start[se] + jnp.arange(n_assign) - start[se]
    n_blocks = n_assign // MOE_BLOCK + N_EXPERTS
    n_rows = n_blocks * MOE_BLOCK
    buf_tok = jnp.zeros((n_rows,), jnp.int32).at[dest].set(stok)
    buf_g = jnp.zeros((n_rows,), jnp.float32).at[dest].set(sg)
    blk_e = jnp.minimum(jnp.searchsorted(pad_end, jnp.arange(n_blocks) * MOE_BLOCK, side='right'),
                        N_EXPERTS - 1)

    def expert_block(args):
        tok, g, e = args
        h = xf[tok]
        a = jax.nn.silu(h @ w_gate[e]) * (h @ w_up[e])
        return (a @ w_down[e]) * g[:, None].astype(x.dtype)

    y_blk = lax.map(expert_block, (buf_tok.reshape(n_blocks, MOE_BLOCK),
                                   buf_g.reshape(n_blocks, MOE_BLOCK), blk_e))
    routed = jnp.zeros_like(xf).at[buf_tok].add(y_blk.reshape(n_rows, D))
    shared = (jax.nn.silu(xf @ sh_gate) * (xf @ sh_up)) @ sh_down
    return (routed + shared).reshape(B, S, D)


def setup_inputs(seed: int = 0) -> dict:
    key = jax.random.key(seed)
    keys = iter(jax.random.split(key, 64))

    def nrm(shape, scale):
        return jax.random.normal(next(keys), shape, jnp.float32) * scale

    def add_ln(p, name):
        p[name + "_g"] = 1.0 + nrm((D_MODEL,), 0.01)
        p[name + "_b"] = nrm((D_MODEL,), 0.01)

    def add_moe(p, pre):
        p[pre + "_router"] = nrm((D_MODEL, N_EXPERTS), D_MODEL ** -0.5)
        p[pre + "_router_bias"] = nrm((N_EXPERTS,), 0.01)
        p[pre + "_w_gate"] = nrm((N_EXPERTS, D_MODEL, EXPERT_HIDDEN), D_MODEL ** -0.5)
        p[pre + "_w_up"] = nrm((N_EXPERTS, D_MODEL, EXPERT_HIDDEN), D_MODEL ** -0.5)
        p[pre + "_w_down"] = nrm((N_EXPERTS, EXPERT_HIDDEN, D_MODEL), EXPERT_HIDDEN ** -0.5 * DN_BETA)
        p[pre + "_sh_gate"] = nrm((D_MODEL, SHARED_HIDDEN), D_MODEL ** -0.5)
        p[pre + "_sh_up"] = nrm((D_MODEL, SHARED_HIDDEN), D_MODEL ** -0.5)
        p[pre + "_sh_down"] = nrm((SHARED_HIDDEN, D_MODEL), SHARED_HIDDEN ** -0.5 * DN_BETA)

    p = {}
    p["x"] = nrm((BATCH, SEQ, D_MODEL), 1.0)
    sizes, scales = _mix0_layout()
    col_scale = jnp.concatenate([jnp.full((n,), s, jnp.float32) for n, s in zip(sizes, scales)])
    p["l0_w_in"] = nrm((D_MODEL, sum(sizes)), D_MODEL ** -0.5) * col_scale
    p["l0_cmp_pos_k"] = nrm((CMP_LEN, HEAD_DIM), 0.1)
    p["l0_cmp_pos_v"] = nrm((CMP_LEN, HEAD_DIM), 0.1)
    p["l0_cmp_k_w1"] = nrm((CMP_LEN * HEAD_DIM, CMP_HIDDEN), (CMP_LEN * HEAD_DIM) ** -0.5)
    p["l0_cmp_k_w2"] = nrm((CMP_HIDDEN, HEAD_DIM), CMP_HIDDEN ** -0.5)
    p["l0_cmp_v_w1"] = nrm((CMP_LEN * HEAD_DIM, CMP_HIDDEN), (CMP_LEN * HEAD_DIM) ** -0.5)
    p["l0_cmp_v_w2"] = nrm((CMP_HIDDEN, HEAD_DIM), CMP_HIDDEN ** -0.5)
    p["l0_w_out"] = nrm((SB_WIDTH + NSA_WIDTH, D_MODEL), (SB_WIDTH + NSA_WIDTH) ** -0.5 * DN_BETA)
    add_ln(p, "l0_ln1")
    add_moe(p, "l0")
    add_ln(p, "l0_ln2")
    p["l1_w_in"] = nrm((D_MODEL, D_MODEL), D_MODEL ** -0.5)
    p["l1_lambda_re"] = -0.5 + nrm((SSM_GROUPS, SSM_STATE), 0.02)
    p["l1_lambda_im"] = math.pi * jnp.arange(SSM_STATE, dtype=jnp.float32)[None, :] + nrm((SSM_GROUPS, SSM_STATE), 0.02)
    p["l1_b_re"] = nrm((SSM_GROUPS, SSM_STATE, SSM_GROUP), (2 * SSM_GROUP) ** -0.5)
    p["l1_b_im"] = nrm((SSM_GROUPS, SSM_STATE, SSM_GROUP), (2 * SSM_GROUP) ** -0.5)
    p["l1_c_re"] = nrm((SSM_GROUPS, SSM_GROUP, SSM_STATE), (2 * SSM_STATE) ** -0.5)
    p["l1_c_im"] = nrm((SSM_GROUPS, SSM_GROUP, SSM_STATE), (2 * SSM_STATE) ** -0.5)
    p["l1_d"] = nrm((SSM_GROUPS, SSM_GROUP), 1.0)
    p["l1_log_dt"] = jax.random.uniform(next(keys), (SSM_GROUPS,), jnp.float32,
                                        math.log(DT_MIN), math.log(DT_MAX))
    p["l1_w_glu"] = nrm((D_MODEL, D_MODEL), D_MODEL ** -0.5)
    p["l1_w_out"] = nrm((D_MODEL, D_MODEL), D_MODEL ** -0.5 * DN_BETA)
    add_ln(p, "l1_ln1")
    add_moe(p, "l1")
    add_ln(p, "l1_ln2")
    return p


def reference(x, l0_w_in, l0_cmp_pos_k, l0_cmp_pos_v, l0_cmp_k_w1, l0_cmp_k_w2, l0_cmp_v_w1,
              l0_cmp_v_w2, l0_w_out, l0_ln1_g, l0_ln1_b, l0_router, l0_router_bias, l0_w_gate,
              l0_w_up, l0_w_down, l0_sh_gate, l0_sh_up, l0_sh_down, l0_ln2_g, l0_ln2_b,
              l1_w_in, l1_lambda_re, l1_lambda_im, l1_b_re, l1_b_im, l1_c_re, l1_c_im, l1_d,
              l1_log_dt, l1_w_glu, l1_w_out, l1_ln1_g, l1_ln1_b, l1_router, l1_router_bias,
              l1_w_gate, l1_w_up, l1_w_down, l1_sh_gate, l1_sh_up, l1_sh_down, l1_ln2_g,
              l1_ln2_b):
    mixer_params = [
        (l0_w_in, l0_cmp_pos_k, l0_cmp_pos_v, l0_cmp_k_w1, l0_cmp_k_w2, l0_cmp_v_w1,
         l0_cmp_v_w2, l0_w_out),
        (l1_w_in, l1_lambda_re, l1_lambda_im, l1_b_re, l1_b_im, l1_c_re, l1_c_im, l1_d,
         l1_log_dt, l1_w_glu, l1_w_out),
    ]
    norm1 = [(l0_ln1_g, l0_ln1_b), (l1_ln1_g, l1_ln1_b)]
    moe_params = [
        (l0_router, l0_router_bias, l0_w_gate, l0_w_up, l0_w_down, l0_sh_gate, l0_sh_up, l0_sh_down),
        (l1_router, l1_router_bias, l1_w_gate, l1_w_up, l1_w_down, l1_sh_gate, l1_sh_up, l1_sh_down),
    ]
    norm2 = [(l0_ln2_g, l0_ln2_b), (l1_ln2_g, l1_ln2_b)]
    h = x
    for layer in range(DEPTH):
        if layer % 2 == 0:
            mixed = hybrid_attention_mixer(h, *mixer_params[layer])
        else:
            mixed = s5_mixer(h, *mixer_params[layer])
        h = layer_norm(DN_ALPHA * h + mixed, *norm1[layer])
        h = layer_norm(DN_ALPHA * h + moe_ffn(h, *moe_params[layer]), *norm2[layer])
    return h
```

```cpp
#ifndef HOST_EMU
#include <hip/hip_runtime.h>
#endif
#include <stdint.h>
#include <stddef.h>
#include <math.h>
#include <string.h>

#ifndef CFG_B
#define CFG_B 32
#define CFG_S 2048
#define CFG_D 1024
#endif

#ifdef HOST_EMU
#include <stdio.h>
#include <stdlib.h>
#define __global__
#define __device__
#define __host__
#define __forceinline__ inline
struct EmuDim { int x; };
static EmuDim e_blockIdx, e_gridDim, e_blockDim;
#define BIDX (e_blockIdx.x)
#define GDIM (e_gridDim.x)
#define NTHR (e_blockDim.x)
#define PAR_BEGIN for (int tid = 0; tid < NTHR; ++tid) {
#define PAR_END }
template <class T> static inline T emu_atomic_add(T* p, T v) { T o = *p; *p = o + v; return o; }
#define ATOMIC_ADD(p, v) emu_atomic_add((p), (v))
typedef int hipStream_t;
static unsigned char g_emu_lds[163840];
#define LDS_DECL unsigned char* lds = g_emu_lds
#else
#define BIDX ((int)blockIdx.x)
#define GDIM ((int)gridDim.x)
#define NTHR ((int)blockDim.x)
#define PAR_BEGIN { const int tid = (int)threadIdx.x;
#define PAR_END } __syncthreads();
#define ATOMIC_ADD(p, v) atomicAdd((p), (v))
#define LDS_DECL extern __shared__ __attribute__((aligned(16))) unsigned char lds[]
#endif

typedef unsigned short bf16;

constexpr int NB = CFG_B, S = CFG_S, DM = CFG_D, T = NB * S;
constexpr int NCH = 2, TC = T / NCH;
constexpr int MOE_ROWS = ((TC * 6 + 64 * 255 + 255) / 256) * 256, MOE_TILES = MOE_ROWS / 256;
constexpr int NG = DM / 16;
constexpr int NCP = S / 16, NCMP = NCP - 1, NSLC = S / 64;
constexpr int PROJ_N = 2840, PROJ_NP = 2944;
constexpr int GU_IL = 32;
constexpr float DN_ALPHA = 1.4142135623730951f;
constexpr float LN_EPS = 1e-5f;

constexpr size_t al256(size_t x) { return (x + 255) & ~(size_t)255; }
constexpr size_t O_CTL = 0, CTL_BYTES = 65536;
constexpr size_t O_PADSTART = O_CTL + CTL_BYTES;
constexpr size_t O_TILEE = O_PADSTART + 512;
constexpr size_t O_BIASK = al256(O_TILEE + (size_t)MOE_TILES * 4);
constexpr size_t O_BIASV = O_BIASK + 1024;
constexpr size_t O_ABAR = O_BIASV + 1024;
constexpr size_t O_BBAR = al256(O_ABAR + (size_t)NG * 64 * 2 * 4);
constexpr size_t O_WT_IN0 = al256(O_BBAR + (size_t)NG * 64 * 16 * 2 * 4);
constexpr size_t O_WT_K1 = al256(O_WT_IN0 + (size_t)PROJ_NP * DM * 2);
constexpr size_t O_WT_V1 = O_WT_K1 + (size_t)256 * 2048 * 2;
constexpr size_t O_WT_OUT0 = O_WT_V1 + (size_t)256 * 2048 * 2;
constexpr size_t O_WT_R = al256(O_WT_OUT0 + (size_t)DM * 1024 * 2);
constexpr size_t O_WT_SGU = al256(O_WT_R + (size_t)2 * 128 * DM * 2);
constexpr size_t O_WT_SD = al256(O_WT_SGU + (size_t)2 * 512 * DM * 2);
constexpr size_t O_WT_GU = al256(O_WT_SD + (size_t)2 * DM * 256 * 2);
constexpr size_t O_WT_D = al256(O_WT_GU + (size_t)64 * 512 * DM * 2);
constexpr size_t O_WT_IN1 = al256(O_WT_D + (size_t)64 * DM * 256 * 2);
constexpr size_t O_WT_GLU = O_WT_IN1 + (size_t)DM * DM * 2;
constexpr size_t O_WT_OUT1 = O_WT_GLU + (size_t)DM * DM * 2;
constexpr size_t O_H = al256(O_WT_OUT1 + (size_t)DM * DM * 2);
constexpr size_t O_H2 = al256(O_H + (size_t)T * DM * 2);
constexpr size_t O_SCR = al256(O_H2 + (size_t)T * DM * 2);
constexpr size_t HB = (size_t)NB * 8 * S * 64 * 2, GB = (size_t)NB * 2 * S * 64 * 2;
constexpr size_t A_QA = O_SCR, A_KA = A_QA + HB, A_VA = A_KA + HB, A_QB = A_VA + HB;
constexpr size_t A_KC = A_QB + HB, A_VC = A_KC + GB, A_KS = A_VC + GB, A_VS = A_KS + GB, A_KW = A_VS + GB, A_VW = A_KW + GB;
constexpr size_t A_GRAW = A_VW + GB;
constexpr size_t A_HCK = al256(A_GRAW + (size_t)T * 24 * 4);
constexpr size_t A_HCV = A_HCK + (size_t)NB * 2 * NCP * 256 * 2;
constexpr size_t A_KCMP = A_HCV + (size_t)NB * 2 * NCP * 256 * 2;
constexpr size_t A_VCMP = A_KCMP + (size_t)NB * 2 * NCP * 64 * 4;
constexpr size_t A_ATT = al256(A_VCMP + (size_t)NB * 2 * NCP * 64 * 4);
constexpr size_t A_END = A_ATT + (size_t)T * 1024 * 2;
constexpr size_t B_LOGIT = O_SCR;
constexpr size_t B_EIDX = B_LOGIT + (size_t)T * 64 * 4;
constexpr size_t B_GATE = al256(B_EIDX + (size_t)T * 6 * 4);
constexpr size_t B_POS = al256(B_GATE + (size_t)T * 6 * 4);
constexpr size_t B_ROWTOK = al256(B_POS + (size_t)T * 6 * 4);
constexpr size_t B_ROWGATE = al256(B_ROWTOK + (size_t)MOE_ROWS * 4);
constexpr size_t B_ASH = al256(B_ROWGATE + (size_t)MOE_ROWS * 4);
constexpr size_t B_AEX = al256(B_ASH + (size_t)T * 256 * 2);
constexpr size_t B_Y = al256(B_AEX + (size_t)MOE_ROWS * 256 * 2);
constexpr size_t B_END = B_Y + (size_t)MOE_ROWS * DM * 2;
constexpr size_t C_U = O_SCR, C_YS = C_U + (size_t)T * DM * 2, C_Y2 = C_YS + (size_t)T * DM * 2, C_END = C_Y2 + (size_t)T * DM * 2;
constexpr size_t WS_NEED = (A_END > B_END ? (A_END > C_END ? A_END : C_END) : (B_END > C_END ? B_END : C_END)) + 4096;

__host__ __device__ __forceinline__ float bf2f(bf16 v) { unsigned u = ((unsigned)v) << 16; float f; memcpy(&f, &u, 4); return f; }
__host__ __device__ __forceinline__ bf16 f2bf(float f) { unsigned u; memcpy(&u, &f, 4); u = (u + 0x7fffu + ((u >> 16) & 1u)) >> 16; return (bf16)u; }
__host__ __device__ __forceinline__ float sigmoidf_(float x) { return 1.0f / (1.0f + expf(-x)); }
__host__ __device__ __forceinline__ float gelu_tanh(float x) { return 0.5f * x * (1.0f + tanhf(0.7978845608028654f * (x + 0.044715f * x * x * x))); }
__host__ __device__ __forceinline__ float siluf_(float x) { return x * sigmoidf_(x); }

struct P {
    const float* in[44];
    float* out;
    unsigned char* ws;
    int layer, chunk, pad0, pad1;
};
#define WSP(T_, off) ((T_*)(p.ws + (off)))

enum { I_X = 0, I_L0_WIN, I_POSK, I_POSV, I_KW1, I_KW2, I_VW1, I_VW2, I_L0_WOUT, I_L0_LN1G, I_L0_LN1B,
       I_L0_ROUTER, I_L0_RBIAS, I_L0_WG, I_L0_WU, I_L0_WD, I_L0_SG, I_L0_SU, I_L0_SD, I_L0_LN2G, I_L0_LN2B,
       I_L1_WIN, I_LRE, I_LIM, I_BRE, I_BIM, I_CRE, I_CIM, I_DSK, I_LOGDT, I_WGLU, I_L1_WOUT, I_L1_LN1G, I_L1_LN1B,
       I_L1_ROUTER, I_L1_RBIAS, I_L1_WG, I_L1_WU, I_L1_WD, I_L1_SG, I_L1_SU, I_L1_SD, I_L1_LN2G, I_L1_LN2B };
constexpr int MOE_IN0[2] = { I_L0_ROUTER, I_L1_ROUTER };

struct XposeJob { const float* src; bf16* dst; int K, N, Ncover, il, il2, add, batch; long sstride, dstride; };
__device__ __forceinline__ void ph_xpose(const XposeJob j, unsigned char* lds) {
    float* tile = (float*)lds;
    const int tk = j.K / 64, tn = (j.Ncover + 63) / 64, per = tk * tn;
    for (int item = BIDX; item < per * j.batch; item += GDIM) {
        const int bt = item / per, it = item % per, k0 = (it / tn) * 64, n0 = (it % tn) * 64;
        const float* src = j.src + (long)bt * j.sstride; bf16* dst = j.dst + (long)bt * j.dstride;
        PAR_BEGIN
            for (int e = tid; e < 4096; e += NTHR) { const int kk = e >> 6, nn = e & 63; tile[kk * 65 + nn] = (n0 + nn < j.N) ? src[(long)(k0 + kk) * j.N + n0 + nn] : 0.f; }
        PAR_END
        PAR_BEGIN
            for (int e = tid; e < 4096; e += NTHR) { const int nn = e >> 6, kk = e & 63, n = n0 + nn;
                if (n < j.Ncover) { const long row = (long)(n / j.il) * j.il2 + (n % j.il) + j.add; dst[row * j.K + k0 + kk] = f2bf(tile[kk * 65 + nn]); } }
        PAR_END
    }
}

__device__ __forceinline__ void ph_cvt(const float* src, bf16* dst, long n) {
    PAR_BEGIN
        for (long i = (long)BIDX * NTHR + tid; i < n; i += (long)GDIM * NTHR) dst[i] = f2bf(src[i]);
    PAR_END
}

__device__ __forceinline__ void ph_tables(const P& p) {
    PAR_BEGIN
        const long gt = (long)BIDX * NTHR + tid, gs = (long)GDIM * NTHR;
        for (long i = gt; i < 512; i += gs) {
            const int which = (int)(i >> 8), c = (int)(i & 255);
            const float* pos = p.in[which ? I_POSV : I_POSK]; const float* w1 = p.in[which ? I_VW1 : I_KW1];
            float s = 0.f; for (int jx = 0; jx < 2048; ++jx) s += pos[jx] * w1[(long)jx * 256 + c];
            WSP(float, which ? O_BIASV : O_BIASK)[c] = s;
        }
        for (long i = gt; i < (long)NG * 64; i += gs) {
            const int g = (int)(i >> 6);
            const float lre = p.in[I_LRE][i], lim = p.in[I_LIM][i], step = expf(p.in[I_LOGDT][g]);
            const float mag = expf(lre * step), are = mag * cosf(lim * step), aim = mag * sinf(lim * step);
            const float den = lre * lre + lim * lim;
            const float zre = ((are - 1.0f) * lre + aim * lim) / den, zim = (aim * lre - (are - 1.0f) * lim) / den;
            WSP(float, O_ABAR)[i * 2] = are; WSP(float, O_ABAR)[i * 2 + 1] = aim;
            for (int h = 0; h < 16; ++h) { const float br = p.in[I_BRE][i * 16 + h], bi = p.in[I_BIM][i * 16 + h];
                WSP(float, O_BBAR)[(i * 16 + h) * 2] = zre * br - zim * bi; WSP(float, O_BBAR)[(i * 16 + h) * 2 + 1] = zre * bi + zim * br; }
        }
    PAR_END
}

__device__ __forceinline__ void ph_rope(const P& p) {
    PAR_BEGIN
        const long rows_q = (long)NB * 8 * S, rows_k = (long)NB * 2 * S, total = (rows_q + 3 * rows_k) * 8;
        for (long i = (long)BIDX * NTHR + tid; i < total; i += (long)GDIM * NTHR) {
            const int jx = (int)(i & 7); long row = i >> 3; bf16* base;
            if (row < rows_q) base = WSP(bf16, A_QB);
            else { row -= rows_q; const int w = (int)(row / rows_k); row -= (long)w * rows_k; base = WSP(bf16, w == 0 ? A_KC : (w == 1 ? A_KS : A_KW)); }
            const int s = (int)(row % S);
            const float inv = powf(500000.0f, -(float)jx / 8.0f), ang = (float)s * inv, c = cosf(ang), sn = sinf(ang);
            bf16* r = base + row * 64; const float x1 = bf2f(r[jx]), x2 = bf2f(r[jx + 8]);
            r[jx] = f2bf(x1 * c - x2 * sn); r[jx + 8] = f2bf(x2 * c + x1 * sn);
        }
    PAR_END
}

__device__ __forceinline__ void ph_cmpw2(const P& p) {
    PAR_BEGIN
        const long rows = (long)NB * 2 * NCP, total = rows * 64 * 2;
        for (long i = (long)BIDX * NTHR + tid; i < total; i += (long)GDIM * NTHR) {
            const int which = (int)(i / (rows * 64)); const long r = (i / 64) % rows; const int d = (int)(i & 63);
            const bf16* hc = WSP(bf16, which ? A_HCV : A_HCK) + r * 256; const float* w2 = p.in[which ? I_VW2 : I_KW2];
            float s = 0.f; for (int c = 0; c < 256; ++c) s += bf2f(hc[c]) * w2[c * 64 + d];
            WSP(float, which ? A_VCMP : A_KCMP)[r * 64 + d] = s;
        }
    PAR_END
}

__device__ __forceinline__ void ph_sb(const P& p) {
    PAR_BEGIN
        const bf16* QA = WSP(bf16, A_QA); const bf16* KA = WSP(bf16, A_KA); const bf16* VA = WSP(bf16, A_VA); bf16* ATT = WSP(bf16, A_ATT);
        for (long gq = (long)BIDX * NTHR + tid; gq < (long)NB * 8 * S; gq += (long)GDIM * NTHR) {
            const int t = (int)(gq % S); const long bh = gq / S; const int h = (int)(bh & 7); const long b = bh >> 3;
            float q[64], acc[64];
#pragma unroll
            for (int d = 0; d < 64; ++d) { q[d] = bf2f(QA[gq * 64 + d]) * 0.125f; acc[d] = 0.f; }
            float run = 0.f;
            for (int s = t - 1; s >= 0; --s) {
                const bf16* kr = KA + (bh * S + s) * 64; const bf16* vr = VA + (bh * S + s) * 64;
                float z = 0.f;
#pragma unroll
                for (int d = 0; d < 64; ++d) z += q[d] * bf2f(kr[d]);
                const float l1p = log1pf(expf(-fabsf(z)));
                const float sp_pos = fmaxf(z, 0.f) + l1p, sp_neg = fmaxf(-z, 0.f) + l1p;
                const float w = expf(run - sp_neg);
#pragma unroll
                for (int d = 0; d < 64; ++d) acc[d] += w * bf2f(vr[d]);
                run -= sp_pos;
                if (run < -120.f) break;
            }
            bf16* o = ATT + (b * S + t) * 1024 + h * 64;
#pragma unroll
            for (int d = 0; d < 64; ++d) o[d] = f2bf(acc[d]);
        }
    PAR_END
}

constexpr int NSA_LDS_PER = (4 * 64 + 4 * 512 + 4 * 64 + 64 + 64 + 32 + 16 + 16 + 16) * 4;
__device__ __forceinline__ void ph_nsa(const P& p, unsigned char* lds) {
    const int per = NTHR / 256; const long items = (long)NB * 2 * S;
    const bf16* QB = WSP(bf16, A_QB); bf16* ATT = WSP(bf16, A_ATT);
    const float* KCMP = WSP(float, A_KCMP); const float* VCMP = WSP(float, A_VCMP);
    for (long it0 = (long)BIDX * per; it0 < items; it0 += (long)GDIM * per) {
#define NSA_SETUP const int sub = tid >> 8, lt = tid & 255; const long item = it0 + sub; const bool act = item < items; \
        const int t = act ? (int)(item % S) : 0; const long bg = act ? item / S : 0; const int g = (int)(bg & 1); const long b = bg >> 1; \
        float* L = (float*)(lds + (size_t)sub * NSA_LDS_PER); float* qs = L; float* sc = qs + 256; float* osum = sc + 2048; float* pm = osum + 256; float* pl = pm + 64; \
        float* imp = pl + 64; int* sel = (int*)(imp + 32); float* st = (float*)(sel + 16); float* gts = st + 16; (void)lt; (void)g; (void)b; (void)t; (void)qs; (void)sc; (void)osum; (void)pm; (void)pl; (void)imp; (void)sel; (void)st; (void)gts;
#define NSA_SOFTMAX(NEXPR) \
        PAR_BEGIN NSA_SETUP if (act && lt < 64) { const int r = lt >> 4, part = lt & 15, n = (NEXPR); float m = -3e38f; \
            for (int jx = part; jx < n; jx += 16) m = fmaxf(m, sc[r * 512 + jx]); float l = 0.f; \
            for (int jx = part; jx < n; jx += 16) { const float v = sc[r * 512 + jx]; if (v > -1e29f) l += expf(v - m); } pm[lt] = m; pl[lt] = l; } PAR_END \
        PAR_BEGIN NSA_SETUP if (act && lt < 4) { float m = -3e38f; for (int q2 = 0; q2 < 16; ++q2) m = fmaxf(m, pm[lt * 16 + q2]); float l = 0.f; \
            for (int q2 = 0; q2 < 16; ++q2) { const float pmv = pm[lt * 16 + q2]; if (pmv > -1e29f) l += pl[lt * 16 + q2] * expf(pmv - m); } st[lt] = m; st[4 + lt] = l; } PAR_END \
        PAR_BEGIN NSA_SETUP if (act) { const int n = (NEXPR); for (int idx = lt; idx < 4 * n; idx += 256) { const int r = idx / n, jx = idx % n; const float v = sc[r * 512 + jx]; \
            const float l = st[4 + r]; sc[r * 512 + jx] = (v > -1e29f && l > 0.f) ? expf(v - st[r]) / l : 0.f; } } PAR_END
        PAR_BEGIN NSA_SETUP
            if (act) { const int r = lt >> 6, d = lt & 63; qs[lt] = bf2f(QB[((b * 8 + g * 4 + r) * S + t) * 64 + d]) * 0.125f; osum[lt] = 0.f;
                if (lt < 12) gts[lt] = sigmoidf_(WSP(float, A_GRAW)[(b * S + t) * 24 + g * 12 + lt]); }
        PAR_END
        PAR_BEGIN NSA_SETUP
            if (act) for (int idx = lt; idx < 4 * NCP; idx += 256) { const int r = idx / NCP, n = idx % NCP; float v = -1e30f;
                if (n < NCMP && 16 * n + 31 <= t) { const float* kr = KCMP + (bg * NCP + n) * 64; v = 0.f; for (int d = 0; d < 64; ++d) v += qs[r * 64 + d] * kr[d]; }
                sc[r * 512 + n] = v; }
        PAR_END
        NSA_SOFTMAX(NCP)
        PAR_BEGIN NSA_SETUP
            if (act) { const int r = lt >> 6, d = lt & 63; float o = 0.f; for (int n = 0; n < NCMP; ++n) o += sc[r * 512 + n] * VCMP[(bg * NCP + n) * 64 + d]; osum[lt] += gts[r * 3 + 0] * o; }
        PAR_END
        PAR_BEGIN NSA_SETUP
            if (act && lt < 32) { float s = 0.f; if (lt < NSLC) { const int n0 = 4 * lt - 1 < 0 ? 0 : 4 * lt - 1, n1 = 4 * lt + 3 > NCMP - 1 ? NCMP - 1 : 4 * lt + 3;
                for (int r = 0; r < 4; ++r) for (int n = n0; n <= n1; ++n) s += sc[r * 512 + n]; } imp[lt] = s; }
        PAR_END
        PAR_BEGIN NSA_SETUP
            if (act && lt == 0) { const int cur = t >> 6;
                for (int m = 0; m < NSLC; ++m) { const bool valid = m <= cur, forced = (m == 0) || (valid && m > cur - 2); imp[m] = forced ? imp[m] + 1e4f : (valid ? imp[m] : -1e30f); }
                int ns = 0;
                for (int i = 0; i < 8; ++i) { int best = 0; float bv = -3.4e38f; for (int m = 0; m < NSLC; ++m) if (imp[m] > bv) { bv = imp[m]; best = m; } imp[best] = -3.4e38f; if (best <= cur) sel[ns++] = best; }
                sel[8] = ns; }
        PAR_END
        PAR_BEGIN NSA_SETUP
            if (act) { const int n = sel[8] * 64; const bf16* KS = WSP(bf16, A_KS);
                for (int idx = lt; idx < 4 * n; idx += 256) { const int r = idx / n, jx = idx % n, pos = sel[jx >> 6] * 64 + (jx & 63); float v = -1e30f;
                    if (pos <= t) { const bf16* kr = KS + (bg * S + pos) * 64; v = 0.f; for (int d = 0; d < 64; ++d) v += qs[r * 64 + d] * bf2f(kr[d]); }
                    sc[r * 512 + jx] = v; } }
        PAR_END
        NSA_SOFTMAX(sel[8] * 64)
        PAR_BEGIN NSA_SETUP
            if (act) { const int r = lt >> 6, d = lt & 63, n = sel[8] * 64; const bf16* VS = WSP(bf16, A_VS); float o = 0.f;
                for (int jx = 0; jx < n; ++jx) { const int pos = sel[jx >> 6] * 64 + (jx & 63); o += sc[r * 512 + jx] * bf2f(VS[(bg * S + pos) * 64 + d]); }
                osum[lt] += gts[r * 3 + 1] * o; }
        PAR_END
        PAR_BEGIN NSA_SETUP
            if (act) { const bf16* KW = WSP(bf16, A_KW);
                for (int idx = lt; idx < 4 * 512; idx += 256) { const int r = idx >> 9, jx = idx & 511, pos = t - 511 + jx; float v = -1e30f;
                    if (pos >= 0) { const bf16* kr = KW + (bg * S + pos) * 64; v = 0.f; for (int d = 0; d < 64; ++d) v += qs[r * 64 + d] * bf2f(kr[d]); }
                    sc[r * 512 + jx] = v; } }
        PAR_END
        NSA_SOFTMAX(512)
        PAR_BEGIN NSA_SETUP
            if (act) { const int r = lt >> 6, d = lt & 63; const bf16* VW = WSP(bf16, A_VW); float o = 0.f;
                for (int jx = 0; jx < 512; ++jx) { const int pos = t - 511 + jx; if (pos >= 0) o += sc[r * 512 + jx] * bf2f(VW[(bg * S + pos) * 64 + d]); }
                osum[lt] += gts[r * 3 + 2] * o;
                ATT[(b * S + t) * 1024 + 512 + (g * 4 + r) * 64 + d] = f2bf(osum[lt]); }
        PAR_END
    }
}

constexpr int S5_LDS_PER = (8 * 128 + 8 * 16 + 128) * 4;
__device__ __forceinline__ void ph_s5(const P& p, unsigned char* lds) {
    const int per = NTHR / 64; const long items = (long)NB * NG;
    const bf16* U = WSP(bf16, C_U); bf16* YS = WSP(bf16, C_YS);
    const float* ABAR = WSP(float, O_ABAR); const float* BBAR = WSP(float, O_BBAR);
    for (long it0 = (long)BIDX * per; it0 < items; it0 += (long)GDIM * per) {
#define S5_SETUP const int sub = tid >> 6, lt = tid & 63; const long item = it0 + sub; const bool act = item < items; const int g = act ? (int)(item % NG) : 0; const long b = act ? item / NG : 0; \
        float* L = (float*)(lds + (size_t)sub * S5_LDS_PER); float* hbuf = L; float* ubuf = hbuf + 1024; float* hst = ubuf + 128; (void)lt; (void)g; (void)b; (void)hbuf; (void)ubuf; (void)hst;
        PAR_BEGIN S5_SETUP if (act) { hst[lt] = 0.f; hst[64 + lt] = 0.f; } PAR_END
        for (int t0 = 0; t0 < S; t0 += 8) {
            PAR_BEGIN S5_SETUP
                if (act) for (int e = lt; e < 128; e += 64) ubuf[e] = bf2f(U[(b * S + t0 + (e >> 4)) * DM + g * 16 + (e & 15)]);
            PAR_END
            PAR_BEGIN S5_SETUP
                if (act) { const long gp = (long)g * 64 + lt; const float are = ABAR[gp * 2], aim = ABAR[gp * 2 + 1]; float bre[16], bim[16];
#pragma unroll
                    for (int h = 0; h < 16; ++h) { bre[h] = BBAR[(gp * 16 + h) * 2]; bim[h] = BBAR[(gp * 16 + h) * 2 + 1]; }
                    float hr = hst[lt], hi = hst[64 + lt];
                    for (int i = 0; i < 8; ++i) { float ur = 0.f, ui = 0.f;
#pragma unroll
                        for (int h = 0; h < 16; ++h) { const float u = ubuf[i * 16 + h]; ur += u * bre[h]; ui += u * bim[h]; }
                        const float nr = are * hr - aim * hi + ur, ni = are * hi + aim * hr + ui; hr = nr; hi = ni;
                        hbuf[i * 128 + lt] = hr; hbuf[i * 128 + 64 + lt] = hi; }
                    hst[lt] = hr; hst[64 + lt] = hi; }
            PAR_END
            PAR_BEGIN S5_SETUP
                if (act) { const int hh = lt & 15, iq = lt >> 4; const float* cre = p.in[I_CRE] + ((long)g * 16 + hh) * 64; const float* cim = p.in[I_CIM] + ((long)g * 16 + hh) * 64;
                    const float dsk = p.in[I_DSK][g * 16 + hh];
                    for (int i = iq * 2; i < iq * 2 + 2; ++i) { float y = 0.f;
                        for (int pp = 0; pp < 64; ++pp) y += cre[pp] * hbuf[i * 128 + pp] - cim[pp] * hbuf[i * 128 + 64 + pp];
                        y += dsk * ubuf[i * 16 + hh];
                        YS[(b * S + t0 + i) * DM + g * 16 + hh] = f2bf(gelu_tanh(y)); } }
            PAR_END
        }
    }
}

__device__ __forceinline__ void ph_route(const P& p, unsigned char* lds) {
    const int NT_ = NTHR; float* rb = (float*)lds;
    int* hist = (int*)(rb + (size_t)NT_ * 72); int* base = hist + 64; int* lr = base + 64;
    const float* LOGIT = WSP(float, B_LOGIT); const float* rbias = p.in[MOE_IN0[p.layer] + 1];
    int* gcnt = WSP(int, O_CTL) + (p.layer * NCH + p.chunk) * 64;
    const long tbeg = (long)p.chunk * TC;
    for (long t0 = (long)BIDX * NT_; t0 < TC; t0 += (long)GDIM * NT_) {
        PAR_BEGIN if (tid < 64) hist[tid] = 0; PAR_END
        PAR_BEGIN
            const long tl = t0 + tid;
            if (tl < TC) { const long tok = tbeg + tl; float* sb = rb + (size_t)tid * 72; float* gs = sb + 64;
                for (int e = 0; e < 64; ++e) sb[e] = sigmoidf_(LOGIT[tok * 64 + e]) + rbias[e];
                for (int gq = 0; gq < 8; ++gq) { float m1 = -3e38f, m2 = -3e38f; for (int jx = 0; jx < 8; ++jx) { const float v = sb[gq * 8 + jx]; if (v > m1) { m2 = m1; m1 = v; } else if (v > m2) m2 = v; } gs[gq] = m1 + m2; }
                unsigned keep = 0u;
                for (int i = 0; i < 4; ++i) { int best = 0; float bv = -3.4e38f; for (int gq = 0; gq < 8; ++gq) if (!((keep >> gq) & 1u) && gs[gq] > bv) { bv = gs[gq]; best = gq; } keep |= 1u << best; }
                unsigned long long taken = 0ull; int ei[6]; float gv[6]; float gsum = 0.f;
#pragma unroll
                for (int i = 0; i < 6; ++i) { int best = 0; float bv = -3.4e38f;
                    for (int e = 0; e < 64; ++e) if (((keep >> (e >> 3)) & 1u) && !((taken >> e) & 1ull) && sb[e] > bv) { bv = sb[e]; best = e; }
                    taken |= 1ull << best; ei[i] = best; gv[i] = sb[best] - rbias[best]; gsum += gv[i]; }
#pragma unroll
                for (int i = 0; i < 6; ++i) { WSP(int, B_EIDX)[tok * 6 + i] = ei[i]; WSP(float, B_GATE)[tok * 6 + i] = gv[i] / gsum * 2.5f; lr[tid * 6 + i] = ATOMIC_ADD(&hist[ei[i]], 1); }
            }
        PAR_END
        PAR_BEGIN if (tid < 64) base[tid] = ATOMIC_ADD(&gcnt[tid], hist[tid]); PAR_END
        PAR_BEGIN
            const long tl = t0 + tid;
            if (tl < TC) { const long tok = tbeg + tl; for (int i = 0; i < 6; ++i) WSP(int, B_POS)[tok * 6 + i] = base[WSP(int, B_EIDX)[tok * 6 + i]] + lr[tid * 6 + i]; }
        PAR_END
    }
}

__device__ __forceinline__ void ph_offsets(const P& p) {
    if (BIDX != 0) return;
    const int* gcnt = WSP(int, O_CTL) + (p.layer * NCH + p.chunk) * 64; int* ps = WSP(int, O_PADSTART); int* te = WSP(int, O_TILEE);
    PAR_BEGIN if (tid == 0) { int acc = 0; for (int e = 0; e < 64; ++e) { ps[e] = acc; acc += (gcnt[e] + 255) / 256 * 256; } ps[64] = acc; } PAR_END
    PAR_BEGIN for (int i = tid; i < MOE_TILES; i += NTHR) { const int r = i * 256; int e = -1; if (r < ps[64]) { e = 0; while (ps[e + 1] <= r) ++e; } te[i] = e; } PAR_END
}
__device__ __forceinline__ void ph_clear_rows(const P& p) {
    PAR_BEGIN for (long i = (long)BIDX * NTHR + tid; i < MOE_ROWS; i += (long)GDIM * NTHR) { WSP(int, B_ROWTOK)[i] = 0; WSP(float, B_ROWGATE)[i] = 0.f; } PAR_END
}
__device__ __forceinline__ void ph_scatter(const P& p) {
    PAR_BEGIN
        const int* ps = WSP(int, O_PADSTART);
        for (long i = (long)BIDX * NTHR + tid; i < (long)TC * 6; i += (long)GDIM * NTHR) { const long gi = (long)p.chunk * TC * 6 + i;
            const int e = WSP(int, B_EIDX)[gi], dest = ps[e] + WSP(int, B_POS)[gi];
            WSP(int, B_ROWTOK)[dest] = (int)(gi / 6); WSP(float, B_ROWGATE)[dest] = WSP(float, B_GATE)[gi]; WSP(int, B_POS)[gi] = dest; }
    PAR_END
}

struct LnJob { const float* pre; const bf16* y; const int* pos; const float* g; const float* b; bf16* obf; float* of32; long t_beg, t_cnt; };
constexpr int LN_LDS_PER = (DM + 64) * 4;
__device__ __forceinline__ void ph_ln(const LnJob j, unsigned char* lds) {
    const int per = NTHR / 256;
    for (long r0 = (long)BIDX * per; r0 < j.t_cnt; r0 += (long)GDIM * per) {
#define LN_SETUP const int sub = tid >> 8, lt = tid & 255; const long rl = r0 + sub; const bool act = rl < j.t_cnt; const long tok = j.t_beg + (act ? rl : 0); \
        float* vals = (float*)(lds + (size_t)sub * LN_LDS_PER); float* red = vals + DM; (void)lt; (void)tok; (void)red;
        PAR_BEGIN LN_SETUP
            if (act) for (int c = lt; c < DM; c += 256) { float v = j.pre[tok * DM + c]; if (j.y) for (int k = 0; k < 6; ++k) v += bf2f(j.y[(long)j.pos[tok * 6 + k] * DM + c]); vals[c] = v; }
        PAR_END
        PAR_BEGIN LN_SETUP if (act && lt < 16) { float s = 0.f; for (int c = lt * (DM / 16); c < (lt + 1) * (DM / 16); ++c) s += vals[c]; red[lt] = s; } PAR_END
        PAR_BEGIN LN_SETUP if (act && lt == 0) { float s = 0.f; for (int i = 0; i < 16; ++i) s += red[i]; red[32] = s / (float)DM; } PAR_END
        PAR_BEGIN LN_SETUP if (act && lt < 16) { const float mu = red[32]; float s = 0.f; for (int c = lt * (DM / 16); c < (lt + 1) * (DM / 16); ++c) { const float d = vals[c] - mu; s += d * d; } red[lt] = s; } PAR_END
        PAR_BEGIN LN_SETUP if (act && lt == 0) { float s = 0.f; for (int i = 0; i < 16; ++i) s += red[i]; red[33] = 1.0f / sqrtf(s / (float)DM + LN_EPS); } PAR_END
        PAR_BEGIN LN_SETUP
            if (act) { const float mu = red[32], rs = red[33];
                for (int c = lt; c < DM; c += 256) { const float o = (vals[c] - mu) * rs * j.g[c] + j.b[c]; if (j.obf) j.obf[tok * DM + c] = f2bf(o); else j.of32[tok * DM + c] = o; } }
        PAR_END
    }
}

struct GemmArgs { const bf16* A; const bf16* Bt; const int* rowidx; const int* tile_e; long lda; long b_estride; int M, N, K, pad; };

struct EpiProj0 { unsigned char* ws;
    __device__ __forceinline__ void operator()(int row, int col, float v, float) const {
        if (col >= PROJ_N) return; const long b = row / S, s = row % S;
        if (col < 2048) { const int seg = col >> 9, h = (col >> 6) & 7, d = col & 63; bf16* base = (bf16*)(ws + A_QA + (size_t)seg * HB); base[((b * 8 + h) * S + s) * 64 + d] = f2bf(v); }
        else if (col < 2816) { const int c2 = col - 2048, seg = c2 >> 7, g = (c2 >> 6) & 1, d = c2 & 63; bf16* base = (bf16*)(ws + A_KC + (size_t)seg * GB); base[((b * 2 + g) * S + s) * 64 + d] = f2bf(v); }
        else ((float*)(ws + A_GRAW))[(long)row * 24 + (col - 2816)] = v; } };
struct EpiCmp1 { bf16* out; const float* bias;
    __device__ __forceinline__ void operator()(int row, int col, float v, float) const { out[(long)row * 256 + col] = f2bf(gelu_tanh(v + bias[col])); } };
struct EpiResF32 { float* out; const float* res; int ld; int pad = 0;
    __device__ __forceinline__ void operator()(int row, int col, float v, float) const { out[(long)row * ld + col] = DN_ALPHA * res[(long)row * ld + col] + v; } };
struct EpiResBf { float* out; const bf16* res; int ld; int pad = 0;
    __device__ __forceinline__ void operator()(int row, int col, float v, float) const { out[(long)row * ld + col] = DN_ALPHA * bf2f(res[(long)row * ld + col]) + v; } };
struct EpiLogit { float* out;
    __device__ __forceinline__ void operator()(int row, int col, float v, float) const { if (col < 64) out[(long)row * 64 + col] = v; } };
struct EpiSwiglu { bf16* out;
    __device__ __forceinline__ void operator()(int row, int col, float v, float v2) const { if ((col & GU_IL) == 0) out[(long)row * 256 + (col >> 6) * GU_IL + (col & (GU_IL - 1))] = f2bf(siluf_(v) * v2); } };
struct EpiY { bf16* out; const float* rowgate; int ld; int pad = 0;
    __device__ __forceinline__ void operator()(int row, int col, float v, float) const { out[(long)row * ld + col] = f2bf(v * rowgate[row]); } };
struct EpiBf { bf16* out; int ld; int pad = 0;
    __device__ __forceinline__ void operator()(int row, int col, float v, float) const { out[(long)row * ld + col] = f2bf(v); } };
struct EpiGlu { bf16* out; const bf16* ys; int ld; int pad = 0;
    __device__ __forceinline__ void operator()(int row, int col, float v, float) const { out[(long)row * ld + col] = f2bf(bf2f(ys[(long)row * ld + col]) * sigmoidf_(v)); } };

#ifndef HOST_EMU
typedef short bf16x8_t __attribute__((ext_vector_type(8)));
typedef float f32x4_t __attribute__((ext_vector_type(4)));
template <class Epi>
__global__ void __launch_bounds__(256, 2) k_gemm(GemmArgs g, Epi epi) {
    __shared__ __attribute__((aligned(16))) bf16 shm[2 * 128 * 32];
    const int tid = threadIdx.x, wid = tid >> 6, lane = tid & 63, wr = wid >> 1, wc = wid & 1, fr = lane & 15, fq = lane >> 4;
    const int ntn = g.N / 128, ntiles = (g.M / 128) * ntn, K = g.K;
    bf16* SA = shm; bf16* SB = shm + 128 * 32;
    for (int tile = blockIdx.x; tile < ntiles; tile += gridDim.x) {
        const int brow = (tile / ntn) * 128, bcol = (tile % ntn) * 128;
        const bf16* Bg = g.Bt;
        if (g.tile_e) { const int e = g.tile_e[brow >> 8]; if (e < 0) continue; Bg += (long)e * g.b_estride; }
        const bf16* ap[2]; const bf16* bp[2];
#pragma unroll
        for (int i = 0; i < 2; ++i) { const int bb = tid * 16 + i * 4096, r = bb / 64, c = (bb % 64) / 2;
            const long ridx = g.rowidx ? (long)g.rowidx[brow + r] : (long)(brow + r);
            ap[i] = g.A + ridx * g.lda + c; bp[i] = Bg + (long)(bcol + r) * K + c; }
        f32x4_t acc[4][4];
#pragma unroll
        for (int m = 0; m < 4; ++m)
#pragma unroll
            for (int n = 0; n < 4; ++n) acc[m][n] = (f32x4_t){0.f, 0.f, 0.f, 0.f};
        for (int t = 0; t < K / 32; ++t) {
#pragma unroll
            for (int i = 0; i < 2; ++i) { const int bb = tid * 16 + i * 4096;
                __builtin_amdgcn_global_load_lds((const unsigned*)(ap[i] + t * 32), (__attribute__((address_space(3))) unsigned*)((char*)SA + bb), 16, 0, 0);
                __builtin_amdgcn_global_load_lds((const unsigned*)(bp[i] + t * 32), (__attribute__((address_space(3))) unsigned*)((char*)SB + bb), 16, 0, 0); }
            asm volatile("s_waitcnt vmcnt(0)" ::: "memory"); __syncthreads();
            bf16x8_t At[4], Bl[4];
#pragma unroll
            for (int m = 0; m < 4; ++m) { At[m] = *(const bf16x8_t*)((const char*)SA + (wr * 64 + m * 16 + fr) * 64 + fq * 16); Bl[m] = *(const bf16x8_t*)((const char*)SB + (wc * 64 + m * 16 + fr) * 64 + fq * 16); }
#pragma unroll
            for (int m = 0; m < 4; ++m)
#pragma unroll
                for (int n = 0; n < 4; ++n) acc[m][n] = __builtin_amdgcn_mfma_f32_16x16x32_bf16(At[m], Bl[n], acc[m][n], 0, 0, 0);
            __syncthreads();
        }
#pragma unroll
        for (int m = 0; m < 4; ++m)
#pragma unroll
            for (int n = 0; n < 4; ++n)
#pragma unroll
                for (int jx = 0; jx < 4; ++jx) epi(brow + wr * 64 + m * 16 + fq * 4 + jx, bcol + wc * 64 + n * 16 + fr, acc[m][n][jx], acc[m][n ^ 2][jx]);
    }
}
template <class Epi> static void run_gemm(hipStream_t st, const GemmArgs& g, const Epi& e) {
    const int ntiles = (g.M / 128) * (g.N / 128); const int grid = ntiles < 2048 ? ntiles : 2048;
    k_gemm<Epi><<<grid, 256, 0, st>>>(g, e);
}
#else
template <class Epi> static void run_gemm(hipStream_t, const GemmArgs& g, const Epi& epi) {
    static float Ct[128][128];
    for (int tm = 0; tm < g.M / 128; ++tm) for (int tn = 0; tn < g.N / 128; ++tn) {
        const int brow = tm * 128, bcol = tn * 128; const bf16* Bg = g.Bt;
        if (g.tile_e) { const int e = g.tile_e[brow >> 8]; if (e < 0) continue; Bg += (long)e * g.b_estride; }
        for (int r = 0; r < 128; ++r) { const long ridx = g.rowidx ? g.rowidx[brow + r] : brow + r; const bf16* a = g.A + ridx * g.lda;
            for (int c = 0; c < 128; ++c) { const bf16* bt = Bg + (long)(bcol + c) * g.K; float s = 0.f; for (int k = 0; k < g.K; ++k) s += bf2f(a[k]) * bf2f(bt[k]); Ct[r][c] = s; } }
        for (int r = 0; r < 128; ++r) for (int c = 0; c < 128; ++c) epi(brow + r, bcol + c, Ct[r][c], Ct[r][c ^ 32]);
    }
}
#endif

enum { PH_XPOSE = 0, PH_CVT, PH_TABLES, PH_ROPE, PH_CMPW2, PH_SB, PH_NSA, PH_S5, PH_ROUTE, PH_OFFSETS, PH_CLEAR, PH_SCATTER, PH_LN };
#ifndef HOST_EMU
__global__ void __launch_bounds__(256) k_xpose(XposeJob j) { LDS_DECL; ph_xpose(j, lds); }
__global__ void __launch_bounds__(256) k_cvt(const float* s, bf16* d, long n) { ph_cvt(s, d, n); }
__global__ void __launch_bounds__(256) k_ln(LnJob j) { LDS_DECL; ph_ln(j, lds); }
template <int PH> __global__ void __launch_bounds__(256) k_phase(P p) {
    LDS_DECL;
    if (PH == PH_TABLES) ph_tables(p); else if (PH == PH_ROPE) ph_rope(p); else if (PH == PH_CMPW2) ph_cmpw2(p); else if (PH == PH_SB) ph_sb(p);
    else if (PH == PH_NSA) ph_nsa(p, lds); else if (PH == PH_S5) ph_s5(p, lds); else if (PH == PH_ROUTE) ph_route(p, lds); else if (PH == PH_OFFSETS) ph_offsets(p);
    else if (PH == PH_CLEAR) ph_clear_rows(p); else if (PH == PH_SCATTER) ph_scatter(p);
}
#define LAUNCH_PHASE(PH, grid, ldsb) k_phase<PH><<<(grid), 256, (ldsb), stream>>>(p)
#define LAUNCH_XPOSE(job, grid) k_xpose<<<(grid), 256, 64 * 65 * 4, stream>>>(job)
#define LAUNCH_CVT(s, d, n, grid) k_cvt<<<(grid), 256, 0, stream>>>(s, d, n)
#define LAUNCH_LN(job, grid) k_ln<<<(grid), 256, LN_LDS_PER, stream>>>(job)
#else
#define EMU_LOOP(grid, body) do { e_gridDim.x = (grid); e_blockDim.x = 256; for (int _b = 0; _b < (grid); ++_b) { e_blockIdx.x = _b; LDS_DECL; (void)lds; body; } } while (0)
template <int PH> static void emu_phase(const P& p, unsigned char* lds) {
    if (PH == PH_TABLES) ph_tables(p); else if (PH == PH_ROPE) ph_rope(p); else if (PH == PH_CMPW2) ph_cmpw2(p); else if (PH == PH_SB) ph_sb(p);
    else if (PH == PH_NSA) ph_nsa(p, lds); else if (PH == PH_S5) ph_s5(p, lds); else if (PH == PH_ROUTE) ph_route(p, lds); else if (PH == PH_OFFSETS) ph_offsets(p);
    else if (PH == PH_CLEAR) ph_clear_rows(p); else if (PH == PH_SCATTER) ph_scatter(p);
}
#define LAUNCH_PHASE(PH, grid, ldsb) EMU_LOOP(((grid) < 8 ? (grid) : 8), emu_phase<PH>(p, lds))
#define LAUNCH_XPOSE(job, grid) EMU_LOOP(4, ph_xpose(job, lds))
#define LAUNCH_CVT(s, d, n, grid) EMU_LOOP(4, ph_cvt(s, d, n))
#define LAUNCH_LN(job, grid) EMU_LOOP(4, ph_ln(job, lds))
static int hipMemsetAsync(void* p, int v, size_t n, hipStream_t) { memset(p, v, n); return 0; }
#endif

static void xpose(hipStream_t stream, const float* src, bf16* dst, int K, int N, int Ncover, int il, int il2, int add, int batch, long ss, long ds) {
    XposeJob j; memset(&j, 0, sizeof(j)); j.src = src; j.dst = dst; j.K = K; j.N = N; j.Ncover = Ncover; j.il = il; j.il2 = il2; j.add = add; j.batch = batch; j.sstride = ss; j.dstride = ds;
    (void)stream; LAUNCH_XPOSE(j, 2048);
}
static GemmArgs mk_gemm(const bf16* A, long lda, const bf16* Bt, int M, int N, int K) { GemmArgs g; memset(&g, 0, sizeof(g)); g.A = A; g.Bt = Bt; g.lda = lda; g.M = M; g.N = N; g.K = K; return g; }

extern "C" void kernel_launch(void* const* d_in, const int* in_sizes, int n_in, void* d_out, int out_size, void* d_ws, size_t ws_size, hipStream_t stream) {
    (void)in_sizes; (void)out_size;
    if (n_in < 44 || ws_size < WS_NEED) return;
    P p; memset(&p, 0, sizeof(p));
    for (int i = 0; i < 44; ++i) p.in[i] = (const float*)d_in[i];
    p.out = (float*)d_out; p.ws = (unsigned char*)d_ws;
    unsigned char* ws = p.ws;
#define WS(T_, off) ((T_*)(ws + (off)))
    (void)hipMemsetAsync(ws + O_CTL, 0, CTL_BYTES, stream);
    xpose(stream, p.in[I_L0_WIN], WS(bf16, O_WT_IN0), DM, PROJ_N, PROJ_NP, PROJ_NP, 0, 0, 1, 0, 0);
    xpose(stream, p.in[I_KW1], WS(bf16, O_WT_K1), 2048, 256, 256, 256, 0, 0, 1, 0, 0);
    xpose(stream, p.in[I_VW1], WS(bf16, O_WT_V1), 2048, 256, 256, 256, 0, 0, 1, 0, 0);
    xpose(stream, p.in[I_L0_WOUT], WS(bf16, O_WT_OUT0), 1024, DM, DM, DM, 0, 0, 1, 0, 0);
    for (int l = 0; l < 2; ++l) { const int mi = MOE_IN0[l];
        xpose(stream, p.in[mi], WS(bf16, O_WT_R) + (size_t)l * 128 * DM, DM, 64, 128, 128, 0, 0, 1, 0, 0);
        xpose(stream, p.in[mi + 5], WS(bf16, O_WT_SGU) + (size_t)l * 512 * DM, DM, 256, 256, GU_IL, 2 * GU_IL, 0, 1, 0, 0);
        xpose(stream, p.in[mi + 6], WS(bf16, O_WT_SGU) + (size_t)l * 512 * DM, DM, 256, 256, GU_IL, 2 * GU_IL, GU_IL, 1, 0, 0);
        xpose(stream, p.in[mi + 7], WS(bf16, O_WT_SD) + (size_t)l * DM * 256, 256, DM, DM, DM, 0, 0, 1, 0, 0); }
    xpose(stream, p.in[I_L1_WIN], WS(bf16, O_WT_IN1), DM, DM, DM, DM, 0, 0, 1, 0, 0);
    xpose(stream, p.in[I_WGLU], WS(bf16, O_WT_GLU), DM, DM, DM, DM, 0, 0, 1, 0, 0);
    xpose(stream, p.in[I_L1_WOUT], WS(bf16, O_WT_OUT1), DM, DM, DM, DM, 0, 0, 1, 0, 0);
    LAUNCH_PHASE(PH_TABLES, 64, 0);
    LAUNCH_CVT(p.in[I_X], WS(bf16, O_H), (long)T * DM, 2048);
    { GemmArgs g = mk_gemm(WS(bf16, O_H), DM, WS(bf16, O_WT_IN0), T, PROJ_NP, DM); EpiProj0 e{ws}; run_gemm(stream, g, e); }
    LAUNCH_PHASE(PH_ROPE, 2048, 0);
    { GemmArgs g = mk_gemm(WS(bf16, A_KC), 1024, WS(bf16, O_WT_K1), NB * 2 * NCP, 256, 2048); EpiCmp1 e{WS(bf16, A_HCK), WS(float, O_BIASK)}; run_gemm(stream, g, e); }
    { GemmArgs g = mk_gemm(WS(bf16, A_VC), 1024, WS(bf16, O_WT_V1), NB * 2 * NCP, 256, 2048); EpiCmp1 e{WS(bf16, A_HCV), WS(float, O_BIASV)}; run_gemm(stream, g, e); }
    LAUNCH_PHASE(PH_CMPW2, 1024, 0);
    LAUNCH_PHASE(PH_SB, (NB * 8 * S + 255) / 256, 0);
    LAUNCH_PHASE(PH_NSA, 8192, NSA_LDS_PER);
    { GemmArgs g = mk_gemm(WS(bf16, A_ATT), 1024, WS(bf16, O_WT_OUT0), T, DM, 1024); EpiResF32 e{p.out, p.in[I_X], DM}; run_gemm(stream, g, e); }
    { LnJob j; memset(&j, 0, sizeof(j)); j.pre = p.out; j.g = p.in[I_L0_LN1G]; j.b = p.in[I_L0_LN1B]; j.obf = WS(bf16, O_H); j.t_beg = 0; j.t_cnt = T; LAUNCH_LN(j, 4096); }
    for (int layer = 0; layer < 2; ++layer) {
        const int mi = MOE_IN0[layer]; bf16* hin = WS(bf16, O_H); p.layer = layer;
        if (layer == 1) {
            { GemmArgs g = mk_gemm(WS(bf16, O_H2), DM, WS(bf16, O_WT_IN1), T, DM, DM); EpiBf e{WS(bf16, C_U), DM}; run_gemm(stream, g, e); }
            LAUNCH_PHASE(PH_S5, (NB * NG + 3) / 4, 4 * S5_LDS_PER);
            { GemmArgs g = mk_gemm(WS(bf16, C_YS), DM, WS(bf16, O_WT_GLU), T, DM, DM); EpiGlu e{WS(bf16, C_Y2), WS(bf16, C_YS), DM}; run_gemm(stream, g, e); }
            { GemmArgs g = mk_gemm(WS(bf16, C_Y2), DM, WS(bf16, O_WT_OUT1), T, DM, DM); EpiResBf e{p.out, WS(bf16, O_H2), DM}; run_gemm(stream, g, e); }
            { LnJob j; memset(&j, 0, sizeof(j)); j.pre = p.out; j.g = p.in[I_L1_LN1G]; j.b = p.in[I_L1_LN1B]; j.obf = WS(bf16, O_H); j.t_beg = 0; j.t_cnt = T; LAUNCH_LN(j, 4096); }
        }
        xpose(stream, p.in[mi + 2], WS(bf16, O_WT_GU), DM, 256, 256, GU_IL, 2 * GU_IL, 0, 64, (long)DM * 256, (long)512 * DM);
        xpose(stream, p.in[mi + 3], WS(bf16, O_WT_GU), DM, 256, 256, GU_IL, 2 * GU_IL, GU_IL, 64, (long)DM * 256, (long)512 * DM);
        xpose(stream, p.in[mi + 4], WS(bf16, O_WT_D), 256, DM, DM, DM, 0, 0, 64, (long)256 * DM, (long)DM * 256);
        { GemmArgs g = mk_gemm(hin, DM, WS(bf16, O_WT_R) + (size_t)layer * 128 * DM, T, 128, DM); EpiLogit e{WS(float, B_LOGIT)}; run_gemm(stream, g, e); }
        { GemmArgs g = mk_gemm(hin, DM, WS(bf16, O_WT_SGU) + (size_t)layer * 512 * DM, T, 512, DM); EpiSwiglu e{WS(bf16, B_ASH)}; run_gemm(stream, g, e); }
        { GemmArgs g = mk_gemm(WS(bf16, B_ASH), 256, WS(bf16, O_WT_SD) + (size_t)layer * DM * 256, T, DM, 256); EpiResBf e{p.out, hin, DM}; run_gemm(stream, g, e); }
        for (int ch = 0; ch < NCH; ++ch) {
            p.chunk = ch;
#ifndef HOST_EMU
            (void)hipFuncSetAttribute((const void*)k_phase<PH_ROUTE>, hipFuncAttributeMaxDynamicSharedMemorySize, 256 * 72 * 4 + 128 * 4 + 256 * 6 * 4);
#endif
            LAUNCH_PHASE(PH_ROUTE, (TC + 255) / 256, 256 * 72 * 4 + 128 * 4 + 256 * 6 * 4);
            LAUNCH_PHASE(PH_OFFSETS, 1, 0);
            LAUNCH_PHASE(PH_CLEAR, 256, 0);
            LAUNCH_PHASE(PH_SCATTER, 1024, 0);
            { GemmArgs g = mk_gemm(hin, DM, WS(bf16, O_WT_GU), MOE_ROWS, 512, DM); g.rowidx = WS(int, B_ROWTOK); g.tile_e = WS(int, O_TILEE); g.b_estride = (long)512 * DM; EpiSwiglu e{WS(bf16, B_AEX)}; run_gemm(stream, g, e); }
            { GemmArgs g = mk_gemm(WS(bf16, B_AEX), 256, WS(bf16, O_WT_D), MOE_ROWS, DM, 256); g.tile_e = WS(int, O_TILEE); g.b_estride = (long)DM * 256; EpiY e{WS(bf16, B_Y), WS(float, B_ROWGATE), DM}; run_gemm(stream, g, e); }
            { LnJob j; memset(&j, 0, sizeof(j)); j.pre = p.out; j.y = WS(bf16, B_Y); j.pos = WS(int, B_POS); j.g = p.in[mi + 8]; j.b = p.in[mi + 9]; j.t_beg = (long)ch * TC; j.t_cnt = TC;
              if (layer == 0) j.obf = WS(bf16, O_H2); else j.of32 = p.out; LAUNCH_LN(j, 4096); }
        }
    }
}
```

```cpp
#ifndef HOST_EMU
#include <hip/hip_runtime.h>
#endif
#include <stdint.h>
#include <stddef.h>
#include <math.h>
#include <string.h>

#ifndef CFG_B
#define CFG_B 32
#define CFG_S 2048
#define CFG_D 1024
#endif

#ifdef HOST_EMU
#include <stdio.h>
#include <stdlib.h>
#define __global__
#define __device__
#define __host__
#define __forceinline__ inline
struct EmuDim { int x; };
static EmuDim e_blockIdx, e_gridDim, e_blockDim;
#define BIDX (e_blockIdx.x)
#define GDIM_OF(a_) (e_gridDim.x)
#define NTHR (e_blockDim.x)
#define PAR_BEGIN for (int tid = 0; tid < NTHR; ++tid) {
#define PAR_END }
template <class T> static inline T emu_atomic_add(T* p, T v) { T o = *p; *p = o + v; return o; }
#define ATOMIC_ADD(p, v) emu_atomic_add((p), (v))
typedef int hipStream_t;
static unsigned char g_emu_lds[163840];
#define LDS_DECL unsigned char* lds = g_emu_lds
#else
#define BIDX ((int)blockIdx.x)
#define GDIM_OF(a_) ((a_).grid)
#define NTHR 512
#define PAR_BEGIN { int tid = (int)threadIdx.x; asm volatile("" : "+v"(tid));
#define PAR_END } __syncthreads();
#define ATOMIC_ADD(p, v) atomicAdd((p), (v))
#define LDS_DECL extern __shared__ __attribute__((aligned(16))) unsigned char lds[]
#endif

typedef unsigned short bf16;

constexpr int NB = CFG_B, S = CFG_S, DM = CFG_D, T = NB * S;
constexpr int NCH = 1, TC = T / NCH;
constexpr int MOE_ROWS = ((TC * 6 + 64 * 255 + 255) / 256) * 256, MOE_TILES = MOE_ROWS / 256;
constexpr int NG = DM / 16;
constexpr int NCP = S / 16, NCMP = NCP - 1, NSLC = S / 64;
constexpr int PROJ_N = 2840, PROJ_NP = 3072;
constexpr int GU_IL = 128;
constexpr float DN_ALPHA = 1.4142135623730951f;
constexpr float LN_EPS = 1e-5f;
constexpr float QSCALE = 0.125f * 1.4426950408889634f;

constexpr size_t al256(size_t x) { return (x + 255) & ~(size_t)255; }
constexpr size_t O_CTL = 0, CTL_BYTES = 65536;
constexpr size_t O_CNT = O_CTL + 16384;
constexpr size_t O_PADSTART = O_CTL + CTL_BYTES;
constexpr size_t O_TILEE = O_PADSTART + 512;
constexpr size_t O_CMPTE = al256(O_TILEE + (size_t)MOE_TILES * 4);
constexpr size_t O_BIASK = al256(O_CMPTE + 1024);
constexpr size_t O_BIASV = O_BIASK + 1024;
constexpr size_t O_BIASP = O_BIASV + 1024;
constexpr size_t O_WT_K2 = O_BIASP + (size_t)64 * 512 * 4;
constexpr size_t O_ROPE = O_WT_K2 + (size_t)2 * 256 * 256 * 2;
constexpr size_t O_ABAR = O_ROPE + (size_t)S * 16 * 4;
constexpr size_t O_BBAR = al256(O_ABAR + (size_t)NG * 64 * 2 * 4);
constexpr size_t O_S5BT = al256(O_BBAR + (size_t)NG * 64 * 16 * 2 * 4);
constexpr size_t O_S5AP = al256(O_S5BT + (size_t)NG * 128 * 16 * 2);
constexpr size_t O_S5CT = al256(O_S5AP + (size_t)NG * 64 * 8 * 4);
constexpr size_t O_WT_IN0 = al256(O_S5CT + (size_t)NG * 32 * 128 * 2);
constexpr size_t O_WT_K1 = al256(O_WT_IN0 + (size_t)PROJ_NP * DM * 2);
constexpr size_t O_WT_V1 = O_WT_K1 + (size_t)256 * 2048 * 2;
constexpr size_t O_WT_OUT0 = O_WT_V1 + (size_t)256 * 2048 * 2;
constexpr size_t O_WT_R = al256(O_WT_OUT0 + (size_t)DM * 1024 * 2);
constexpr size_t O_WT_SGU = al256(O_WT_R + (size_t)2 * 256 * DM * 2);
constexpr size_t O_WT_SD = al256(O_WT_SGU + (size_t)2 * 512 * DM * 2);
constexpr size_t O_WT_GU = al256(O_WT_SD + (size_t)2 * DM * 256 * 2);
constexpr size_t O_WT_D = al256(O_WT_GU + (size_t)64 * 512 * DM * 2);
constexpr size_t O_WT_IN1 = al256(O_WT_D + (size_t)64 * DM * 256 * 2);
constexpr size_t O_WT_GLU = O_WT_IN1 + (size_t)DM * DM * 2;
constexpr size_t O_WT_OUT1 = O_WT_GLU + (size_t)DM * DM * 2;
constexpr size_t O_H = al256(O_WT_OUT1 + (size_t)DM * DM * 2);
constexpr size_t O_H2 = al256(O_H + (size_t)T * DM * 2);
constexpr size_t O_SCR = al256(O_H2 + (size_t)T * DM * 2);
constexpr size_t HB = (size_t)NB * 8 * S * 64 * 2, GB = (size_t)NB * 2 * S * 64 * 2;
constexpr size_t A_QA = O_SCR, A_KA = A_QA + HB, A_VA = A_KA + HB, A_QB = A_VA + HB;
constexpr size_t A_KC = A_QB + HB, A_VC = A_KC + GB, A_KS = A_VC + GB, A_VS = A_KS + GB, A_KW = A_VS + GB, A_VW = A_KW + GB;
constexpr size_t A_GRAW = A_VW + GB;
constexpr size_t A_HCK = al256(A_GRAW + (size_t)T * 24 * 4);
constexpr size_t A_HCV = A_HCK + (size_t)NB * 2 * NCP * 256 * 2;
constexpr size_t A_KCMP = A_HCV + (size_t)NB * 2 * NCP * 256 * 2;
constexpr size_t A_VCMP = A_KCMP + (size_t)NB * 2 * NCP * 64 * 4;
constexpr size_t A_ATT = al256(A_VCMP + (size_t)NB * 2 * NCP * 64 * 4);
constexpr size_t A_END = A_ATT + (size_t)T * 1024 * 2;
constexpr size_t B_EIDX = O_SCR;
constexpr size_t B_GATE = al256(B_EIDX + (size_t)T * 6 * 4);
constexpr size_t B_POS = al256(B_GATE + (size_t)T * 6 * 4);
constexpr size_t B_ROWTOK = al256(B_POS + (size_t)T * 6 * 4);
constexpr size_t B_ROWGATE = al256(B_ROWTOK + (size_t)MOE_ROWS * 4);
constexpr size_t B_AEX = al256(B_ROWGATE + (size_t)MOE_ROWS * 4);
constexpr size_t B_H8 = al256(B_AEX + (size_t)MOE_ROWS * 256);
static_assert(B_H8 + (size_t)T * DM <= B_AEX + (size_t)MOE_ROWS * 256 * 2, "h8 fits behind the fp8 AEX");
constexpr size_t B_ASH = B_AEX;
constexpr size_t B_Y = al256(B_AEX + (size_t)MOE_ROWS * 256 * 2);
constexpr size_t B_LOGIT = B_Y;
constexpr size_t B_END = B_Y + (size_t)MOE_ROWS * DM;
static_assert((size_t)T * 256 * 2 <= (size_t)MOE_ROWS * 256 * 2 && (size_t)T * 64 * 4 <= (size_t)MOE_ROWS * DM, "MoE overlays");
constexpr size_t B_H28 = B_AEX;
constexpr size_t C_U = O_SCR + ((size_t)128 << 20), C_YS = C_U + (size_t)T * DM * 2, C_Y2 = C_YS + (size_t)T * DM * 2, C_END = C_Y2 + (size_t)T * DM * 2;
static_assert(B_H28 + (size_t)T * DM <= B_H8 && B_H28 + (size_t)T * DM <= O_SCR + ((size_t)128 << 20), "h2 fp8 copy: inside the AEX half, below stage C");
constexpr size_t WS_NEED = (A_END > B_END ? (A_END > C_END ? A_END : C_END) : (B_END > C_END ? B_END : C_END)) + 4096;

__host__ __device__ __forceinline__ float bf2f(bf16 v) { unsigned u = ((unsigned)v) << 16; float f; memcpy(&f, &u, 4); return f; }
__host__ __device__ __forceinline__ bf16 f2bf(float f) { unsigned u; memcpy(&u, &f, 4); u = (u + 0x7fffu + ((u >> 16) & 1u)) >> 16; return (bf16)u; }
#ifdef HOST_EMU
__host__ __device__ __forceinline__ float sigmoidf_(float x) { return 1.0f / (1.0f + expf(-x)); }
#else
__device__ __forceinline__ float sigmoidf_(float x) { return __builtin_amdgcn_rcpf(1.0f + __builtin_amdgcn_exp2f(-1.4426950408889634f * x)); }
#endif
__host__ __device__ __forceinline__ float gelu_tanh(float x) { return 0.5f * x * (1.0f + tanhf(0.7978845608028654f * (x + 0.044715f * x * x * x))); }
__host__ __device__ __forceinline__ float siluf_(float x) { return x * sigmoidf_(x); }


constexpr float Y8_SCALE = 16.0f, Y8_INV = 1.0f / 16.0f;
__host__ __device__ __forceinline__ float fp82f(unsigned c) { const unsigned e = (c >> 3) & 15u, m = c & 7u; const float v = e ? (1.0f + (float)m * 0.125f) * exp2f((float)e - 7.0f) : (float)m * 0.001953125f; return (c & 0x80u) ? -v : v; }
#ifdef HOST_EMU
static inline unsigned f2fp8(float f) { const unsigned sg = f < 0.f ? 0x80u : 0u; float a = fabsf(f); if (!(a == a)) return 0x7fu; if (a >= 448.f) return sg | 0x7eu;
    if (a < 0.015625f) { const int q = (int)nearbyintf(a * 512.0f); return sg | (unsigned)q; }
    int e; float m = frexpf(a, &e); m *= 2.f; e -= 1; int q = (int)nearbyintf((m - 1.0f) * 8.0f); if (q == 8) { q = 0; e += 1; } unsigned c = ((unsigned)(e + 7) << 3) | (unsigned)q; if (c > 0x7eu) c = 0x7eu; return sg | c; }
#endif
struct f4 { float v[4]; };
__host__ __device__ __forceinline__ f4 ld_f4(const float* p) {
    f4 r;
#ifdef HOST_EMU
    for (int i = 0; i < 4; ++i) r.v[i] = p[i];
#else
    const float4 w = *(const float4*)p; r.v[0] = w.x; r.v[1] = w.y; r.v[2] = w.z; r.v[3] = w.w;
#endif
    return r;
}
__host__ __device__ __forceinline__ void st_bf4(bf16* p, float a, float b, float c, float d) {
#ifdef HOST_EMU
    p[0] = f2bf(a); p[1] = f2bf(b); p[2] = f2bf(c); p[3] = f2bf(d);
#else
    uint2 w; w.x = (unsigned)f2bf(a) | ((unsigned)f2bf(b) << 16); w.y = (unsigned)f2bf(c) | ((unsigned)f2bf(d) << 16); *(uint2*)p = w;
#endif
}
__host__ __device__ __forceinline__ void cp16(bf16* d, const bf16* s_) {
#ifdef HOST_EMU
    for (int i = 0; i < 8; ++i) d[i] = s_[i];
#else
    *(uint4*)d = *(const uint4*)s_;
#endif
}
struct f8 { float v[8]; };
__host__ __device__ __forceinline__ void st_bf8(bf16* p, const f8& x) {
#ifdef HOST_EMU
    for (int i = 0; i < 8; ++i) p[i] = f2bf(x.v[i]);
#else
    uint4 w; w.x = (unsigned)f2bf(x.v[0]) | ((unsigned)f2bf(x.v[1]) << 16); w.y = (unsigned)f2bf(x.v[2]) | ((unsigned)f2bf(x.v[3]) << 16);
    w.z = (unsigned)f2bf(x.v[4]) | ((unsigned)f2bf(x.v[5]) << 16); w.w = (unsigned)f2bf(x.v[6]) | ((unsigned)f2bf(x.v[7]) << 16); *(uint4*)p = w;
#endif
}
__host__ __device__ __forceinline__ f8 ld_bf8(const bf16* p) {
    f8 r;
#ifdef HOST_EMU
    for (int i = 0; i < 8; ++i) r.v[i] = bf2f(p[i]);
#else
    const uint4 w = *(const uint4*)p; r.v[0] = bf2f((bf16)(w.x & 0xffffu)); r.v[1] = bf2f((bf16)(w.x >> 16)); r.v[2] = bf2f((bf16)(w.y & 0xffffu)); r.v[3] = bf2f((bf16)(w.y >> 16));
    r.v[4] = bf2f((bf16)(w.z & 0xffffu)); r.v[5] = bf2f((bf16)(w.z >> 16)); r.v[6] = bf2f((bf16)(w.w & 0xffffu)); r.v[7] = bf2f((bf16)(w.w >> 16));
#endif
    return r;
}
__host__ __device__ __forceinline__ f8 ld_f8(const float* p) { f8 r; const f4 a = ld_f4(p), b = ld_f4(p + 4); for (int i = 0; i < 4; ++i) { r.v[i] = a.v[i]; r.v[4 + i] = b.v[i]; } return r; }
__host__ __device__ __forceinline__ void st_f8(float* p, const f8& x) {
#ifdef HOST_EMU
    for (int i = 0; i < 8; ++i) p[i] = x.v[i];
#else
    *(float4*)p = make_float4(x.v[0], x.v[1], x.v[2], x.v[3]); *(float4*)(p + 4) = make_float4(x.v[4], x.v[5], x.v[6], x.v[7]);
#endif
}


struct P {
    const float* in[44];
    float* out;
    unsigned char* ws;
    int grid, pad0, pad1, pad2;
};
#define WSP(T_, off) ((T_*)(p.ws + (off)))

enum { I_X = 0, I_L0_WIN, I_POSK, I_POSV, I_KW1, I_KW2, I_VW1, I_VW2, I_L0_WOUT, I_L0_LN1G, I_L0_LN1B,
       I_L0_ROUTER, I_L0_RBIAS, I_L0_WG, I_L0_WU, I_L0_WD, I_L0_SG, I_L0_SU, I_L0_SD, I_L0_LN2G, I_L0_LN2B,
       I_L1_WIN, I_LRE, I_LIM, I_BRE, I_BIM, I_CRE, I_CIM, I_DSK, I_LOGDT, I_WGLU, I_L1_WOUT, I_L1_LN1G, I_L1_LN1B,
       I_L1_ROUTER, I_L1_RBIAS, I_L1_WG, I_L1_WU, I_L1_WD, I_L1_SG, I_L1_SU, I_L1_SD, I_L1_LN2G, I_L1_LN2B };
constexpr int MOE_IN0[2] = { I_L0_ROUTER, I_L1_ROUTER };

struct XposeJob { const float* src; bf16* dst; int K, N, Ncover, il, il2, add, batch, grid; long sstride, dstride; int first; };
__device__ __forceinline__ void ph_xpose(const XposeJob j, unsigned char* lds) {
    bf16* tile = (bf16*)lds;
    const int tk = j.K / 64, tn = (j.Ncover + 255) / 256, per = tk * tn;
    for (int item = (BIDX - j.first + GDIM_OF(j)) % GDIM_OF(j); item < per * j.batch; item += GDIM_OF(j)) {
        const int bt = item / per, it = item % per, k0 = (it / tn) * 64, n0 = (it % tn) * 256;
        const float* src = j.src + (long)bt * j.sstride; bf16* dst = j.dst + (long)bt * j.dstride;
        PAR_BEGIN
            for (int e = tid; e < 16 * 64; e += NTHR) { const int k4 = (e >> 6) * 4, n4 = (e & 63) * 4, n = n0 + n4;
                float v[4][4];
                for (int r = 0; r < 4; ++r) { const float* row = src + (long)(k0 + k4 + r) * j.N;
                    if (n + 3 < j.N && (j.N & 3) == 0) { const f4 q = ld_f4(row + n); v[r][0] = q.v[0]; v[r][1] = q.v[1]; v[r][2] = q.v[2]; v[r][3] = q.v[3]; }
                    else for (int c = 0; c < 4; ++c) v[r][c] = (n + c < j.N) ? row[n + c] : 0.f; }
                for (int c = 0; c < 4; ++c) st_bf4(tile + (n4 + c) * 72 + k4, v[0][c], v[1][c], v[2][c], v[3][c]); }
        PAR_END
        PAR_BEGIN
            for (int e = tid; e < 256 * 8; e += NTHR) { const int nn = e >> 3, c8 = (e & 7) * 8, n = n0 + nn;
                if (n < j.Ncover) { const long row = (long)(n / j.il) * j.il2 + (n % j.il) + j.add; cp16(dst + row * j.K + k0 + c8, tile + nn * 72 + c8); } }
        PAR_END
    }
}

__device__ __forceinline__ void ph_cvt(const P& p, const float* src, bf16* dst, long n) {
    PAR_BEGIN
        for (long i = ((long)BIDX * NTHR + tid) * 8; i < n; i += (long)GDIM_OF(p) * NTHR * 8) st_bf8(dst + i, ld_f8(src + i));
    PAR_END
}

__device__ __forceinline__ void ph_tables(const P& p) {
    PAR_BEGIN
        const long gt = (long)BIDX * NTHR + tid, gs = (long)GDIM_OF(p) * NTHR;
        for (long i = gt; i < 2 * (NB * 2 * NCP / 256); i += gs) WSP(int, O_CMPTE)[i] = (i >= NB * 2 * NCP / 256) ? 1 : 0;
        for (long i = gt; i < 64 * 512; i += gs) {
            const int sl = (int)(i >> 9), which = (int)((i >> 8) & 1), c = (int)(i & 255);
            const float* pos = p.in[which ? I_POSV : I_POSK]; const float* w1 = p.in[which ? I_VW1 : I_KW1];
            float s = 0.f; for (int jx = 32 * sl; jx < 32 * sl + 32; ++jx) s += pos[jx] * w1[(long)jx * 256 + c];
            WSP(float, O_BIASP)[i] = s;
        }
        for (long i = gt; i < (long)S * 8; i += gs) { const int jx = (int)(i & 7), sp = (int)(i >> 3); const float inv = powf(500000.0f, -(float)jx / 8.0f), ang = (float)sp * inv;
            WSP(float, O_ROPE)[i * 2] = cosf(ang); WSP(float, O_ROPE)[i * 2 + 1] = sinf(ang); }
        for (long i = gt; i < (long)NG * 64; i += gs) {
            const int g = (int)(i >> 6);
            const float lre = p.in[I_LRE][i], lim = p.in[I_LIM][i], step = expf(p.in[I_LOGDT][g]);
            const float mag = expf(lre * step), are = mag * cosf(lim * step), aim = mag * sinf(lim * step);
            const float den = lre * lre + lim * lim;
            const float zre = ((are - 1.0f) * lre + aim * lim) / den, zim = (aim * lre - (are - 1.0f) * lim) / den;
            WSP(float, O_ABAR)[i * 2] = are; WSP(float, O_ABAR)[i * 2 + 1] = aim;
            const int ps = (int)(i & 63);
            for (int h = 0; h < 16; ++h) { const float br = p.in[I_BRE][i * 16 + h], bi = p.in[I_BIM][i * 16 + h]; const float bbr = zre * br - zim * bi, bbi = zre * bi + zim * br;
                WSP(float, O_BBAR)[(i * 16 + h) * 2] = bbr; WSP(float, O_BBAR)[(i * 16 + h) * 2 + 1] = bbi;
                WSP(bf16, O_S5BT)[((long)g * 128 + ps) * 16 + h] = f2bf(bbr); WSP(bf16, O_S5BT)[((long)g * 128 + 64 + ps) * 16 + h] = f2bf(bbi);
                WSP(bf16, O_S5CT)[((long)g * 32 + h) * 128 + ps] = f2bf(p.in[I_CRE][((long)g * 16 + h) * 64 + ps]); WSP(bf16, O_S5CT)[((long)g * 32 + h) * 128 + 64 + ps] = f2bf(-p.in[I_CIM][((long)g * 16 + h) * 64 + ps]);
                WSP(bf16, O_S5CT)[((long)g * 32 + 16 + h) * 128 + ps] = 0; WSP(bf16, O_S5CT)[((long)g * 32 + 16 + h) * 128 + 64 + ps] = 0; }
            { float* ap = WSP(float, O_S5AP) + i * 8; const float a2r = are * are - aim * aim, a2i = 2.f * are * aim, a3r = a2r * are - a2i * aim, a3i = a2r * aim + a2i * are, a4r = a2r * a2r - a2i * a2i, a4i = 2.f * a2r * a2i;
              ap[0] = are; ap[1] = aim; ap[2] = a2r; ap[3] = a2i; ap[4] = a3r; ap[5] = a3i; ap[6] = a4r; ap[7] = a4i; }
        }
    PAR_END
}

__device__ __forceinline__ void ph_bias_finish(const P& p) {
    PAR_BEGIN
        for (long i = (long)BIDX * NTHR + tid; i < 512; i += (long)GDIM_OF(p) * NTHR) { float s = 0.f; for (int sl = 0; sl < 64; ++sl) s += WSP(float, O_BIASP)[sl * 512 + i]; WSP(float, O_BIASK)[i] = s; }
    PAR_END
}
__device__ __forceinline__ void ph_rope(const P& p) {
    PAR_BEGIN
        const long rows_q = (long)NB * 8 * S, rows_k = (long)NB * 2 * S, total = rows_q + 3 * rows_k;
        for (long i = (long)BIDX * NTHR + tid; i < total; i += (long)GDIM_OF(p) * NTHR) {
            long row = i; bf16* base;
            if (row < rows_q) base = WSP(bf16, A_QB);
            else { row -= rows_q; const int w = (int)(row / rows_k); row -= (long)w * rows_k; base = WSP(bf16, w == 0 ? A_KC : (w == 1 ? A_KS : A_KW)); }
            const int sp = (int)(row % S); const float* cs = WSP(float, O_ROPE) + (long)sp * 16;
            bf16* r = base + row * 64; const f8 x1 = ld_bf8(r), x2 = ld_bf8(r + 8), t0 = ld_f8(cs), t1 = ld_f8(cs + 8);
            f8 o1, o2;
            for (int jx = 0; jx < 8; ++jx) { const float c = jx < 4 ? t0.v[2 * jx] : t1.v[2 * jx - 8], sn = jx < 4 ? t0.v[2 * jx + 1] : t1.v[2 * jx - 7];
                o1.v[jx] = x1.v[jx] * c - x2.v[jx] * sn; o2.v[jx] = x2.v[jx] * c + x1.v[jx] * sn; }
            st_bf8(r, o1); st_bf8(r + 8, o2);
        }
    PAR_END
}

__device__ __forceinline__ void ph_cmpw2(const P& p) {
    PAR_BEGIN
        const long rows = (long)NB * 2 * NCP, total = rows * 64 * 2;
        for (long i = (long)BIDX * NTHR + tid; i < total; i += (long)GDIM_OF(p) * NTHR) {
            const int which = (int)(i / (rows * 64)); const long r = (i / 64) % rows; const int d = (int)(i & 63);
            const bf16* hc = WSP(bf16, which ? A_HCV : A_HCK) + r * 256; const float* w2 = p.in[which ? I_VW2 : I_KW2];
            float s = 0.f; for (int c = 0; c < 256; ++c) s += bf2f(hc[c]) * w2[c * 64 + d];
            WSP(bf16, which ? A_VCMP : A_KCMP)[r * 64 + d] = f2bf(s);
        }
    PAR_END
}

__device__ __forceinline__ void ph_sb(const P& p) {
    PAR_BEGIN
        const bf16* QA = WSP(bf16, A_QA); const bf16* KA = WSP(bf16, A_KA); const bf16* VA = WSP(bf16, A_VA); bf16* ATT = WSP(bf16, A_ATT);
        for (long gq = (long)BIDX * NTHR + tid; gq < (long)NB * 8 * S; gq += (long)GDIM_OF(p) * NTHR) {
            const int t = (int)(gq % S); const long bh = gq / S; const int h = (int)(bh & 7); const long b = bh >> 3;
            float q[64], acc[64];
#pragma unroll
            for (int d = 0; d < 64; ++d) { q[d] = bf2f(QA[gq * 64 + d]) * (0.125f / QSCALE); acc[d] = 0.f; }
            float run = 0.f;
            for (int s = t - 1; s >= 0; --s) {
                const bf16* kr = KA + (bh * S + s) * 64; const bf16* vr = VA + (bh * S + s) * 64;
                float z = 0.f;
#pragma unroll
                for (int d = 0; d < 64; ++d) z += q[d] * bf2f(kr[d]);
                const float l1p = log1pf(expf(-fabsf(z)));
                const float sp_pos = fmaxf(z, 0.f) + l1p, sp_neg = fmaxf(-z, 0.f) + l1p;
                const float w = expf(run - sp_neg);
#pragma unroll
                for (int d = 0; d < 64; ++d) acc[d] += w * bf2f(vr[d]);
                run -= sp_pos;
                if (run < -120.f) break;
            }
            bf16* o = ATT + (b * S + t) * 1024 + h * 64;
#pragma unroll
            for (int d = 0; d < 64; ++d) o[d] = f2bf(acc[d]);
        }
    PAR_END
}

constexpr int NSA_LDS_PER = (4 * 64 + 4 * 512 + 4 * 64 + 64 + 64 + 32 + 16 + 16 + 16) * 4;
__device__ __forceinline__ void ph_nsa(const P& p, unsigned char* lds) {
    const int per = NTHR / 256; const long items = (long)NB * 2 * S;
    const bf16* QB = WSP(bf16, A_QB); bf16* ATT = WSP(bf16, A_ATT);
    const bf16* KCMP = WSP(bf16, A_KCMP); const bf16* VCMP = WSP(bf16, A_VCMP);
    for (long it0 = (long)BIDX * per; it0 < items; it0 += (long)GDIM_OF(p) * per) {
#define NSA_SETUP const int sub = tid >> 8, lt = tid & 255; const long item = it0 + sub; const bool act = item < items; \
        const int t = act ? (int)(item % S) : 0; const long bg = act ? item / S : 0; const int g = (int)(bg & 1); const long b = bg >> 1; \
        float* L = (float*)(lds + (size_t)sub * NSA_LDS_PER); float* qs = L; float* sc = qs + 256; float* osum = sc + 2048; float* pm = osum + 256; float* pl = pm + 64; \
        float* imp = pl + 64; int* sel = (int*)(imp + 32); float* st = (float*)(sel + 16); float* gts = st + 16; (void)lt; (void)g; (void)b; (void)t; (void)qs; (void)sc; (void)osum; (void)pm; (void)pl; (void)imp; (void)sel; (void)st; (void)gts;
#define NSA_SOFTMAX(NEXPR) \
        PAR_BEGIN NSA_SETUP if (act && lt < 64) { const int r = lt >> 4, part = lt & 15, n = (NEXPR); float m = -3e38f; \
            for (int jx = part; jx < n; jx += 16) m = fmaxf(m, sc[r * 512 + jx]); float l = 0.f; \
            for (int jx = part; jx < n; jx += 16) { const float v = sc[r * 512 + jx]; if (v > -1e29f) l += expf(v - m); } pm[lt] = m; pl[lt] = l; } PAR_END \
        PAR_BEGIN NSA_SETUP if (act && lt < 4) { float m = -3e38f; for (int q2 = 0; q2 < 16; ++q2) m = fmaxf(m, pm[lt * 16 + q2]); float l = 0.f; \
            for (int q2 = 0; q2 < 16; ++q2) { const float pmv = pm[lt * 16 + q2]; if (pmv > -1e29f) l += pl[lt * 16 + q2] * expf(pmv - m); } st[lt] = m; st[4 + lt] = l; } PAR_END \
        PAR_BEGIN NSA_SETUP if (act) { const int n = (NEXPR); for (int idx = lt; idx < 4 * n; idx += 256) { const int r = idx / n, jx = idx % n; const float v = sc[r * 512 + jx]; \
            const float l = st[4 + r]; sc[r * 512 + jx] = (v > -1e29f && l > 0.f) ? expf(v - st[r]) / l : 0.f; } } PAR_END
        PAR_BEGIN NSA_SETUP
            if (act) { const int r = lt >> 6, d = lt & 63; qs[lt] = bf2f(QB[((b * 8 + g * 4 + r) * S + t) * 64 + d]) * (0.125f / QSCALE); osum[lt] = 0.f;
                if (lt < 12) gts[lt] = sigmoidf_(WSP(float, A_GRAW)[(b * S + t) * 24 + g * 12 + lt]); }
        PAR_END
        PAR_BEGIN NSA_SETUP
            if (act) for (int idx = lt; idx < 4 * NCP; idx += 256) { const int r = idx / NCP, n = idx % NCP; float v = -1e30f;
                if (n < NCMP && 16 * n + 31 <= t) { const bf16* kr = KCMP + (bg * NCP + n) * 64; v = 0.f; for (int d = 0; d < 64; ++d) v += qs[r * 64 + d] * bf2f(kr[d]); }
                sc[r * 512 + n] = v; }
        PAR_END
        NSA_SOFTMAX(NCP)
        PAR_BEGIN NSA_SETUP
            if (act) { const int r = lt >> 6, d = lt & 63; float o = 0.f; for (int n = 0; n < NCMP; ++n) o += sc[r * 512 + n] * bf2f(VCMP[(bg * NCP + n) * 64 + d]); osum[lt] += gts[r * 3 + 0] * o; }
        PAR_END
        PAR_BEGIN NSA_SETUP
            if (act && lt < 32) { float s = 0.f; if (lt < NSLC) { const int n0 = 4 * lt - 1 < 0 ? 0 : 4 * lt - 1, n1 = 4 * lt + 3 > NCMP - 1 ? NCMP - 1 : 4 * lt + 3;
                for (int r = 0; r < 4; ++r) for (int n = n0; n <= n1; ++n) s += sc[r * 512 + n]; } imp[lt] = s; }
        PAR_END
        PAR_BEGIN NSA_SETUP
            if (act && lt == 0) { const int cur = t >> 6;
                for (int m = 0; m < NSLC; ++m) { const bool valid = m <= cur, forced = (m == 0) || (valid && m > cur - 2); imp[m] = forced ? imp[m] + 1e4f : (valid ? imp[m] : -1e30f); }
                int ns = 0;
                for (int i = 0; i < 8; ++i) { int best = 0; float bv = -3.4e38f; for (int m = 0; m < NSLC; ++m) if (imp[m] > bv) { bv = imp[m]; best = m; } imp[best] = -3.4e38f; if (best <= cur) sel[ns++] = best; }
                sel[8] = ns; }
        PAR_END
        PAR_BEGIN NSA_SETUP
            if (act) { const int n = sel[8] * 64; const bf16* KS = WSP(bf16, A_KS);
                for (int idx = lt; idx < 4 * n; idx += 256) { const int r = idx / n, jx = idx % n, pos = sel[jx >> 6] * 64 + (jx & 63); float v = -1e30f;
                    if (pos <= t) { const bf16* kr = KS + (bg * S + pos) * 64; v = 0.f; for (int d = 0; d < 64; ++d) v += qs[r * 64 + d] * bf2f(kr[d]); }
                    sc[r * 512 + jx] = v; } }
        PAR_END
        NSA_SOFTMAX(sel[8] * 64)
        PAR_BEGIN NSA_SETUP
            if (act) { const int r = lt >> 6, d = lt & 63, n = sel[8] * 64; const bf16* VS = WSP(bf16, A_VS); float o = 0.f;
                for (int jx = 0; jx < n; ++jx) { const int pos = sel[jx >> 6] * 64 + (jx & 63); o += sc[r * 512 + jx] * bf2f(VS[(bg * S + pos) * 64 + d]); }
                osum[lt] += gts[r * 3 + 1] * o; }
        PAR_END
        PAR_BEGIN NSA_SETUP
            if (act) { const bf16* KW = WSP(bf16, A_KW);
                for (int idx = lt; idx < 4 * 512; idx += 256) { const int r = idx >> 9, jx = idx & 511, pos = t - 511 + jx; float v = -1e30f;
                    if (pos >= 0) { const bf16* kr = KW + (bg * S + pos) * 64; v = 0.f; for (int d = 0; d < 64; ++d) v += qs[r * 64 + d] * bf2f(kr[d]); }
                    sc[r * 512 + jx] = v; } }
        PAR_END
        NSA_SOFTMAX(512)
        PAR_BEGIN NSA_SETUP
            if (act) { const int r = lt >> 6, d = lt & 63; const bf16* VW = WSP(bf16, A_VW); float o = 0.f;
                for (int jx = 0; jx < 512; ++jx) { const int pos = t - 511 + jx; if (pos >= 0) o += sc[r * 512 + jx] * bf2f(VW[(bg * S + pos) * 64 + d]); }
                osum[lt] += gts[r * 3 + 2] * o;
                ATT[(b * S + t) * 1024 + 512 + (g * 4 + r) * 64 + d] = f2bf(osum[lt]); }
        PAR_END
    }
}

constexpr int S5_LDS_PER = (8 * 128 + 8 * 16 + 128) * 4;
__device__ __forceinline__ void ph_s5(const P& p, unsigned char* lds) {
    const int per = NTHR / 64; const long items = (long)NB * NG;
    const bf16* U = WSP(bf16, C_U); bf16* YS = WSP(bf16, C_YS);
    const float* ABAR = WSP(float, O_ABAR); const float* BBAR = WSP(float, O_BBAR);
    for (long it0 = (long)BIDX * per; it0 < items; it0 += (long)GDIM_OF(p) * per) {
#define S5_SETUP const int sub = tid >> 6, lt = tid & 63; const long item = it0 + sub; const bool act = item < items; const int g = act ? (int)(item % NG) : 0; const long b = act ? item / NG : 0; \
        float* L = (float*)(lds + (size_t)sub * S5_LDS_PER); float* hbuf = L; float* ubuf = hbuf + 1024; float* hst = ubuf + 128; (void)lt; (void)g; (void)b; (void)hbuf; (void)ubuf; (void)hst;
        PAR_BEGIN S5_SETUP if (act) { hst[lt] = 0.f; hst[64 + lt] = 0.f; } PAR_END
        for (int t0 = 0; t0 < S; t0 += 8) {
            PAR_BEGIN S5_SETUP
                if (act) for (int e = lt; e < 128; e += 64) ubuf[e] = bf2f(U[(b * S + t0 + (e >> 4)) * DM + g * 16 + (e & 15)]);
            PAR_END
            PAR_BEGIN S5_SETUP
                if (act) { const long gp = (long)g * 64 + lt; const float are = ABAR[gp * 2], aim = ABAR[gp * 2 + 1]; float bre[16], bim[16];
#pragma unroll
                    for (int h = 0; h < 16; ++h) { bre[h] = BBAR[(gp * 16 + h) * 2]; bim[h] = BBAR[(gp * 16 + h) * 2 + 1]; }
                    float hr = hst[lt], hi = hst[64 + lt];
                    for (int i = 0; i < 8; ++i) { float ur = 0.f, ui = 0.f;
#pragma unroll
                        for (int h = 0; h < 16; ++h) { const float u = ubuf[i * 16 + h]; ur += u * bre[h]; ui += u * bim[h]; }
                        const float nr = are * hr - aim * hi + ur, ni = are * hi + aim * hr + ui; hr = nr; hi = ni;
                        hbuf[i * 128 + lt] = hr; hbuf[i * 128 + 64 + lt] = hi; }
                    hst[lt] = hr; hst[64 + lt] = hi; }
            PAR_END
            PAR_BEGIN S5_SETUP
                if (act) { const int hh = lt & 15, iq = lt >> 4; const float* cre = p.in[I_CRE] + ((long)g * 16 + hh) * 64; const float* cim = p.in[I_CIM] + ((long)g * 16 + hh) * 64;
                    const float dsk = p.in[I_DSK][g * 16 + hh];
                    for (int i = iq * 2; i < iq * 2 + 2; ++i) { float y = 0.f;
                        for (int pp = 0; pp < 64; ++pp) y += cre[pp] * hbuf[i * 128 + pp] - cim[pp] * hbuf[i * 128 + 64 + pp];
                        y += dsk * ubuf[i * 16 + hh];
                        YS[(b * S + t0 + i) * DM + g * 16 + hh] = f2bf(gelu_tanh(y)); } }
            PAR_END
        }
    }
}

__device__ __forceinline__ void ph_route(const P& p, const int layer, const int chunk, unsigned char* lds) {
    const int NT_ = 256; float* rb = (float*)lds;
    int* hist = (int*)(rb + (size_t)NT_ * 72); int* base = hist + 64; int* lr = base + 64;
    const float* LOGIT = WSP(float, B_LOGIT); const float* rbias = p.in[layer == 0 ? I_L0_RBIAS : I_L1_RBIAS];
    int* gcnt = WSP(int, O_CNT) + (layer * NCH + chunk) * 64;
    const long tbeg = (long)chunk * TC;
    for (long t0 = (long)BIDX * NT_; t0 < TC; t0 += (long)GDIM_OF(p) * NT_) {
        PAR_BEGIN if (tid < 64) hist[tid] = 0; PAR_END
        PAR_BEGIN
            const long tl = t0 + tid;
            if (tid < NT_ && tl < TC) { const long tok = tbeg + tl; float* sb = rb + (size_t)tid * 72; float* gs = sb + 64;
                for (int e = 0; e < 64; ++e) sb[e] = sigmoidf_(LOGIT[tok * 64 + e]) + rbias[e];
                for (int gq = 0; gq < 8; ++gq) { float m1 = -3e38f, m2 = -3e38f; for (int jx = 0; jx < 8; ++jx) { const float v = sb[gq * 8 + jx]; if (v > m1) { m2 = m1; m1 = v; } else if (v > m2) m2 = v; } gs[gq] = m1 + m2; }
                unsigned keep = 0u;
                for (int i = 0; i < 4; ++i) { int best = 0; float bv = -3.4e38f; for (int gq = 0; gq < 8; ++gq) if (!((keep >> gq) & 1u) && gs[gq] > bv) { bv = gs[gq]; best = gq; } keep |= 1u << best; }
                unsigned long long taken = 0ull; int ei[6]; float gv[6]; float gsum = 0.f;
#pragma unroll
                for (int i = 0; i < 6; ++i) { int best = 0; float bv = -3.4e38f;
                    for (int e = 0; e < 64; ++e) if (((keep >> (e >> 3)) & 1u) && !((taken >> e) & 1ull) && sb[e] > bv) { bv = sb[e]; best = e; }
                    taken |= 1ull << best; ei[i] = best; gv[i] = sb[best] - rbias[best]; gsum += gv[i]; }
#pragma unroll
                for (int i = 0; i < 6; ++i) { WSP(int, B_EIDX)[tok * 6 + i] = ei[i]; WSP(float, B_GATE)[tok * 6 + i] = gv[i] / gsum * 2.5f; lr[tid * 6 + i] = ATOMIC_ADD(&hist[ei[i]], 1); }
            }
        PAR_END
        PAR_BEGIN if (tid < 64) base[tid] = ATOMIC_ADD(&gcnt[tid], hist[tid]); PAR_END
        PAR_BEGIN
            const long tl = t0 + tid;
            if (tid < NT_ && tl < TC) { const long tok = tbeg + tl; for (int i = 0; i < 6; ++i) WSP(int, B_POS)[tok * 6 + i] = base[WSP(int, B_EIDX)[tok * 6 + i]] + lr[tid * 6 + i]; }
        PAR_END
    }
}

__device__ __forceinline__ void ph_offsets(const P& p, const int layer, const int chunk) {
    if (BIDX == 0) {
    const int* gcnt = WSP(int, O_CNT) + (layer * NCH + chunk) * 64; int* ps = WSP(int, O_PADSTART); int* te = WSP(int, O_TILEE);
    PAR_BEGIN if (tid == 0) { int acc = 0; for (int e = 0; e < 64; ++e) { ps[e] = acc; acc += (gcnt[e] + 255) / 256 * 256; } ps[64] = acc; } PAR_END
    PAR_BEGIN for (int i = tid; i < MOE_TILES; i += NTHR) { const int r = i * 256; int e = -1; if (r < ps[64]) { e = 0; while (ps[e + 1] <= r) ++e; } te[i] = e; } PAR_END
    }
}
__device__ __forceinline__ void ph_clear_rows(const P& p) {
    PAR_BEGIN for (long i = (long)BIDX * NTHR + tid; i < MOE_ROWS; i += (long)GDIM_OF(p) * NTHR) { WSP(int, B_ROWTOK)[i] = 0; WSP(float, B_ROWGATE)[i] = 0.f; } PAR_END
}
__device__ __forceinline__ void ph_scatter(const P& p, const int chunk) {
    PAR_BEGIN
        const int* ps = WSP(int, O_PADSTART);
        for (long i = (long)BIDX * NTHR + tid; i < (long)TC * 6; i += (long)GDIM_OF(p) * NTHR) { const long gi = (long)chunk * TC * 6 + i;
            const int e = WSP(int, B_EIDX)[gi], dest = ps[e] + WSP(int, B_POS)[gi];
            WSP(int, B_ROWTOK)[dest] = (int)(gi / 6); WSP(float, B_ROWGATE)[dest] = WSP(float, B_GATE)[gi]; WSP(int, B_POS)[gi] = dest; }
    PAR_END
}


__device__ __forceinline__ void ph_place(const P& p, const int layer, const int chunk, unsigned char* lds) {
    const int* gcnt = WSP(int, O_CNT) + (layer * NCH + chunk) * 64; int* psl = (int*)lds;
    PAR_BEGIN if (tid == 0) { int acc = 0; for (int e = 0; e < 64; ++e) { const int c = gcnt[e]; psl[e] = acc; psl[65 + e] = c; acc += (c + 255) / 256 * 256; } psl[64] = acc; } PAR_END
    PAR_BEGIN
        for (long i = (long)BIDX * NTHR + tid; i < (long)TC * 6; i += (long)GDIM_OF(p) * NTHR) { const long gi = (long)chunk * TC * 6 + i;
            const int e = WSP(int, B_EIDX)[gi], dest = psl[e] + WSP(int, B_POS)[gi];
            WSP(int, B_ROWTOK)[dest] = (int)(gi / 6); WSP(float, B_ROWGATE)[dest] = WSP(float, B_GATE)[gi]; WSP(int, B_POS)[gi] = dest; }
        for (long i = (long)BIDX * NTHR + tid; i < 64 * 256; i += (long)GDIM_OF(p) * NTHR) { const int e = (int)(i >> 8), k = (int)(i & 255), row = psl[e] + psl[65 + e] + k;
            if (row < psl[e + 1]) { WSP(int, B_ROWTOK)[row] = 0; WSP(float, B_ROWGATE)[row] = 0.f; } }
        if (BIDX == 0) { int* ps = WSP(int, O_PADSTART); int* te = WSP(int, O_TILEE);
            for (int i = tid; i < 65; i += NTHR) ps[i] = psl[i];
            for (int i = tid; i < MOE_TILES; i += NTHR) { const int r = i * 256; int e = -1; if (r < psl[64]) { e = 0; while (psl[e + 1] <= r) ++e; } te[i] = e; } }
    PAR_END
}
struct LnJob { const float* pre; const bf16* preb; const unsigned char* y; const int* pos; const float* gate; const float* g; const float* b; bf16* obf; float* of32; unsigned char* of8; long t_beg, t_cnt; int grid, pad; };
constexpr int LN_LDS_PER = (DM + 64) * 4;
__device__ __forceinline__ void ph_ln(const LnJob j, unsigned char* lds) {
    const int per = NTHR / 256;
    for (long r0 = (long)BIDX * per; r0 < j.t_cnt; r0 += (long)GDIM_OF(j) * per) {
#define LN_SETUP const int sub = tid >> 8, lt = tid & 255; const long rl = r0 + sub; const bool act = rl < j.t_cnt; const long tok = j.t_beg + (act ? rl : 0); \
        float* vals = (float*)(lds + (size_t)sub * LN_LDS_PER); float* red = vals + DM; (void)lt; (void)tok; (void)red;
        PAR_BEGIN LN_SETUP
            if (act) for (int c = lt; c < DM; c += 256) { float v = j.preb ? bf2f(j.preb[tok * DM + c]) : j.pre[tok * DM + c]; if (j.y) { float ys = 0.f; for (int k = 0; k < 6; ++k) ys += fp82f(j.y[(long)j.pos[tok * 6 + k] * DM + c]); v += ys * Y8_INV; } vals[c] = v; }
        PAR_END
        PAR_BEGIN LN_SETUP if (act && lt < 16) { float s = 0.f; for (int c = lt * (DM / 16); c < (lt + 1) * (DM / 16); ++c) s += vals[c]; red[lt] = s; } PAR_END
        PAR_BEGIN LN_SETUP if (act && lt == 0) { float s = 0.f; for (int i = 0; i < 16; ++i) s += red[i]; red[32] = s / (float)DM; } PAR_END
        PAR_BEGIN LN_SETUP if (act && lt < 16) { const float mu = red[32]; float s = 0.f; for (int c = lt * (DM / 16); c < (lt + 1) * (DM / 16); ++c) { const float d = vals[c] - mu; s += d * d; } red[lt] = s; } PAR_END
        PAR_BEGIN LN_SETUP if (act && lt == 0) { float s = 0.f; for (int i = 0; i < 16; ++i) s += red[i]; red[33] = 1.0f / sqrtf(s / (float)DM + LN_EPS); } PAR_END
        PAR_BEGIN LN_SETUP
            if (act) { const float mu = red[32], rs = red[33];
                for (int c = lt; c < DM; c += 256) { const float o = (vals[c] - mu) * rs * j.g[c] + j.b[c]; if (j.obf) j.obf[tok * DM + c] = f2bf(o); else j.of32[tok * DM + c] = o; } }
        PAR_END
    }
}


#ifndef HOST_EMU
constexpr float W8_SCALE = 64.0f, A8_SCALE = 8.0f, F8_ACC_INV = 1.0f / (W8_SCALE * A8_SCALE);
__device__ __forceinline__ float clamp8(float x) { return __builtin_amdgcn_fmed3f(x, -448.0f, 448.0f); }
__device__ __forceinline__ unsigned pk4_fp8(float a, float b, float c, float d) { int w = __builtin_amdgcn_cvt_pk_fp8_f32(clamp8(a), clamp8(b), 0, false); w = __builtin_amdgcn_cvt_pk_fp8_f32(clamp8(c), clamp8(d), w, true); return (unsigned)w; }
__device__ __forceinline__ float wave_sum(float v) {
    v += __builtin_bit_cast(float, __builtin_amdgcn_mov_dpp(__builtin_bit_cast(int, v), 0xB1, 0xf, 0xf, true));
    v += __builtin_bit_cast(float, __builtin_amdgcn_mov_dpp(__builtin_bit_cast(int, v), 0x4E, 0xf, 0xf, true));
    v += __builtin_bit_cast(float, __builtin_amdgcn_ds_swizzle(__builtin_bit_cast(int, v), 0x101F));
    v += __builtin_bit_cast(float, __builtin_amdgcn_ds_swizzle(__builtin_bit_cast(int, v), 0x201F));
    v += __builtin_bit_cast(float, __builtin_amdgcn_ds_swizzle(__builtin_bit_cast(int, v), 0x401F));
    auto rr = __builtin_amdgcn_permlane32_swap(__float_as_uint(v), __float_as_uint(v), false, false);
    return __uint_as_float(rr[0]) + __uint_as_float(rr[1]); }
__device__ __forceinline__ void ph_ln2(const LnJob j) {
    static_assert(DM == 1024, "ln2: a lane owns 16 consecutive columns; a wave takes two adjacent rows per pass (their loads overlap)");
    int tid = threadIdx.x; asm volatile("" : "+v"(tid));
    const int lane = tid & 63, wid = __builtin_amdgcn_readfirstlane(tid >> 6);
    for (long r = ((long)blockIdx.x * 8 + wid) * 2; r < j.t_cnt; r += (long)j.grid * 16) {
        int c0 = lane * 16; asm volatile("" : "+v"(c0));
        const long tok0 = j.t_beg + r; float v[2][16]; int yrow[2][6];
#pragma unroll
        for (int u = 0; u < 2; ++u) { const long o = (tok0 + u) * DM + c0;
            if (j.y) {
#pragma unroll
                for (int k = 0; k < 6; ++k) yrow[u][k] = j.pos[(tok0 + u) * 6 + k]; }
            if (j.preb) { const f8 a = ld_bf8(j.preb + o), b = ld_bf8(j.preb + o + 8);
#pragma unroll
                for (int q = 0; q < 8; ++q) { v[u][q] = a.v[q]; v[u][8 + q] = b.v[q]; } }
            else { const f8 a = ld_f8(j.pre + o), b = ld_f8(j.pre + o + 8);
#pragma unroll
                for (int q = 0; q < 8; ++q) { v[u][q] = a.v[q]; v[u][8 + q] = b.v[q]; } } }
        if (j.y) {
#pragma unroll
            for (int kb = 0; kb < 6; kb += 3) {
                uint4 w[2][3]; float gk[2][3];
#pragma unroll
                for (int u = 0; u < 2; ++u)
#pragma unroll
                    for (int k = 0; k < 3; ++k) { w[u][k] = *(const uint4*)(j.y + (long)yrow[u][kb + k] * DM + c0); gk[u][k] = j.gate ? j.gate[(tok0 + u) * 6 + kb + k] * Y8_INV : Y8_INV; }
#pragma unroll
                for (int u = 0; u < 2; ++u)
#pragma unroll
                    for (int k = 0; k < 3; ++k) { const unsigned ww[4] = {w[u][k].x, w[u][k].y, w[u][k].z, w[u][k].w};
#pragma unroll
                        for (int q = 0; q < 4; ++q) { const auto lo = __builtin_amdgcn_cvt_pk_f32_fp8((int)ww[q], false), hi2 = __builtin_amdgcn_cvt_pk_f32_fp8((int)ww[q], true);
                            v[u][4 * q] += lo[0] * gk[u][k]; v[u][4 * q + 1] += lo[1] * gk[u][k]; v[u][4 * q + 2] += hi2[0] * gk[u][k]; v[u][4 * q + 3] += hi2[1] * gk[u][k]; } }
            }
        }
        int c0b = lane * 16; asm volatile("" : "+v"(c0b));
        const f8 g0 = ld_f8(j.g + c0b), g1 = ld_f8(j.g + c0b + 8), b0 = ld_f8(j.b + c0b), b1 = ld_f8(j.b + c0b + 8);
#pragma unroll
        for (int u = 0; u < 2; ++u) {
            float s = 0.f;
#pragma unroll
            for (int i = 0; i < 16; ++i) s += v[u][i];
            const float mu = wave_sum(s) * (1.0f / (float)DM);
            float q2 = 0.f;
#pragma unroll
            for (int i = 0; i < 16; ++i) { const float d = v[u][i] - mu; q2 += d * d; }
            const float rs = 1.0f / sqrtf(wave_sum(q2) * (1.0f / (float)DM) + LN_EPS);
            f8 o0, o1;
#pragma unroll
            for (int q = 0; q < 8; ++q) { o0.v[q] = (v[u][q] - mu) * rs * g0.v[q] + b0.v[q]; o1.v[q] = (v[u][8 + q] - mu) * rs * g1.v[q] + b1.v[q]; }
            const long o = (tok0 + u) * DM + c0;
            if (j.obf) { st_bf8(j.obf + o, o0); st_bf8(j.obf + o + 8, o1); } else { st_f8(j.of32 + o, o0); st_f8(j.of32 + o + 8, o1); }
            if (j.of8) { uint4 w8; w8.x = pk4_fp8(o0.v[0] * A8_SCALE, o0.v[1] * A8_SCALE, o0.v[2] * A8_SCALE, o0.v[3] * A8_SCALE); w8.y = pk4_fp8(o0.v[4] * A8_SCALE, o0.v[5] * A8_SCALE, o0.v[6] * A8_SCALE, o0.v[7] * A8_SCALE);
                w8.z = pk4_fp8(o1.v[0] * A8_SCALE, o1.v[1] * A8_SCALE, o1.v[2] * A8_SCALE, o1.v[3] * A8_SCALE); w8.w = pk4_fp8(o1.v[4] * A8_SCALE, o1.v[5] * A8_SCALE, o1.v[6] * A8_SCALE, o1.v[7] * A8_SCALE); *(uint4*)(j.of8 + o) = w8; }
        }
    }
}
#define ph_ln(j, lds) ph_ln2(j)
#endif

struct GemmArgs { const bf16* A; const bf16* Bt; const int* rowidx; const int* tile_e; const int* m_rt; long lda; long b_estride; int M, N, K, grid; };
constexpr int GEMM_LDS = 131072, GEMM_TE_LDS = 8192;
static_assert(MOE_TILES <= 2048, "tile table");
struct EpiProj0 { static constexpr bool HAS_LD = false; unsigned char* ws;
    __device__ __forceinline__ void oct(int row, int col, const f8& v, const f8&) const {
        if (col >= PROJ_N) return; const long b = row / S, s = row % S;
        if (col < 2048) { const int seg = col >> 9, h = (col >> 6) & 7, d = col & 63; bf16* base = (bf16*)(ws + A_QA + (size_t)seg * HB); const float sc = (seg == 3 || seg == 0) ? QSCALE : 1.0f;
            f8 o; for (int i = 0; i < 8; ++i) o.v[i] = v.v[i] * sc; st_bf8(base + ((b * 8 + h) * S + s) * 64 + d, o); }
        else if (col < 2816) { const int c2 = col - 2048, seg = c2 >> 7, g = (c2 >> 6) & 1, d = c2 & 63; bf16* base = (bf16*)(ws + A_KC + (size_t)seg * GB); st_bf8(base + ((b * 2 + g) * S + s) * 64 + d, v); }
        else st_f8((float*)(ws + A_GRAW) + (long)row * 24 + (col - 2816), v); } };
#ifndef HOST_EMU
struct EpiProj0R { static constexpr bool HAS_LD = false; unsigned char* ws; float asc;
    __device__ __forceinline__ void oct(int row, int col, const f8& v0, const f8&) const {
        if (col >= PROJ_N) return; const long b = row / S, s = row % S;
        f8 v; for (int i = 0; i < 8; ++i) v.v[i] = v0.v[i] * asc;
        f8 x = v;
        const bool rs = (col >= 1536 && col < 2048) || (col >= 2048 && col < 2816 && ((((col - 2048) >> 7) & 1) == 0));
        if (rs && (col & 32) == 0) {
            f8 pv; for (int i = 0; i < 8; ++i) pv.v[i] = __builtin_bit_cast(float, __builtin_amdgcn_ds_swizzle(__builtin_bit_cast(int, v.v[i]), 0x401F));
            if ((col & 16) == 0) { const float* cs = (const float*)(ws + O_ROPE) + s * 16; const f8 t0 = ld_f8(cs), t1 = ld_f8(cs + 8); const float sg = (col & 8) ? 1.0f : -1.0f;
                for (int jx = 0; jx < 8; ++jx) { const float c = jx < 4 ? t0.v[2 * jx] : t1.v[2 * jx - 8], sn = jx < 4 ? t0.v[2 * jx + 1] : t1.v[2 * jx - 7]; x.v[jx] = v.v[jx] * c + sg * pv.v[jx] * sn; } } }
        if (col < 2048) { const int seg = col >> 9, h = (col >> 6) & 7, d = col & 63; bf16* base = (bf16*)(ws + A_QA + (size_t)seg * HB); const float sc = (seg == 3 || seg == 0) ? QSCALE : 1.0f;
            f8 o; for (int i = 0; i < 8; ++i) o.v[i] = x.v[i] * sc; st_bf8(base + ((b * 8 + h) * S + s) * 64 + d, o); }
        else if (col < 2816) { const int c2 = col - 2048, seg = c2 >> 7, g = (c2 >> 6) & 1, d = c2 & 63; bf16* base = (bf16*)(ws + A_KC + (size_t)seg * GB); st_bf8(base + ((b * 2 + g) * S + s) * 64 + d, x); }
        else st_f8((float*)(ws + A_GRAW) + (long)row * 24 + (col - 2816), x); } };
#endif
struct EpiCmp1 { static constexpr bool HAS_LD = true; bf16* out; const float* bias;
    __device__ __forceinline__ f8 ld(int row, int col) const { return ld_f8(bias + (row >= NB * 2 * NCP ? 256 : 0) + col); }
    __device__ __forceinline__ void fin(int row, int col, const f8& v, const f8&, const f8& bv) const { f8 o; for (int i = 0; i < 8; ++i) o.v[i] = gelu_tanh(v.v[i] + bv.v[i]); st_bf8(out + (long)row * 256 + col, o); }
    __device__ __forceinline__ void oct(int row, int col, const f8& v, const f8& v2) const { fin(row, col, v, v2, ld(row, col)); } };
struct EpiCmp2 { static constexpr bool HAS_LD = false; bf16* outk; bf16* outv;
    __device__ __forceinline__ void oct(int row, int col, const f8& v, const f8&) const { if (col < 64) { bf16* o = row >= NB * 2 * NCP ? outv + (long)(row - NB * 2 * NCP) * 64 : outk + (long)row * 64; st_bf8(o + col, v); } } };
struct EpiResF32 { static constexpr bool HAS_LD = true; bf16* out; const float* res; int ld_; float sc = 1.0f;
    __device__ __forceinline__ f8 ld(int row, int col) const { return ld_f8(res + (long)row * ld_ + col); }
    __device__ __forceinline__ void fin(int row, int col, const f8& v, const f8&, const f8& r) const { f8 o; for (int i = 0; i < 8; ++i) o.v[i] = DN_ALPHA * r.v[i] + v.v[i] * sc; st_bf8(out + (long)row * ld_ + col, o); }
    __device__ __forceinline__ void oct(int row, int col, const f8& v, const f8& v2) const { fin(row, col, v, v2, ld(row, col)); } };
template <bool OUT_BF> struct EpiResBfT { static constexpr bool HAS_LD = true; float* out; bf16* outb; const bf16* res; int ld_; float sc = 1.0f;
    __device__ __forceinline__ f8 ld(int row, int col) const { return ld_bf8(res + (long)row * ld_ + col); }
    __device__ __forceinline__ void fin(int row, int col, const f8& v, const f8&, const f8& r) const { f8 o; for (int i = 0; i < 8; ++i) o.v[i] = DN_ALPHA * r.v[i] + v.v[i] * sc;
        if (OUT_BF) st_bf8(outb + (long)row * ld_ + col, o); else st_f8(out + (long)row * ld_ + col, o); }
    __device__ __forceinline__ void oct(int row, int col, const f8& v, const f8& v2) const { fin(row, col, v, v2, ld(row, col)); } };
struct EpiLogit { static constexpr bool HAS_LD = false; float* out;
    __device__ __forceinline__ void oct(int row, int col, const f8& v, const f8&) const { if (col < 64) st_f8(out + (long)row * 64 + col, v); } };
struct EpiSwiglu { static constexpr bool HAS_LD = false; bf16* out;
    __device__ __forceinline__ void oct(int row, int col, const f8& v, const f8& v2) const { if ((col & GU_IL) == 0) { f8 o; for (int i = 0; i < 8; ++i) o.v[i] = siluf_(v.v[i]) * v2.v[i];
        st_bf8(out + (long)row * 256 + (col >> 8) * GU_IL + (col & (GU_IL - 1)), o); } } };
#ifndef HOST_EMU
struct EpiSwiglu8 { static constexpr bool HAS_LD = false; unsigned char* out;
    __device__ __forceinline__ void oct(int row, int col, const f8& v, const f8& v2) const { if ((col & GU_IL) == 0) { float o[8]; for (int i = 0; i < 8; ++i) o[i] = siluf_(v.v[i] * F8_ACC_INV) * (v2.v[i] * (F8_ACC_INV * A8_SCALE));
        uint2 w; w.x = pk4_fp8(o[0], o[1], o[2], o[3]); w.y = pk4_fp8(o[4], o[5], o[6], o[7]); *(uint2*)(out + (long)row * 256 + (col >> 8) * GU_IL + (col & (GU_IL - 1))) = w; } } };
#endif
#ifndef HOST_EMU
struct EpiY8 { static constexpr bool HAS_LD = false; unsigned char* out; int ld_; float sc;
    __device__ __forceinline__ void oct(int row, int col, const f8& v, const f8&) const { const float f = Y8_SCALE * sc;
        uint2 w; w.x = pk4_fp8(v.v[0] * f, v.v[1] * f, v.v[2] * f, v.v[3] * f); w.y = pk4_fp8(v.v[4] * f, v.v[5] * f, v.v[6] * f, v.v[7] * f); *(uint2*)(out + (long)row * ld_ + col) = w; } };
#endif
struct EpiY { static constexpr bool HAS_LD = true; unsigned char* out; const float* rowgate; int ld_; float sc = 1.0f;
    __device__ __forceinline__ f8 ld(int row, int) const { f8 r; r.v[0] = rowgate[row]; for (int i = 1; i < 8; ++i) r.v[i] = 0.f; return r; }
    __device__ __forceinline__ void fin(int row, int col, const f8& v, const f8&, const f8& rg) const { const float gt = rg.v[0] * (Y8_SCALE * sc); unsigned char* o = out + (long)row * ld_ + col;
#ifdef HOST_EMU
        for (int i = 0; i < 8; ++i) o[i] = (unsigned char)f2fp8(v.v[i] * gt);
#else
        int w0 = __builtin_amdgcn_cvt_pk_fp8_f32(v.v[0] * gt, v.v[1] * gt, 0, false); w0 = __builtin_amdgcn_cvt_pk_fp8_f32(v.v[2] * gt, v.v[3] * gt, w0, true);
        int w1 = __builtin_amdgcn_cvt_pk_fp8_f32(v.v[4] * gt, v.v[5] * gt, 0, false); w1 = __builtin_amdgcn_cvt_pk_fp8_f32(v.v[6] * gt, v.v[7] * gt, w1, true);
        uint2 w; w.x = (unsigned)w0; w.y = (unsigned)w1; *(uint2*)o = w;
#endif
    }
    __device__ __forceinline__ void oct(int row, int col, const f8& v, const f8& v2) const { fin(row, col, v, v2, ld(row, col)); } };
struct EpiBf { static constexpr bool HAS_LD = false; bf16* out; int ld; float sc = 1.0f;
    __device__ __forceinline__ void oct(int row, int col, const f8& v, const f8&) const { f8 o; for (int i = 0; i < 8; ++i) o.v[i] = v.v[i] * sc; st_bf8(out + (long)row * ld + col, o); } };
#ifndef HOST_EMU
struct EpiGlu8 { static constexpr bool HAS_LD = true; unsigned char* out; const unsigned char* ys; int ld_; int pad = 0;
    __device__ __forceinline__ f8 ld(int row, int col) const { const uint2 w = *(const uint2*)(ys + (long)row * ld_ + col); f8 r;
        const auto a0 = __builtin_amdgcn_cvt_pk_f32_fp8((int)w.x, false), a1 = __builtin_amdgcn_cvt_pk_f32_fp8((int)w.x, true), a2 = __builtin_amdgcn_cvt_pk_f32_fp8((int)w.y, false), a3 = __builtin_amdgcn_cvt_pk_f32_fp8((int)w.y, true);
        r.v[0] = a0[0]; r.v[1] = a0[1]; r.v[2] = a1[0]; r.v[3] = a1[1]; r.v[4] = a2[0]; r.v[5] = a2[1]; r.v[6] = a3[0]; r.v[7] = a3[1]; return r; }
    __device__ __forceinline__ void fin(int row, int col, const f8& v, const f8&, const f8& y) const { float o[8]; for (int i = 0; i < 8; ++i) o[i] = y.v[i] * sigmoidf_(v.v[i] * F8_ACC_INV);
        uint2 w; w.x = pk4_fp8(o[0], o[1], o[2], o[3]); w.y = pk4_fp8(o[4], o[5], o[6], o[7]); *(uint2*)(out + (long)row * ld_ + col) = w; }
    __device__ __forceinline__ void oct(int row, int col, const f8& v, const f8& v2) const { fin(row, col, v, v2, ld(row, col)); } };
#endif
struct EpiGlu { static constexpr bool HAS_LD = true; bf16* out; const bf16* ys; int ld_; int pad = 0;
    __device__ __forceinline__ f8 ld(int row, int col) const { return ld_bf8(ys + (long)row * ld_ + col); }
    __device__ __forceinline__ void fin(int row, int col, const f8& v, const f8&, const f8& y) const { f8 o; for (int i = 0; i < 8; ++i) o.v[i] = y.v[i] * sigmoidf_(v.v[i]); st_bf8(out + (long)row * ld_ + col, o); }
    __device__ __forceinline__ void oct(int row, int col, const f8& v, const f8& v2) const { fin(row, col, v, v2, ld(row, col)); } };

struct Unit { int pm, pn; };
struct StaticOrder {
    int nM, nN, nwg, G, c;
    __host__ __device__ void init(int M, int N, int G_, int c_) { nM = M / 256; nN = N / 256; nwg = nM * nN; G = G_; c = c_; }
    __host__ __device__ bool next(int i, Unit& u) const {
        const long L = (long)i * G + c; if (L >= nwg) return false;
        int wgid = (int)L; { const int q = nwg / 8, r = nwg % 8, xcd = wgid % 8, off = wgid / 8; wgid = (xcd < r ? xcd * (q + 1) : r * (q + 1) + (xcd - r) * q) + off; }
        const int nig = 8 * nN, gid = wgid / nig, fm = gid * 8, gsz = (nM - fm) < 8 ? (nM - fm) : 8;
        u.pm = fm + ((wgid % nig) % gsz); u.pn = (wgid % nig) / gsz; return true;
    }
};

#ifndef HOST_EMU
typedef short bf16x8_t __attribute__((ext_vector_type(8)));
typedef float f32x4_t __attribute__((ext_vector_type(4)));
#define LAS __attribute__((address_space(3)))
constexpr int HTB = 128 * 64 * 2;
__device__ __forceinline__ int lds_byte(int r, int c) { const int st = (r >> 4) * 2 + (c >> 5), rr = r & 15, cc = c & 31, ob = rr * 64 + cc * 2; return st * 1024 + (ob ^ (((ob >> 9) & 1) << 5)); }
__device__ __forceinline__ void stage_rc(int b, int& R, int& C) { const int st = b / 1024, sb = b % 1024, swz = sb ^ (((sb >> 9) & 1) << 5); R = (st >> 1) * 16 + swz / 64; C = (st & 1) * 32 + (swz % 64) / 2; }

typedef int i32x4_t __attribute__((ext_vector_type(4)));
typedef int i32x8_t __attribute__((ext_vector_type(8)));
template <class Epi, bool F8 = false, bool TE_LDS = false>
__device__ __forceinline__ void ph_gemm(const GemmArgs g, const Epi E, unsigned char* lds_) {
    LAS unsigned char* lds = (LAS unsigned char*)lds_;
    int tid = threadIdx.x; asm volatile("" : "+v"(tid));
    const int wid = __builtin_amdgcn_readfirstlane(tid >> 6), lane = tid & 63, wr = wid >> 2, wc = wid & 3, fr = lane & 15, fq = lane >> 4;
    const int K = g.K, nt = K / 64;
    const int Mrt = g.m_rt ? __builtin_amdgcn_readfirstlane(*g.m_rt) : g.M;
    StaticOrder S; S.init(Mrt, g.N, g.grid, (int)blockIdx.x);
    int RA[2]; unsigned CA2[2], voffB[2];
#pragma unroll
    for (int i = 0; i < 2; ++i) { int R, C; stage_rc(tid * 16 + i * 8192, R, C); RA[i] = R; CA2[i] = (unsigned)C * 2u;
        const int rho = R & 31, Rb = (R & ~31) + 8 * ((rho & 15) >> 2) + 4 * (rho >> 4) + (rho & 3);
        voffB[i] = (unsigned)(Rb * K + C) * 2u; }
    const size_t kstep = 128;
    const size_t hstepB = (size_t)128 * K * 2, tstepB = 2 * hstepB;
    const unsigned lda2 = (unsigned)g.lda * 2u;
    const unsigned ldsw = (unsigned)wid * 1024u;
    const int aoff = lds_byte(wr * 64 + fr, fq * 8), boff = lds_byte(wc * 32 + fr, fq * 8);
    const char* gA = (const char*)g.A;
#define PG8_SA(b, h) (((b) * 2 + (h)) * HTB)
#define PG8_SB(b, h) ((4 + (b) * 2 + (h)) * HTB)
#define PG8_STAGE_B(bufoff, gbase) do { _Pragma("unroll") for (int _i = 0; _i < 2; ++_i) \
        __builtin_amdgcn_global_load_lds((const unsigned*)((const char*)(gbase) + voffB[_i]), (LAS unsigned*)(lds + (bufoff) + ldsw + _i * 8192), 16, 0, 0); } while (0)
#define PG8_STAGE_A(bufoff, kbase, o0, o1) do { \
        __builtin_amdgcn_global_load_lds((const unsigned*)((kbase) + (o0)), (LAS unsigned*)(lds + (bufoff) + ldsw), 16, 0, 0); \
        __builtin_amdgcn_global_load_lds((const unsigned*)((kbase) + (o1)), (LAS unsigned*)(lds + (bufoff) + ldsw + 8192), 16, 0, 0); } while (0)
#define PG8_LDA(dst, b, h) do { _Pragma("unroll") for (int m = 0; m < 4; ++m) { dst[m].lo = *(const LAS i32x4_t*)(lds + PG8_SA(b, h) + aoff + m * 2048); dst[m].hi = *(const LAS i32x4_t*)(lds + PG8_SA(b, h) + aoff + m * 2048 + 1024); } } while (0)
#define PG8_LDB(dst, b, h) do { _Pragma("unroll") for (int n = 0; n < 2; ++n) { dst[n].lo = *(const LAS i32x4_t*)(lds + PG8_SB(b, h) + boff + n * 2048); dst[n].hi = *(const LAS i32x4_t*)(lds + PG8_SB(b, h) + boff + n * 2048 + 1024); } } while (0)
#define F8_SC 0
#define PG8_MMA(ai, bj, At, Bt) do { __builtin_amdgcn_s_setprio(1); \
        if constexpr (F8) { _Pragma("unroll") for (int m = 0; m < 4; ++m) _Pragma("unroll") for (int n = 0; n < 2; ++n) \
            asm volatile("v_mfma_f32_16x16x128_f8f6f4 %0, %1, %2, %0" : "+v"(acc[ai][bj][m][n]) : "v"(Bt[n]), "v"(At[m])); } \
        else { _Pragma("unroll") for (int m = 0; m < 4; ++m) _Pragma("unroll") for (int n = 0; n < 2; ++n) _Pragma("unroll") for (int k = 0; k < 2; ++k) \
            acc[ai][bj][m][n] = __builtin_amdgcn_mfma_f32_16x16x32_bf16(__builtin_bit_cast(bf16x8_t, k ? Bt[n].hi : Bt[n].lo), __builtin_bit_cast(bf16x8_t, k ? At[m].hi : At[m].lo), acc[ai][bj][m][n], 0, 0, 0); } \
        __builtin_amdgcn_s_setprio(0); } while (0)
#define PG8_WAIT_V(n) asm volatile("s_waitcnt vmcnt(" #n ")" ::: "memory")
#define PG8_WAIT_L(n) asm volatile("s_waitcnt lgkmcnt(" #n ")" ::: "memory")
#define PG8_BAR __builtin_amdgcn_s_barrier()
#define PG8_SCHED __builtin_amdgcn_sched_barrier(0)
#define PG8_OFFS(u, o) do { _Pragma("unroll") for (int _h = 0; _h < 2; ++_h) _Pragma("unroll") for (int _i = 0; _i < 2; ++_i) { const int _row = (u).pm * 256 + _h * 128 + RA[_i]; \
        const unsigned _ri = g.rowidx ? (unsigned)g.rowidx[_row] : (unsigned)_row; o[_h][_i] = _ri * lda2 + CA2[_i]; } } while (0)
#define PG8_BBASE(u) ((const char*)g.Bt + (g.tile_e ? (size_t)__builtin_amdgcn_readfirstlane(TE_LDS ? *(const LAS int*)(lds + GEMM_LDS + 4 * (u).pm) : g.tile_e[(u).pm]) * (size_t)g.b_estride * 2 : (size_t)0) + (size_t)(u).pn * tstepB)
    Unit cur, nxt; int ui = 0;
    if (!S.next(0, cur)) return;
    f32x4_t acc[2][2][4][2];
#pragma unroll
    for (int a = 0; a < 2; ++a)
#pragma unroll
        for (int b = 0; b < 2; ++b)
#pragma unroll
            for (int m = 0; m < 4; ++m)
#pragma unroll
                for (int n = 0; n < 2; ++n) acc[a][b][m][n] = (f32x4_t){0.f, 0.f, 0.f, 0.f};
    i32x8_t At[4], B0[2], B1[2];
    unsigned oc[2][2], on[2][2];
    PG8_OFFS(cur, oc);
    const char* cB = PG8_BBASE(cur);
    PG8_STAGE_B(PG8_SB(0, 0), cB); PG8_STAGE_B(PG8_SB(0, 1), cB + hstepB); PG8_STAGE_A(PG8_SA(0, 0), gA, oc[0][0], oc[0][1]); PG8_STAGE_A(PG8_SA(0, 1), gA, oc[1][0], oc[1][1]);
    if (wr == 1) PG8_BAR;
    PG8_WAIT_V(2); PG8_BAR;
    PG8_STAGE_B(PG8_SB(1, 0), cB + kstep); PG8_STAGE_A(PG8_SA(1, 0), gA + kstep, oc[0][0], oc[0][1]); PG8_STAGE_B(PG8_SB(1, 1), cB + hstepB + kstep);
    PG8_WAIT_V(6); PG8_BAR;
    for (;;) {
        const bool has_next = S.next(ui + 1, nxt);
        const char* nB = cB;
        if (has_next) { PG8_OFFS(nxt, on); nB = PG8_BBASE(nxt); }
        else {
#pragma unroll
            for (int h = 0; h < 2; ++h)
#pragma unroll
                for (int i = 0; i < 2; ++i) on[h][i] = oc[h][i];
        }
        for (int t = 0; t < nt; t += 2) {
            const bool last = (t == nt - 2);
            const char* a1 = gA + (size_t)(t + 1) * kstep;
            const char* a2 = last ? gA : gA + (size_t)(t + 2) * kstep; const char* b2 = last ? nB : cB + (size_t)(t + 2) * kstep;
            const char* a3 = a2 + kstep; const char* b3 = b2 + kstep;
            const unsigned o00 = last ? on[0][0] : oc[0][0], o01 = last ? on[0][1] : oc[0][1], o10 = last ? on[1][0] : oc[1][0], o11 = last ? on[1][1] : oc[1][1];
            PG8_LDB(B0, 0, 0); PG8_LDB(B1, 0, 1); PG8_SCHED; PG8_LDA(At, 0, 0); PG8_STAGE_A(PG8_SA(1, 1), a1, oc[1][0], oc[1][1]);
            PG8_WAIT_V(8); PG8_WAIT_L(0); PG8_BAR; PG8_MMA(0, 0, At, B0); PG8_MMA(0, 1, At, B1); PG8_BAR; PG8_SCHED;
            PG8_LDA(At, 0, 1); PG8_STAGE_B(PG8_SB(0, 0), b2); PG8_STAGE_B(PG8_SB(0, 1), b2 + hstepB); PG8_STAGE_A(PG8_SA(0, 0), a2, o00, o01);
            PG8_WAIT_V(8); PG8_WAIT_L(0); PG8_BAR; PG8_MMA(1, 0, At, B0); PG8_MMA(1, 1, At, B1); PG8_BAR; PG8_SCHED;
            PG8_LDB(B0, 1, 0); PG8_LDB(B1, 1, 1); PG8_SCHED; PG8_LDA(At, 1, 0); PG8_STAGE_A(PG8_SA(0, 1), a2, o10, o11);
            PG8_WAIT_V(8); PG8_WAIT_L(0); PG8_BAR; PG8_MMA(0, 0, At, B0); PG8_MMA(0, 1, At, B1); PG8_BAR; PG8_SCHED;
            PG8_LDA(At, 1, 1); PG8_STAGE_B(PG8_SB(1, 0), b3); PG8_STAGE_B(PG8_SB(1, 1), b3 + hstepB); PG8_STAGE_A(PG8_SA(1, 0), a3, o00, o01);
            PG8_WAIT_V(8); PG8_WAIT_L(0); PG8_BAR; PG8_MMA(1, 0, At, B0); PG8_MMA(1, 1, At, B1); PG8_BAR; PG8_SCHED;
        }
        if (wr == 0) PG8_BAR;
        if constexpr (F8) asm volatile("s_nop 15\n\ts_nop 15" ::: "memory");
        {
            f8 raw[4], rawn[4];
#define PG8_EPI_LD(dst, ai_, mp_) do { _Pragma("unroll") for (int mm = 0; mm < 2; ++mm) _Pragma("unroll") for (int bj = 0; bj < 2; ++bj) \
                dst[mm * 2 + bj] = E.ld(cur.pm * 256 + (ai_) * 128 + wr * 64 + ((mp_) * 2 + mm) * 16 + fr, cur.pn * 256 + bj * 128 + wc * 32 + fq * 8); } while (0)
            if constexpr (Epi::HAS_LD) PG8_EPI_LD(rawn, 0, 0);
#pragma unroll
            for (int b4 = 0; b4 < 4; ++b4) { const int ai = b4 >> 1, mp = b4 & 1;
                if constexpr (Epi::HAS_LD) {
#pragma unroll
                    for (int i = 0; i < 4; ++i) raw[i] = rawn[i];
                    if (b4 < 3) PG8_EPI_LD(rawn, (b4 + 1) >> 1, (b4 + 1) & 1);
                }
#pragma unroll
                for (int mm = 0; mm < 2; ++mm) { const int m = mp * 2 + mm, row = cur.pm * 256 + ai * 128 + wr * 64 + m * 16 + fr;
#pragma unroll
                    for (int bj = 0; bj < 2; ++bj) { f8 v, v2;
#pragma unroll
                        for (int n = 0; n < 2; ++n)
#pragma unroll
                            for (int q = 0; q < 4; ++q) { v.v[4 * n + q] = acc[ai][bj][m][n][q]; v2.v[4 * n + q] = acc[ai][bj ^ 1][m][n][q]; }
                        const int col = cur.pn * 256 + bj * 128 + wc * 32 + fq * 8;
                        if constexpr (Epi::HAS_LD) E.fin(row, col, v, v2, raw[mm * 2 + bj]); else E.oct(row, col, v, v2); } }
            }
#undef PG8_EPI_LD
        }
        if (!has_next) break;
#pragma unroll
        for (int a = 0; a < 2; ++a)
#pragma unroll
            for (int b = 0; b < 2; ++b)
#pragma unroll
                for (int m = 0; m < 4; ++m)
#pragma unroll
                    for (int n = 0; n < 2; ++n) acc[a][b][m][n] = (f32x4_t){0.f, 0.f, 0.f, 0.f};
        cur = nxt; cB = nB; ++ui;
#pragma unroll
        for (int h = 0; h < 2; ++h)
#pragma unroll
            for (int i = 0; i < 2; ++i) oc[h][i] = on[h][i];
        if (wr == 1) PG8_BAR;
    }
    PG8_WAIT_V(0);
    PG8_BAR;
#undef PG8_SA
#undef PG8_SB
#undef PG8_STAGE_A
#undef PG8_STAGE_B
#undef PG8_LDA
#undef PG8_LDB
#undef PG8_MMA
#undef PG8_WAIT_V
#undef PG8_WAIT_L
#undef PG8_BAR
#undef PG8_SCHED
#undef PG8_OFFS
#undef PG8_BBASE
}
#else
template <class Epi> static void ph_gemm(const GemmArgs g, const Epi E, unsigned char*) {
    static float Ct[256][256];
    const int Mrt = g.m_rt ? *g.m_rt : g.M;
    StaticOrder S; S.init(Mrt, g.N, GDIM_OF(g), BIDX); Unit u;
    for (int i = 0; S.next(i, u); ++i) {
        const int brow = u.pm * 256, bcol = u.pn * 256; const bf16* Bg = g.Bt + (g.tile_e ? (long)g.tile_e[u.pm] * g.b_estride : 0);
        for (int r = 0; r < 256; ++r) { const long ridx = g.rowidx ? g.rowidx[brow + r] : brow + r; const bf16* a = g.A + ridx * g.lda;
            for (int c = 0; c < 256; ++c) { const bf16* bt = Bg + (long)(bcol + c) * g.K; float s = 0.f; for (int k = 0; k < g.K; ++k) s += bf2f(a[k]) * bf2f(bt[k]); Ct[r][c] = s; } }
        for (int r = 0; r < 256; ++r) for (int c = 0; c < 256; c += 8) { f8 v, v2; for (int q = 0; q < 8; ++q) { v.v[q] = Ct[r][c + q]; v2.v[q] = Ct[r][(c ^ 128) + q]; } E.oct(brow + r, bcol + c, v, v2); }
    }
}
#endif
__host__ __device__ __forceinline__ GemmArgs mk_gemm_(int grid, const bf16* A, long lda, const bf16* Bt, int M, int N, int K) {
    GemmArgs g; g.grid = grid; g.A = A; g.Bt = Bt; g.rowidx = nullptr; g.tile_e = nullptr; g.m_rt = nullptr; g.lda = lda; g.b_estride = 0; g.M = M; g.N = N; g.K = K; return g; }
#define mk_gemm(...) mk_gemm_(p.grid, __VA_ARGS__)
__host__ __device__ __forceinline__ XposeJob mk_xpose_(int grid, const float* src, bf16* dst, int K, int N, int Ncover, int il, int il2, int add, int batch, long ss, long ds) {
    XposeJob j; j.grid = grid; j.src = src; j.dst = dst; j.K = K; j.N = N; j.Ncover = Ncover; j.il = il; j.il2 = il2; j.add = add; j.batch = batch; j.sstride = ss; j.dstride = ds; j.first = 0; return j; }
#define mk_xpose(...) mk_xpose_(p.grid, __VA_ARGS__)

#ifndef HOST_EMU
#define XB_TMO      128
#define XB_XCNT(j)  (256  + 64 * (j))
#define XB_XSUB(j)  (1280 + 64 * (j))
#define XB_XGEN(j)  (2304 + 64 * (j))
#define XB_TOP      3328
#define XB_TOPGEN   3392
#define XCD_BAR_WORDS 3456
#define XB_SPIN_CAP (1u << 18)
__device__ __forceinline__ unsigned xb_ld(unsigned* p)              { return __hip_atomic_load(p, __ATOMIC_RELAXED, __HIP_MEMORY_SCOPE_AGENT); }
__device__ __forceinline__ unsigned xb_add(unsigned* p, unsigned v) { return __hip_atomic_fetch_add(p, v, __ATOMIC_RELAXED, __HIP_MEMORY_SCOPE_AGENT); }
__device__ __forceinline__ unsigned xb_xcc_id() { return (unsigned)__builtin_amdgcn_s_getreg((3 << 11) | 20) & 0xFu; }
#define XB_SPIN(cond, bar) do { unsigned _sp = 0; while (cond) { __builtin_amdgcn_s_sleep(1); \
    if ((++_sp & 255u) == 0u) { if (xb_ld(&(bar)[XB_TMO])) break; if (_sp > XB_SPIN_CAP) { atomicAdd(&(bar)[XB_TMO], 1u); break; } } } } while (0)
struct XcdBarrier { unsigned* bar; unsigned x; volatile LAS unsigned* st; unsigned G; };
__device__ __forceinline__ XcdBarrier xcd_barrier_post(unsigned* bar, volatile LAS unsigned* st, unsigned G) {
    XcdBarrier b; b.bar = bar; b.x = xb_xcc_id(); b.st = st; b.G = G;
    if (threadIdx.x == 0) (void)xb_add(&bar[XB_XCNT(b.x)], 1u);
    return b;
}
__device__ __forceinline__ void xcd_barrier_complete(unsigned* bar, unsigned x, unsigned G, unsigned& nloc, unsigned& nx) {
    unsigned sum, cnt, mine, sp = 0u;
    for (;;) {
        sum = 0u; cnt = 0u; mine = 0u;
#pragma unroll
        for (unsigned j = 0; j < 16; ++j) { const unsigned c = xb_ld(&bar[XB_XCNT(j)]); sum += c; cnt += (c > 0u) ? 1u : 0u; mine = (j == x) ? c : mine; }
        if (sum == G) break;
        __builtin_amdgcn_s_sleep(1);
        if ((++sp & 255u) == 0u) { if (xb_ld(&bar[XB_TMO])) break; if (sp > XB_SPIN_CAP) { atomicAdd(&bar[XB_TMO], 1u); break; } }
    }
    nloc = mine > 0u ? mine : 1u; nx = cnt > 0u ? cnt : 1u;
}
__device__ __forceinline__ void xcd_barrier(const XcdBarrier& b) {
    asm volatile("s_waitcnt vmcnt(0)" ::: "memory");
    __syncthreads();
    if (threadIdx.x == 0) {
        unsigned* bar = b.bar;
        __builtin_amdgcn_s_waitcnt(0);
        unsigned nloc = b.st[0], nx = b.st[1];
        if (nloc == 0u) { xcd_barrier_complete(bar, b.x, b.G, nloc, nx); b.st[0] = nloc; b.st[1] = nx; }
        const unsigned old = xb_add(&bar[XB_XSUB(b.x)], 1u);
        const unsigned gen = old / nloc;
        if (old + 1u == (gen + 1u) * nloc) {
            __builtin_amdgcn_fence(__ATOMIC_RELEASE, "agent");
            asm volatile("s_waitcnt vmcnt(0)" ::: "memory");
            const unsigned og = xb_add(&bar[XB_TOP], 1u);
            const unsigned tg = og / nx;
            if (og + 1u == (tg + 1u) * nx) xb_add(&bar[XB_TOPGEN], 1u);
            else XB_SPIN(xb_ld(&bar[XB_TOPGEN]) == tg, bar);
            __builtin_amdgcn_fence(__ATOMIC_ACQUIRE, "agent");
            xb_add(&bar[XB_XGEN(b.x)], 1u);
            asm volatile("s_waitcnt vmcnt(0)" ::: "memory");
        } else {
            XB_SPIN(xb_ld(&bar[XB_XGEN(b.x)]) == gen, bar);
            __builtin_amdgcn_fence(__ATOMIC_ACQUIRE, "agent");
            asm volatile("s_waitcnt vmcnt(0)" ::: "memory");
        }
    }
    __syncthreads();
}
#define PHASE_BEGIN {
#define PHASE_END } xcd_barrier(gbar);
#define PROGRAM_ARGS const P& p, unsigned char* lds, const XcdBarrier& gbar
#else
constexpr int EMU_GRID = 4;
#define PHASE_BEGIN for (int _b = 0; _b < EMU_GRID; ++_b) { e_blockIdx.x = _b;
#define PHASE_END }
#define PROGRAM_ARGS const P& p, unsigned char* lds, int gbar
#endif


#ifndef HOST_EMU
typedef float f32x16_t __attribute__((ext_vector_type(16)));
typedef short s16x4_t __attribute__((ext_vector_type(4)));
typedef float f32x2_t __attribute__((ext_vector_type(2)));
typedef __bf16 bf16x2_t __attribute__((ext_vector_type(2)));
typedef unsigned u32x4_t __attribute__((ext_vector_type(4)));
typedef unsigned u32x2_t __attribute__((ext_vector_type(2)));
__device__ __forceinline__ int crow(int r, int hi) { return (r & 3) + 8 * (r >> 2) + 4 * hi; }
__device__ __forceinline__ unsigned cvtpk(float lo, float hi) { f32x2_t v = {lo, hi}; bf16x2_t b = __builtin_convertvector(v, bf16x2_t); return __builtin_bit_cast(unsigned, b); }
__device__ __forceinline__ float xhalf_max(float m) { auto rr = __builtin_amdgcn_permlane32_swap(__float_as_uint(m), __float_as_uint(m), false, false); return fmaxf(__uint_as_float(rr[0]), __uint_as_float(rr[1])); }
__device__ __forceinline__ float xhalf_sum(float m) { auto rr = __builtin_amdgcn_permlane32_swap(__float_as_uint(m), __float_as_uint(m), false, false); return __uint_as_float(rr[0]) + __uint_as_float(rr[1]); }
constexpr int N2_SLOT = 16384;
constexpr int N2_IMPA = 2 * N2_SLOT, N2_IMPB = N2_IMPA + 32768, N2_IMPT = N2_IMPB + 32768, N2_SEL = N2_IMPT + 8192, N2_END = N2_SEL + 512;
static_assert(N2_END <= GEMM_LDS, "nsa lds");
__device__ __forceinline__ void n2_qk(f32x16_t& p0, f32x16_t& p1, const LAS unsigned char* Ks, const bf16x8_t (&qr)[4], int r32, int hi) {
#pragma unroll
    for (int r = 0; r < 16; ++r) { p0[r] = 0.f; p1[r] = 0.f; }
    asm volatile("" : "+v"(p0), "+v"(p1));
#pragma unroll
    for (int ks = 0; ks < 4; ++ks) { const int c = ((2 * ks + hi) ^ (r32 & 7)) * 16;
        const bf16x8_t k0 = *(const LAS bf16x8_t*)(Ks + r32 * 128 + c), k1 = *(const LAS bf16x8_t*)(Ks + (32 + r32) * 128 + c);
        p0 = __builtin_amdgcn_mfma_f32_32x32x16_bf16(k0, qr[ks], p0, 0, 0, 0); p1 = __builtin_amdgcn_mfma_f32_32x32x16_bf16(k1, qr[ks], p1, 0, 0, 0); }
}
__device__ __forceinline__ void n2_pv(f32x16_t& o0, f32x16_t& o1, const LAS unsigned char* Vs, const f32x16_t& p0, const f32x16_t& p1, int lane) {
    const int hi = lane >> 5; const LAS unsigned char* vb = Vs + (4 * hi + ((lane & 15) >> 2)) * 128 + (((lane >> 4) & 1) * 16 + (lane & 3) * 4) * 2;
#pragma unroll
    for (int s = 0; s < 4; ++s) {
        bf16x8_t pb;
        { const f32x16_t& pp = (s < 2) ? p0 : p1; const int r0 = 8 * (s & 1);
          union { unsigned u[4]; bf16x8_t v; } pk; pk.u[0] = cvtpk(pp[r0], pp[r0 + 1]); pk.u[1] = cvtpk(pp[r0 + 2], pp[r0 + 3]); pk.u[2] = cvtpk(pp[r0 + 4], pp[r0 + 5]); pk.u[3] = cvtpk(pp[r0 + 6], pp[r0 + 7]); pb = pk.v; }
#pragma unroll
        for (int d0 = 0; d0 < 2; ++d0) {
            const s16x4_t lo = __builtin_bit_cast(s16x4_t, __builtin_amdgcn_ds_read_tr16_b64_v4i16((LAS s16x4_t*)(vb + s * 2048 + d0 * 64)));
            const s16x4_t hh = __builtin_bit_cast(s16x4_t, __builtin_amdgcn_ds_read_tr16_b64_v4i16((LAS s16x4_t*)(vb + s * 2048 + 1024 + d0 * 64)));
            const bf16x8_t vf = (bf16x8_t){lo[0], lo[1], lo[2], lo[3], hh[0], hh[1], hh[2], hh[3]};
            if (d0 == 0) o0 = __builtin_amdgcn_mfma_f32_32x32x16_bf16(vf, pb, o0, 0, 0, 0); else o1 = __builtin_amdgcn_mfma_f32_32x32x16_bf16(vf, pb, o1, 0, 0, 0);
        }
    }
}
__device__ __forceinline__ void ph_nsa2(const P& p, unsigned char* lds_) {
    LAS unsigned char* lds = (LAS unsigned char*)lds_;
    int tid = threadIdx.x; asm volatile("" : "+v"(tid));
    const int lane = tid & 63, wid = __builtin_amdgcn_readfirstlane(tid >> 6), r32 = lane & 31, hi = lane >> 5;
    const int hr = wid >> 1, tsub = (wid & 1) * 32 + r32;
    const int skey = tid >> 3, sch = tid & 7;
    const unsigned soff = (unsigned)(skey * 128 + sch * 16);
    const bf16* QB = WSP(bf16, A_QB); bf16* ATT = WSP(bf16, A_ATT);
    const bf16* KCMP = WSP(bf16, A_KCMP); const bf16* VCMP = WSP(bf16, A_VCMP);
    const bf16* KS = WSP(bf16, A_KS); const bf16* VS = WSP(bf16, A_VS); const bf16* KW = WSP(bf16, A_KW); const bf16* VW = WSP(bf16, A_VW);
    LAS float* IMPA = (LAS float*)(lds + N2_IMPA); LAS float* IMPB = (LAS float*)(lds + N2_IMPB); LAS float* IMPT = (LAS float*)(lds + N2_IMPT); LAS unsigned* SEL = (LAS unsigned*)(lds + N2_SEL);
    constexpr int NQT = S / 64, NBG = NB * 2, NUNITS = NBG * NQT;
#define N2_LOAD(Kp, Vp, row0, kreg, vreg) do { const long rb_ = (long)(row0) * 128;     \
        kreg = *(const u32x4_t*)((const char*)(Kp) + rb_ + soff); vreg = *(const u32x4_t*)((const char*)(Vp) + rb_ + soff); } while (0)
#define N2_STORE(slot, kreg, vreg) do { *(LAS u32x4_t*)(lds + (slot) * N2_SLOT + skey * 128 + ((sch ^ (skey & 7)) * 16)) = kreg; *(LAS u32x4_t*)(lds + (slot) * N2_SLOT + 8192 + skey * 128 + sch * 16) = vreg; } while (0)
    for (int unit0 = blockIdx.x; unit0 < NUNITS; unit0 += p.grid) {
        int unit = unit0;
        if (p.grid % NBG == 0) { const int per = p.grid / NBG, k = unit0 / p.grid, c0 = (unit0 % p.grid) / NBG; if ((k & 1) && (k + 1) * p.grid <= NUNITS) unit = k * p.grid + (per - 1 - c0) * NBG + unit0 % NBG; }
        const int bg = unit % NBG, qt = unit / NBG, g = bg & 1, b = bg >> 1, t0 = qt * 64, t = t0 + tsub, cur = qt;
        const long kvrow = (long)bg * S;
        bf16x8_t qr[4];
        { const bf16* qrow = QB + ((long)(b * 8 + g * 4 + hr) * S + t) * 64;
#pragma unroll
          for (int ks = 0; ks < 4; ++ks) qr[ks] = *(const bf16x8_t*)(qrow + ks * 16 + hi * 8); }
        float gate[3];
        { const float* gr = WSP(float, A_GRAW) + ((long)b * S + t) * 24 + (g * 4 + hr) * 3;
#pragma unroll
          for (int i = 0; i < 3; ++i) gate[i] = sigmoidf_(gr[i]); }
        f32x16_t oa0, oa1;
#pragma unroll
        for (int r = 0; r < 16; ++r) { oa0[r] = 0.f; oa1[r] = 0.f; }
        asm volatile("" : "+v"(oa0), "+v"(oa1));
        u32x4_t kreg, vreg;
        N2_LOAD(KCMP, VCMP, (long)bg * NCP, kreg, vreg); N2_STORE(0, kreg, vreg);
        N2_LOAD(KCMP, VCMP, (long)bg * NCP + 64, kreg, vreg); N2_STORE(1, kreg, vreg);
        if (tid < 64) SEL[64 + 0] = 0u;
        __syncthreads();
        {
            f32x16_t c0, c1, c2, c3;
            n2_qk(c0, c1, lds, qr, r32, hi); n2_qk(c2, c3, lds + N2_SLOT, qr, r32, hi);
            float m = -1e30f;
            int nlim = (t >= 31) ? ((t - 31) >> 4) : -1; nlim = (nlim > NCMP - 1 ? NCMP - 1 : nlim) - 4 * hi;
            asm volatile("" : "+v"(nlim));
#pragma unroll
            for (int r = 0; r < 16; ++r) { const int nc = (r & 3) + 8 * (r >> 2);
                if (nc > nlim) c0[r] = -INFINITY;
                if (nc + 32 > nlim) c1[r] = -INFINITY;
                if (nc + 64 > nlim) c2[r] = -INFINITY;
                if (nc + 96 > nlim) c3[r] = -INFINITY;
                m = fmaxf(fmaxf(m, c0[r]), fmaxf(c1[r], fmaxf(c2[r], c3[r]))); }
            m = xhalf_max(m);
            float l = 0.f;
#pragma unroll
            for (int r = 0; r < 16; ++r) { c0[r] = __builtin_amdgcn_exp2f(c0[r] - m); c1[r] = __builtin_amdgcn_exp2f(c1[r] - m); c2[r] = __builtin_amdgcn_exp2f(c2[r] - m); c3[r] = __builtin_amdgcn_exp2f(c3[r] - m); l += (c0[r] + c1[r]) + (c2[r] + c3[r]); }
            l = xhalf_sum(l);
            const float inv = l > 0.f ? 1.0f / l : 0.f;
#pragma unroll
            for (int r = 0; r < 16; ++r) { c0[r] *= inv; c1[r] *= inv; c2[r] *= inv; c3[r] *= inv; }
            asm volatile("" : "+v"(c0), "+v"(c1), "+v"(c2), "+v"(c3));
            { LAS float* ia = IMPA + ((wid * 2 + hi) * 32 + r32) * 16; LAS float* ib = IMPB + ((wid * 2 + hi) * 32 + r32) * 16;
#pragma unroll
              for (int gi = 0; gi < 4; ++gi) {
                  ia[0 + gi] = (c0[4 * gi] + c0[4 * gi + 1]) + (c0[4 * gi + 2] + c0[4 * gi + 3]); ib[0 + gi] = c0[4 * gi + 3];
                  ia[4 + gi] = (c1[4 * gi] + c1[4 * gi + 1]) + (c1[4 * gi + 2] + c1[4 * gi + 3]); ib[4 + gi] = c1[4 * gi + 3];
                  ia[8 + gi] = (c2[4 * gi] + c2[4 * gi + 1]) + (c2[4 * gi + 2] + c2[4 * gi + 3]); ib[8 + gi] = c2[4 * gi + 3];
                  ia[12 + gi] = (c3[4 * gi] + c3[4 * gi + 1]) + (c3[4 * gi + 2] + c3[4 * gi + 3]); ib[12 + gi] = c3[4 * gi + 3]; } }
#pragma unroll
            for (int r = 0; r < 16; ++r) { c0[r] *= gate[0]; c1[r] *= gate[0]; c2[r] *= gate[0]; c3[r] *= gate[0]; }
            n2_pv(oa0, oa1, lds + 8192, c0, c1, lane); n2_pv(oa0, oa1, lds + N2_SLOT + 8192, c2, c3, lane);
        }
        __syncthreads();
        if (tid < 64) {
            const int tt = tid, th = tt >> 5, tr = tt & 31; LAS float* im = IMPT + tt * 32;
            for (int m = 0; m < 32; ++m) { float sacc = 0.f;
                if (m < NSLC) {
#pragma unroll
                    for (int r = 0; r < 4; ++r) { const int w = 2 * r + th; sacc += IMPA[((w * 2 + (m & 1)) * 32 + tr) * 16 + (m >> 1)]; if (m >= 1) sacc += IMPB[((w * 2 + ((m - 1) & 1)) * 32 + tr) * 16 + ((m - 1) >> 1)]; } }
                const bool valid = m <= cur, forced = (m == 0) || (valid && m > cur - 2);
                im[m] = (m < NSLC) ? (forced ? sacc + 1e4f : (valid ? sacc : -1e30f)) : -3.4e38f; }
            unsigned sm = 0u;
            for (int i = 0; i < 8; ++i) { int best = 0; float bv = -3.4e38f; for (int m = 0; m < NSLC; ++m) { const float v = im[m]; if (v > bv) { bv = v; best = m; } } im[best] = -3.4e38f; if (best <= cur) sm |= 1u << best; }
            SEL[tt] = sm; atomicOr((unsigned*)&SEL[64], sm);
        }
        __syncthreads();
        const unsigned mysel = SEL[tsub];
#pragma unroll
        for (int br = 0; br < 2; ++br) {
            const bf16* Kp = br == 0 ? KS : KW; const bf16* Vp = br == 0 ? VS : VW;
            unsigned bm;
            if (br == 0) bm = (unsigned)__builtin_amdgcn_readfirstlane((int)SEL[64]);
            else { const int lo = cur - 8 < 0 ? 0 : cur - 8; bm = (cur >= 31 ? 0xffffffffu : ((1u << (cur + 1)) - 1u)) & ~((1u << lo) - 1u); }
            int ja = __builtin_ctz(bm); bm &= bm - 1u; int jb = bm ? __builtin_ctz(bm) : -1; bm &= bm - 1u;
            N2_LOAD(Kp, Vp, kvrow + 64 * ja, kreg, vreg); N2_STORE(0, kreg, vreg);
            if (jb >= 0) { N2_LOAD(Kp, Vp, kvrow + 64 * jb, kreg, vreg); N2_STORE(1, kreg, vreg); }
            __syncthreads();
            int ps = 0; float m = -1e30f, l = 0.f; f32x16_t o0, o1;
#pragma unroll
            for (int r = 0; r < 16; ++r) { o0[r] = 0.f; o1[r] = 0.f; }
            asm volatile("" : "+v"(o0), "+v"(o1));
#define N2_STEP(jj, sub) do { \
                f32x16_t p0, p1; \
                n2_qk(p0, p1, lds + (sub) * N2_SLOT, qr, r32, hi); \
                const bool dead = (br == 0) && !((mysel >> (jj)) & 1u); \
                const bool diag = ((jj) == cur), tail = (br == 1) && ((jj) == cur - 8); \
                float rm = -1e30f; \
                int khi = dead ? -1000 : (diag ? tsub - 4 * hi : 1000), klo = tail ? tsub - 4 * hi : -1000;     \
                asm volatile("" : "+v"(khi), "+v"(klo)); \
                _Pragma("unroll") for (int r = 0; r < 16; ++r) { const int kc = (r & 3) + 8 * (r >> 2); \
                    if (kc > khi || kc <= klo) p0[r] = -INFINITY; \
                    if (kc + 32 > khi || kc + 32 <= klo) p1[r] = -INFINITY; \
                    rm = fmaxf(rm, fmaxf(p0[r], p1[r])); } \
                rm = xhalf_max(rm); \
                const float mn = fmaxf(m, rm), sc = __builtin_amdgcn_exp2f(m - mn); m = mn; \
                float rs = 0.f; \
                _Pragma("unroll") for (int r = 0; r < 16; ++r) { p0[r] = __builtin_amdgcn_exp2f(p0[r] - mn); p1[r] = __builtin_amdgcn_exp2f(p1[r] - mn); rs += p0[r] + p1[r]; } \
                l = l * sc + rs; \
                _Pragma("unroll") for (int r = 0; r < 16; ++r) { o0[r] *= sc; o1[r] *= sc; } \
                n2_pv(o0, o1, lds + (sub) * N2_SLOT + 8192, p0, p1, lane); } while (0)
            for (;;) {
                const int na = bm ? __builtin_ctz(bm) : -1; bm &= bm - 1u; const int nb = bm ? __builtin_ctz(bm) : -1; bm &= bm - 1u;
                if (na >= 0) N2_LOAD(Kp, Vp, kvrow + 64 * na, kreg, vreg);
                N2_STEP(ja, 2 * ps);
                if (na >= 0) N2_STORE(2 * (ps ^ 1), kreg, vreg);
                if (jb >= 0) {
                    if (nb >= 0) N2_LOAD(Kp, Vp, kvrow + 64 * nb, kreg, vreg);
                    N2_STEP(jb, 2 * ps + 1);
                    if (nb >= 0) N2_STORE(2 * (ps ^ 1) + 1, kreg, vreg); }
                __syncthreads();
                if (na < 0) break;
                ja = na; jb = nb; ps ^= 1;
            }
#undef N2_STEP
            l = xhalf_sum(l);
            const float f = (l > 0.f ? 1.0f / l : 0.f) * gate[1 + br];
#pragma unroll
            for (int r = 0; r < 16; ++r) { oa0[r] += f * o0[r]; oa1[r] += f * o1[r]; }
        }
        { unsigned char* orow = (unsigned char*)ATT + ((long)b * S + t) * 1024 + 512 + (g * 4 + hr) * 64;
#pragma unroll
          for (int gi = 0; gi < 4; ++gi) {
              *(unsigned*)(orow + 8 * gi + 4 * hi) = pk4_fp8(oa0[4 * gi] * A8_SCALE, oa0[4 * gi + 1] * A8_SCALE, oa0[4 * gi + 2] * A8_SCALE, oa0[4 * gi + 3] * A8_SCALE);
              *(unsigned*)(orow + 32 + 8 * gi + 4 * hi) = pk4_fp8(oa1[4 * gi] * A8_SCALE, oa1[4 * gi + 1] * A8_SCALE, oa1[4 * gi + 2] * A8_SCALE, oa1[4 * gi + 3] * A8_SCALE); } }
    }
#undef N2_LOAD
#undef N2_STORE
}

__device__ __forceinline__ void ph_sb2(const P& p, unsigned char* lds_) {
    LAS unsigned char* lds = (LAS unsigned char*)lds_;
    int tid = threadIdx.x; asm volatile("" : "+v"(tid));
    const int lane = tid & 63, wid = __builtin_amdgcn_readfirstlane(tid >> 6), r32 = lane & 31, hi = lane >> 5;
    const int skey = tid >> 3, sch = tid & 7;
    const unsigned soff = (unsigned)(skey * 128 + sch * 16);
    const bf16* QA = WSP(bf16, A_QA); const bf16* KA = WSP(bf16, A_KA); const bf16* VA = WSP(bf16, A_VA); bf16* ATT = WSP(bf16, A_ATT);
    LAS unsigned* FLG = (LAS unsigned*)(lds + 2 * N2_SLOT);
    constexpr int NQB = S / 256, NBH = NB * 8, NUNITS = NBH * NQB;
#define N2_LOAD(Kp, Vp, row0, kreg, vreg) do { const long rb_ = (long)(row0) * 128;     \
        kreg = *(const u32x4_t*)((const char*)(Kp) + rb_ + soff); vreg = *(const u32x4_t*)((const char*)(Vp) + rb_ + soff); } while (0)
#define N2_STORE(slot, kreg, vreg) do { *(LAS u32x4_t*)(lds + (slot) * N2_SLOT + skey * 128 + ((sch ^ (skey & 7)) * 16)) = kreg; *(LAS u32x4_t*)(lds + (slot) * N2_SLOT + 8192 + skey * 128 + sch * 16) = vreg; } while (0)
    for (int unit = blockIdx.x; unit < NUNITS; unit += p.grid) {
        const int bh = unit % NBH, qb = unit / NBH, t0 = qb * 256, tw = t0 + 32 * wid, t = tw + r32;
        const long kvrow = (long)bh * S;
        bf16x8_t qr[4];
        { const bf16* qrow = QA + (kvrow + t) * 64;
#pragma unroll
          for (int ks = 0; ks < 4; ++ks) qr[ks] = *(const bf16x8_t*)(qrow + ks * 16 + hi * 8); }
        f32x16_t o0, o1;
#pragma unroll
        for (int r = 0; r < 16; ++r) { o0[r] = 0.f; o1[r] = 0.f; }
        asm volatile("" : "+v"(o0), "+v"(o1));
        float R = 0.f;
        u32x4_t kreg, vreg;
        int j = 4 * qb + 3, slot = 0, iter = 0;
        N2_LOAD(KA, VA, kvrow + 64 * j, kreg, vreg); N2_STORE(0, kreg, vreg);
        __syncthreads();
        for (;;) {
            const int jn = j - 1;
            if (jn >= 0) N2_LOAD(KA, VA, kvrow + 64 * jn, kreg, vreg);
            if (64 * j < tw + 31 && !__all(R > 175.f)) {
                f32x16_t p0, p1, s0, s1;
                n2_qk(p0, p1, lds + slot * N2_SLOT, qr, r32, hi);
                int lim = t - 64 * j - 4 * hi;
                asm volatile("" : "+v"(lim));
#pragma unroll
                for (int r = 0; r < 16; ++r) { const int kc = (r & 3) + 8 * (r >> 2);
                    { const float z = p0[r], c = __builtin_amdgcn_logf(1.0f + __builtin_amdgcn_exp2f(-fabsf(z))); const bool ok = kc < lim; s0[r] = ok ? fmaxf(z, 0.f) + c : 0.f; p0[r] = ok ? -(fmaxf(-z, 0.f) + c) : -INFINITY; }
                    { const float z = p1[r], c = __builtin_amdgcn_logf(1.0f + __builtin_amdgcn_exp2f(-fabsf(z))); const bool ok = kc + 32 < lim; s1[r] = ok ? fmaxf(z, 0.f) + c : 0.f; p1[r] = ok ? -(fmaxf(-z, 0.f) + c) : -INFINITY; } }
                float own[8], part[8], T[8];
#pragma unroll
                for (int i = 0; i < 4; ++i) { own[i] = (s0[4 * i] + s0[4 * i + 1]) + (s0[4 * i + 2] + s0[4 * i + 3]); own[4 + i] = (s1[4 * i] + s1[4 * i + 1]) + (s1[4 * i + 2] + s1[4 * i + 3]); }
#pragma unroll
                for (int i = 0; i < 8; ++i) { auto rr = __builtin_amdgcn_permlane32_swap(__float_as_uint(own[i]), __float_as_uint(own[i]), false, false); part[i] = __uint_as_float(hi ? rr[0] : rr[1]); }
                float sp = R;
#pragma unroll
                for (int i = 7; i >= 0; --i) { T[i] = sp + (hi ? 0.f : part[i]); sp += own[i] + part[i]; }
                R = sp;
#pragma unroll
                for (int i = 0; i < 4; ++i) {
                    { const float e3 = T[i], e2 = e3 + s0[4 * i + 3], e1 = e2 + s0[4 * i + 2], e0 = e1 + s0[4 * i + 1];
                      p0[4 * i] = __builtin_amdgcn_exp2f(p0[4 * i] - e0); p0[4 * i + 1] = __builtin_amdgcn_exp2f(p0[4 * i + 1] - e1); p0[4 * i + 2] = __builtin_amdgcn_exp2f(p0[4 * i + 2] - e2); p0[4 * i + 3] = __builtin_amdgcn_exp2f(p0[4 * i + 3] - e3); }
                    { const float e3 = T[4 + i], e2 = e3 + s1[4 * i + 3], e1 = e2 + s1[4 * i + 2], e0 = e1 + s1[4 * i + 1];
                      p1[4 * i] = __builtin_amdgcn_exp2f(p1[4 * i] - e0); p1[4 * i + 1] = __builtin_amdgcn_exp2f(p1[4 * i + 1] - e1); p1[4 * i + 2] = __builtin_amdgcn_exp2f(p1[4 * i + 2] - e2); p1[4 * i + 3] = __builtin_amdgcn_exp2f(p1[4 * i + 3] - e3); } }
                n2_pv(o0, o1, lds + slot * N2_SLOT + 8192, p0, p1, lane);
            }
            if (jn >= 0) N2_STORE(slot ^ 1, kreg, vreg);
            const bool wdone = __all(R > 175.f);
            if (lane == 0) FLG[(iter & 1) * 8 + wid] = wdone ? 1u : 0u;
            __syncthreads();
            if (jn < 0) break;
            unsigned nd = 0u;
#pragma unroll
            for (int w = 0; w < 8; ++w) nd += FLG[(iter & 1) * 8 + w];
            if (__builtin_amdgcn_readfirstlane((int)nd) == 8) break;
            j = jn; slot ^= 1; ++iter;
        }
        { unsigned char* orow = (unsigned char*)ATT + ((long)(bh >> 3) * S + t) * 1024 + (bh & 7) * 64;
#pragma unroll
          for (int gi = 0; gi < 4; ++gi) {
              *(unsigned*)(orow + 8 * gi + 4 * hi) = pk4_fp8(o0[4 * gi] * A8_SCALE, o0[4 * gi + 1] * A8_SCALE, o0[4 * gi + 2] * A8_SCALE, o0[4 * gi + 3] * A8_SCALE);
              *(unsigned*)(orow + 32 + 8 * gi + 4 * hi) = pk4_fp8(o1[4 * gi] * A8_SCALE, o1[4 * gi + 1] * A8_SCALE, o1[4 * gi + 2] * A8_SCALE, o1[4 * gi + 3] * A8_SCALE); } }
    }
#undef N2_LOAD
#undef N2_STORE
}

__device__ __forceinline__ float gelu_fast(float v) { const float u = 0.7978845608028654f * (v + 0.044715f * v * v * v); return v * __builtin_amdgcn_rcpf(1.0f + __builtin_amdgcn_exp2f(-2.8853900817779268f * u)); }
__device__ __forceinline__ float xhalf_other(float v) { float a = v, b = v; asm volatile("s_nop 4\n\tv_permlane32_swap_b32 %0, %1\n\ts_nop 4" : "+v"(a), "+v"(b)); return (threadIdx.x & 32) ? a : b; }
__device__ __forceinline__ void xhalf_other8(const float (&v)[8], float (&o)[8]) {
    float a0 = v[0], a1 = v[1], a2 = v[2], a3 = v[3], a4 = v[4], a5 = v[5], a6 = v[6], a7 = v[7], b0 = a0, b1 = a1, b2 = a2, b3 = a3, b4 = a4, b5 = a5, b6 = a6, b7 = a7;
    asm volatile("s_nop 4\n\tv_permlane32_swap_b32 %0, %8\n\tv_permlane32_swap_b32 %1, %9\n\tv_permlane32_swap_b32 %2, %10\n\tv_permlane32_swap_b32 %3, %11\n\tv_permlane32_swap_b32 %4, %12\n\tv_permlane32_swap_b32 %5, %13\n\tv_permlane32_swap_b32 %6, %14\n\tv_permlane32_swap_b32 %7, %15\n\ts_nop 4"
                 : "+v"(a0), "+v"(a1), "+v"(a2), "+v"(a3), "+v"(a4), "+v"(a5), "+v"(a6), "+v"(a7), "+v"(b0), "+v"(b1), "+v"(b2), "+v"(b3), "+v"(b4), "+v"(b5), "+v"(b6), "+v"(b7));
    const bool up = (threadIdx.x & 32) != 0;
    o[0] = up ? a0 : b0; o[1] = up ? a1 : b1; o[2] = up ? a2 : b2; o[3] = up ? a3 : b3; o[4] = up ? a4 : b4; o[5] = up ? a5 : b5; o[6] = up ? a6 : b6; o[7] = up ? a7 : b7;
}
constexpr int S5B_ROW = 72, S5B_LDS_PER = 128 * S5B_ROW;
static_assert(8 * S5B_LDS_PER <= GEMM_LDS, "s5 lds");
__device__ __forceinline__ float opq(float v) { asm("" : "+v"(v)); return v; }
__device__ __forceinline__ void ph_s5b(const P& p, unsigned char* lds_, bf16* YS) {
    int tid = threadIdx.x; asm volatile("" : "+v"(tid));
    const int lane = tid & 63, wid = __builtin_amdgcn_readfirstlane(tid >> 6), r32 = lane & 31, hi = lane >> 5;
    LAS unsigned char* HB = (LAS unsigned char*)lds_ + wid * S5B_LDS_PER;
    const bf16* U = WSP(bf16, C_U);
    const bf16* BT = WSP(bf16, O_S5BT); const bf16* CTB = WSP(bf16, O_S5CT); const float* APW = WSP(float, O_S5AP);
    const LAS unsigned char* hrd = HB + (8 * hi + ((lane & 15) >> 2)) * S5B_ROW + (((lane >> 4) & 1) * 16 + (lane & 3) * 4) * 2;
    for (int item = blockIdx.x * 4 + wid; wid < 4 && item < NB * NG; item += p.grid * 4) {
        const int g = item % NG; const long b = item / NG;
        const bf16* btp = BT + ((long)g * 128 + r32) * 16 + 8 * hi;
        const bf16* cfp = CTB + ((long)g * 32 + r32) * 128 + 8 * hi;
        float ap[2][8];
#pragma unroll
        for (int s = 0; s < 2; ++s)
#pragma unroll
            for (int k = 0; k < 8; ++k) ap[s][k] = APW[((long)g * 64 + 32 * s + r32) * 8 + k];
        float hs[2][2] = {{0.f, 0.f}, {0.f, 0.f}};
        const bf16* urow = U + ((long)b * S + r32) * DM + g * 16;
        bf16x8_t uf = *(const bf16x8_t*)(urow + 8 * hi);
        bf16x8_t btf[4];
#pragma unroll
        for (int ct = 0; ct < 4; ++ct) btf[ct] = *(const bf16x8_t*)(btp + ct * 512);
        unsigned pend0 = 0u, pend1 = 0u; unsigned char* pend_row = (unsigned char*)YS;
#pragma nounroll
        for (int c = 0; c < S / 32; ++c) {
            const bf16* ucur = urow + (long)c * 32 * DM;
            const int cn = (c + 1 < S / 32) ? c + 1 : c;
            bf16x8_t cfa[2];
#pragma unroll
            for (int ks = 0; ks < 2; ++ks) cfa[ks] = *(const bf16x8_t*)(cfp + 16 * ks);
            const u32x2_t uq0 = *(const u32x2_t*)(ucur + 4 * hi), uq1 = *(const u32x2_t*)(ucur + 8 + 4 * hi);
            const bf16x8_t ufn = *(const bf16x8_t*)(urow + (long)cn * 32 * DM + 8 * hi);
            if (c > 0) { *(unsigned*)(pend_row + 4 * hi) = pend0; *(unsigned*)(pend_row + 8 + 4 * hi) = pend1; }
            f32x16_t x[4], z16;
#pragma unroll
            for (int r = 0; r < 16; ++r) z16[r] = 0.f;
            asm volatile("" : "+v"(z16));
#pragma unroll
            for (int ct = 0; ct < 4; ++ct) x[ct] = __builtin_amdgcn_mfma_f32_32x32x16_bf16(uf, btf[ct], z16, 0, 0, 0);
#pragma unroll
            for (int s = 0; s < 2; ++s) {
                f32x16_t& xr = x[s]; f32x16_t& xi = x[2 + s];
                const float ar = ap[s][0], ai = ap[s][1], a4r = ap[s][6], a4i = ap[s][7];
                float er[4], ei[4], pr[4], pi[4], cgr[4], cgi[4];
#pragma unroll
                for (int gi = 0; gi < 4; ++gi) {
#pragma unroll
                    for (int k = 1; k < 4; ++k) { const float nr = opq(__builtin_fmaf(-ai, xi[4 * gi + k - 1], opq(__builtin_fmaf(ar, xr[4 * gi + k - 1], xr[4 * gi + k])))), ni = opq(__builtin_fmaf(ai, xr[4 * gi + k - 1], opq(__builtin_fmaf(ar, xi[4 * gi + k - 1], xi[4 * gi + k])))); xr[4 * gi + k] = nr; xi[4 * gi + k] = ni; }
                    er[gi] = xr[4 * gi + 3]; ei[gi] = xi[4 * gi + 3]; }
#pragma unroll
                for (int gi = 0; gi < 4; ++gi) { pr[gi] = 0.f; pi[gi] = 0.f; }
                { const float vin[8] = {er[0], er[1], er[2], er[3], ei[0], ei[1], ei[2], ei[3]}; float vout[8]; xhalf_other8(vin, vout);
#pragma unroll
                  for (int gi = 0; gi < 4; ++gi) { pr[gi] = vout[gi]; pi[gi] = vout[4 + gi]; } }
                float cr = hs[s][0], ci = hs[s][1];
#pragma unroll
                for (int gi = 0; gi < 4; ++gi) {
                    const float evr = hi ? pr[gi] : er[gi], evi = hi ? pi[gi] : ei[gi], odr = hi ? er[gi] : pr[gi], odi = hi ? ei[gi] : pi[gi];
                    const float c0r = cr, c0i = ci;
                    float nr = opq(__builtin_fmaf(-a4i, ci, opq(__builtin_fmaf(a4r, cr, evr)))), ni = opq(__builtin_fmaf(a4i, cr, opq(__builtin_fmaf(a4r, ci, evi)))); cr = nr; ci = ni;
                    cgr[gi] = hi ? cr : c0r; cgi[gi] = hi ? ci : c0i;
                    nr = opq(__builtin_fmaf(-a4i, ci, opq(__builtin_fmaf(a4r, cr, odr)))); ni = opq(__builtin_fmaf(a4i, cr, opq(__builtin_fmaf(a4r, ci, odi)))); cr = nr; ci = ni; }
                hs[s][0] = cr; hs[s][1] = ci;
#pragma unroll
                for (int gi = 0; gi < 4; ++gi)
#pragma unroll
                    for (int k = 0; k < 4; ++k) { const float pwr = ap[s][2 * k], pwi = ap[s][2 * k + 1]; xr[4 * gi + k] = opq(__builtin_fmaf(-pwi, cgi[gi], opq(__builtin_fmaf(pwr, cgr[gi], xr[4 * gi + k])))); xi[4 * gi + k] = opq(__builtin_fmaf(pwi, cgr[gi], opq(__builtin_fmaf(pwr, cgi[gi], xi[4 * gi + k])))); }
            }
#pragma unroll
            for (int ct = 0; ct < 4; ++ct)
#pragma unroll
                for (int gi = 0; gi < 4; ++gi) { u32x2_t w; w.x = cvtpk(x[ct][4 * gi], x[ct][4 * gi + 1]); w.y = cvtpk(x[ct][4 * gi + 2], x[ct][4 * gi + 3]); *(LAS u32x2_t*)(HB + (32 * ct + r32) * S5B_ROW + (8 * gi + 4 * hi) * 2) = w; }
            const float4 dka = *(const float4*)(p.in[I_DSK] + g * 16 + 4 * hi), dkb = *(const float4*)(p.in[I_DSK] + g * 16 + 8 + 4 * hi);
            asm volatile("s_waitcnt lgkmcnt(0)" ::: "memory");
            f32x16_t y;
#pragma unroll
            for (int r = 0; r < 16; ++r) y[r] = 0.f;
            asm volatile("" : "+v"(y));
#pragma unroll
            for (int ks = 0; ks < 8; ++ks) {
                const s16x4_t lo = __builtin_bit_cast(s16x4_t, __builtin_amdgcn_ds_read_tr16_b64_v4i16((LAS s16x4_t*)(hrd + (16 * ks) * S5B_ROW)));
                const s16x4_t hh = __builtin_bit_cast(s16x4_t, __builtin_amdgcn_ds_read_tr16_b64_v4i16((LAS s16x4_t*)(hrd + (16 * ks + 4) * S5B_ROW)));
                const bf16x8_t hf = (bf16x8_t){lo[0], lo[1], lo[2], lo[3], hh[0], hh[1], hh[2], hh[3]};
                const bf16x8_t cfk = ks < 2 ? cfa[ks] : *(const bf16x8_t*)(cfp + 16 * ks);
                y = __builtin_amdgcn_mfma_f32_32x32x16_bf16(cfk, hf, y, 0, 0, 0); }
#pragma unroll
            for (int ct = 0; ct < 4; ++ct) btf[ct] = *(const bf16x8_t*)(btp + ct * 512);
            asm volatile("s_waitcnt lgkmcnt(0)" ::: "memory");
            { unsigned char* yrow = (unsigned char*)YS + ((long)b * S + c * 32 + r32) * DM + g * 16; float dk[8];
              { dk[0] = dka.x; dk[1] = dka.y; dk[2] = dka.z; dk[3] = dka.w; dk[4] = dkb.x; dk[5] = dkb.y; dk[6] = dkb.z; dk[7] = dkb.w; }
              const float u0 = bf2f((bf16)(uq0.x & 0xffffu)), u1 = bf2f((bf16)(uq0.x >> 16)), u2 = bf2f((bf16)(uq0.y & 0xffffu)), u3 = bf2f((bf16)(uq0.y >> 16));
              const float u4 = bf2f((bf16)(uq1.x & 0xffffu)), u5 = bf2f((bf16)(uq1.x >> 16)), u6 = bf2f((bf16)(uq1.y & 0xffffu)), u7 = bf2f((bf16)(uq1.y >> 16));
              pend0 = pk4_fp8(gelu_fast(y[0] + dk[0] * u0) * A8_SCALE, gelu_fast(y[1] + dk[1] * u1) * A8_SCALE, gelu_fast(y[2] + dk[2] * u2) * A8_SCALE, gelu_fast(y[3] + dk[3] * u3) * A8_SCALE);
              pend1 = pk4_fp8(gelu_fast(y[4] + dk[4] * u4) * A8_SCALE, gelu_fast(y[5] + dk[5] * u5) * A8_SCALE, gelu_fast(y[6] + dk[6] * u6) * A8_SCALE, gelu_fast(y[7] + dk[7] * u7) * A8_SCALE); pend_row = yrow; }
            uf = ufn;
        }
        *(unsigned*)(pend_row + 4 * hi) = pend0; *(unsigned*)(pend_row + 8 + 4 * hi) = pend1;
    }
}
#endif


#ifndef HOST_EMU
__device__ __forceinline__ void ph_xpose8(const XposeJob j, unsigned char* lds_, int rank = -1, int nranks = 0) {
    LAS unsigned char* tile = (LAS unsigned char*)lds_;
    int tid = threadIdx.x; asm volatile("" : "+v"(tid));
    const int tk = j.K / 64, tn = j.Ncover / 256, per = tk * tn;
    if (rank < 0) { rank = ((int)blockIdx.x - j.first + j.grid) % j.grid; nranks = j.grid; }
    for (int item = rank; item < per * j.batch; item += nranks) {
        const int bt = item / per, it = item % per, k0 = (it / tn) * 64, n0 = (it % tn) * 256;
        const float* src = j.src + (long)bt * j.sstride + (long)k0 * j.N + n0; unsigned char* dst = (unsigned char*)j.dst + (long)bt * j.dstride + k0;
#pragma unroll
        for (int i = 0; i < 2; ++i) { const int e = tid + 512 * i, k4 = (e >> 6) * 4, n4 = (e & 63) * 4;
            float4 q0 = make_float4(0.f, 0.f, 0.f, 0.f), q1 = q0, q2 = q0, q3 = q0;
            if (n0 + n4 < j.N) { q0 = *(const float4*)(src + (long)(k4 + 0) * j.N + n4); q1 = *(const float4*)(src + (long)(k4 + 1) * j.N + n4); q2 = *(const float4*)(src + (long)(k4 + 2) * j.N + n4); q3 = *(const float4*)(src + (long)(k4 + 3) * j.N + n4); }
            *(LAS unsigned*)(tile + (n4 + 0) * 80 + k4) = pk4_fp8(q0.x * W8_SCALE, q1.x * W8_SCALE, q2.x * W8_SCALE, q3.x * W8_SCALE);
            *(LAS unsigned*)(tile + (n4 + 1) * 80 + k4) = pk4_fp8(q0.y * W8_SCALE, q1.y * W8_SCALE, q2.y * W8_SCALE, q3.y * W8_SCALE);
            *(LAS unsigned*)(tile + (n4 + 2) * 80 + k4) = pk4_fp8(q0.z * W8_SCALE, q1.z * W8_SCALE, q2.z * W8_SCALE, q3.z * W8_SCALE);
            *(LAS unsigned*)(tile + (n4 + 3) * 80 + k4) = pk4_fp8(q0.w * W8_SCALE, q1.w * W8_SCALE, q2.w * W8_SCALE, q3.w * W8_SCALE); }
        __syncthreads();
#pragma unroll
        for (int i = 0; i < 2; ++i) { const int e = tid + 512 * i, nn = e >> 2, c16 = (e & 3) * 16, n = n0 + nn; const long row = (long)(n / j.il) * j.il2 + (n % j.il) + j.add;
            *(u32x4_t*)(dst + row * j.K + c16) = *(const LAS u32x4_t*)(tile + nn * 80 + c16); }
        __syncthreads();
    }
}
__device__ __forceinline__ void xpose_wave8(const XposeJob j, LAS unsigned char* tl, int wave_rank, int n_waves, int lane) {
    const int tk = j.K / 64, tn = j.Ncover / 64, per = tk * tn;
    for (int item = wave_rank; item < per * j.batch; item += n_waves) {
        const int bt = item / per, it = item % per, k0 = (it / tn) * 64, n0 = (it % tn) * 64;
        const float* src = j.src + (long)bt * j.sstride + (long)k0 * j.N + n0; unsigned char* dst = (unsigned char*)j.dst + (long)bt * j.dstride + k0;
#pragma unroll
        for (int i = 0; i < 4; ++i) { const int e = lane + 64 * i, k4 = (e >> 4) * 4, n4 = (e & 15) * 4;
            const float4 q0 = *(const float4*)(src + (long)(k4 + 0) * j.N + n4), q1 = *(const float4*)(src + (long)(k4 + 1) * j.N + n4), q2 = *(const float4*)(src + (long)(k4 + 2) * j.N + n4), q3 = *(const float4*)(src + (long)(k4 + 3) * j.N + n4);
            *(LAS unsigned*)(tl + (n4 + 0) * 80 + k4) = pk4_fp8(q0.x * W8_SCALE, q1.x * W8_SCALE, q2.x * W8_SCALE, q3.x * W8_SCALE);
            *(LAS unsigned*)(tl + (n4 + 1) * 80 + k4) = pk4_fp8(q0.y * W8_SCALE, q1.y * W8_SCALE, q2.y * W8_SCALE, q3.y * W8_SCALE);
            *(LAS unsigned*)(tl + (n4 + 2) * 80 + k4) = pk4_fp8(q0.z * W8_SCALE, q1.z * W8_SCALE, q2.z * W8_SCALE, q3.z * W8_SCALE);
            *(LAS unsigned*)(tl + (n4 + 3) * 80 + k4) = pk4_fp8(q0.w * W8_SCALE, q1.w * W8_SCALE, q2.w * W8_SCALE, q3.w * W8_SCALE); }
        asm volatile("s_waitcnt lgkmcnt(0)" ::: "memory");
#pragma unroll
        for (int i = 0; i < 4; ++i) { const int e = lane + 64 * i, nn = e >> 2, c16 = (e & 3) * 16, n = n0 + nn; const long row = (long)(n / j.il) * j.il2 + (n % j.il) + j.add;
            *(u32x4_t*)(dst + row * j.K + c16) = *(const LAS u32x4_t*)(tl + nn * 80 + c16); }
        asm volatile("s_waitcnt lgkmcnt(0)" ::: "memory");
    }
}
__device__ __forceinline__ void xpose_wave(const XposeJob j, LAS unsigned char* tl, int wave_rank, int n_waves, int lane) {
    const int tk = j.K / 64, tn = j.Ncover / 64, per = tk * tn;
    for (int item = wave_rank; item < per * j.batch; item += n_waves) {
        const int bt = item / per, it = item % per, k0 = (it / tn) * 64, n0 = (it % tn) * 64;
        const float* src = j.src + (long)bt * j.sstride + (long)k0 * j.N + n0; bf16* dst = j.dst + (long)bt * j.dstride + k0;
#pragma unroll
        for (int i = 0; i < 4; ++i) { const int e = lane + 64 * i, k4 = (e >> 4) * 4, n4 = (e & 15) * 4;
            const float4 q0 = *(const float4*)(src + (long)(k4 + 0) * j.N + n4), q1 = *(const float4*)(src + (long)(k4 + 1) * j.N + n4), q2 = *(const float4*)(src + (long)(k4 + 2) * j.N + n4), q3 = *(const float4*)(src + (long)(k4 + 3) * j.N + n4);
            u32x2_t w;
            w.x = (unsigned)f2bf(q0.x) | ((unsigned)f2bf(q1.x) << 16); w.y = (unsigned)f2bf(q2.x) | ((unsigned)f2bf(q3.x) << 16); *(LAS u32x2_t*)(tl + ((n4 + 0) * 72 + k4) * 2) = w;
            w.x = (unsigned)f2bf(q0.y) | ((unsigned)f2bf(q1.y) << 16); w.y = (unsigned)f2bf(q2.y) | ((unsigned)f2bf(q3.y) << 16); *(LAS u32x2_t*)(tl + ((n4 + 1) * 72 + k4) * 2) = w;
            w.x = (unsigned)f2bf(q0.z) | ((unsigned)f2bf(q1.z) << 16); w.y = (unsigned)f2bf(q2.z) | ((unsigned)f2bf(q3.z) << 16); *(LAS u32x2_t*)(tl + ((n4 + 2) * 72 + k4) * 2) = w;
            w.x = (unsigned)f2bf(q0.w) | ((unsigned)f2bf(q1.w) << 16); w.y = (unsigned)f2bf(q2.w) | ((unsigned)f2bf(q3.w) << 16); *(LAS u32x2_t*)(tl + ((n4 + 3) * 72 + k4) * 2) = w; }
        asm volatile("s_waitcnt lgkmcnt(0)" ::: "memory");
#pragma unroll 4
        for (int i = 0; i < 8; ++i) { const int e = lane + 64 * i, nn = e >> 3, c8 = (e & 7) * 8, n = n0 + nn; const long row = (long)(n / j.il) * j.il2 + (n % j.il) + j.add;
            *(u32x4_t*)(dst + row * j.K + c8) = *(const LAS u32x4_t*)(tl + (nn * 72 + c8) * 2); }
        asm volatile("s_waitcnt lgkmcnt(0)" ::: "memory");
    }
}
template <int L> __device__ __forceinline__ void ph_xpose_side(const P& p, unsigned char* lds_) {
    int tid = threadIdx.x; asm volatile("" : "+v"(tid));
    const int lane = tid & 63, wid = __builtin_amdgcn_readfirstlane(tid >> 6);
    if (wid < 4) return;
    LAS unsigned char* tl = (LAS unsigned char*)lds_ + 40960 + (wid - 4) * 9216;
    const int wr_ = (int)blockIdx.x * 4 + (wid - 4), nw = p.grid * 4; constexpr int mi = MOE_IN0[L];
    xpose_wave8(mk_xpose(p.in[mi + 2], WSP(bf16, O_WT_GU), DM, 256, 256, GU_IL, 2 * GU_IL, 0, 64, (long)DM * 256, (long)512 * DM), tl, wr_, nw, lane);
    xpose_wave8(mk_xpose(p.in[mi + 3], WSP(bf16, O_WT_GU), DM, 256, 256, GU_IL, 2 * GU_IL, GU_IL, 64, (long)DM * 256, (long)512 * DM), tl, wr_, nw, lane);
    xpose_wave8(mk_xpose(p.in[mi + 4], WSP(bf16, O_WT_D), 256, DM, DM, DM, 0, 0, 64, (long)256 * DM, (long)DM * 256), tl, wr_, nw, lane);
}
static_assert(4 * S5B_LDS_PER <= 40960 && 40960 + 4 * 9216 <= GEMM_LDS, "s5 side lds");
#endif
constexpr int ROUTE_LDS = 256 * 72 * 4 + 128 * 4 + 256 * 6 * 4;
constexpr int MEGA_LDS_PH = GEMM_LDS;
static_assert(MEGA_LDS_PH >= 2 * NSA_LDS_PER && MEGA_LDS_PH >= 8 * S5_LDS_PER && MEGA_LDS_PH >= 2 * LN_LDS_PER && MEGA_LDS_PH >= ROUTE_LDS && MEGA_LDS_PH >= 256 * 72 * 2, "LDS map");
constexpr int MEGA_LDS = MEGA_LDS_PH + 256 + GEMM_TE_LDS;

#ifndef HOST_EMU
__device__ __forceinline__ void ph_te_load(const int* te, unsigned char* lds_) {
    int t2 = threadIdx.x; asm volatile("" : "+v"(t2));
    for (int i = t2; i < MOE_TILES; i += NTHR) *(LAS int*)((LAS unsigned char*)lds_ + GEMM_LDS + 4 * i) = te[i];
    __syncthreads();
}
#endif
template <int L, int CH> __device__ __forceinline__ void moe_chunk(PROGRAM_ARGS) {
    bf16* const PREB = (L == 0) ? (bf16*)p.out : WSP(bf16, O_H2);
    const int mi = MOE_IN0[L]; const bf16* hin = WSP(bf16, O_H);
    PHASE_BEGIN ph_place(p, L, CH, lds); PHASE_END
#ifndef HOST_EMU
    PHASE_BEGIN { GemmArgs g = mk_gemm(WSP(bf16, B_H8), DM / 2, WSP(bf16, O_WT_GU), MOE_ROWS, 512, DM / 2); g.rowidx = WSP(int, B_ROWTOK); g.tile_e = WSP(int, O_TILEE); g.m_rt = WSP(int, O_PADSTART) + 64; g.b_estride = (long)512 * DM / 2; EpiSwiglu8 e{WSP(unsigned char, B_AEX)}; ph_te_load(WSP(int, O_TILEE), lds); ph_gemm<EpiSwiglu8, true, true>(g, e, lds); } PHASE_END
    PHASE_BEGIN { GemmArgs g = mk_gemm(WSP(bf16, B_AEX), 128, WSP(bf16, O_WT_D), MOE_ROWS, DM, 128); g.tile_e = WSP(int, O_TILEE); g.m_rt = WSP(int, O_PADSTART) + 64; g.b_estride = (long)DM * 128; EpiY8 e{WSP(unsigned char, B_Y), DM, F8_ACC_INV}; ph_gemm<EpiY8, true, true>(g, e, lds); } PHASE_END
#else
    PHASE_BEGIN { GemmArgs g = mk_gemm(hin, DM, WSP(bf16, O_WT_GU), MOE_ROWS, 512, DM); g.rowidx = WSP(int, B_ROWTOK); g.tile_e = WSP(int, O_TILEE); g.m_rt = WSP(int, O_PADSTART) + 64; g.b_estride = (long)512 * DM; EpiSwiglu e{WSP(bf16, B_AEX)}; ph_gemm(g, e, lds); } PHASE_END
    PHASE_BEGIN { GemmArgs g = mk_gemm(WSP(bf16, B_AEX), 256, WSP(bf16, O_WT_D), MOE_ROWS, DM, 256); g.tile_e = WSP(int, O_TILEE); g.m_rt = WSP(int, O_PADSTART) + 64; g.b_estride = (long)DM * 256; EpiY e{WSP(unsigned char, B_Y), WSP(float, B_ROWGATE), DM}; ph_gemm(g, e, lds); } PHASE_END
#endif
    PHASE_BEGIN
        { LnJob j; j.grid = p.grid; j.pad = 0; j.pre = p.out; j.preb = PREB; j.y = WSP(unsigned char, B_Y); j.pos = WSP(int, B_POS); j.g = p.in[mi + 8];
#ifndef HOST_EMU
          j.gate = WSP(float, B_GATE);
#else
          j.gate = nullptr;
#endif
          j.b = p.in[mi + 9]; j.t_beg = (long)CH * TC; j.t_cnt = TC;
          j.obf = (L == 0) ? WSP(bf16, O_H2) : nullptr; j.of32 = (L == 0) ? nullptr : p.out; j.of8 = (L == 0) ? WSP(unsigned char, B_H28) : nullptr; ph_ln(j, lds); }
        if (CH + 1 < NCH) ph_route(p, L, CH + 1, lds);
    PHASE_END
}
template <int L> __device__ __forceinline__ void moe_layer(PROGRAM_ARGS) {
    bf16* const PREB = (L == 0) ? (bf16*)p.out : WSP(bf16, O_H2);
    const int mi = MOE_IN0[L]; const bf16* hin = WSP(bf16, O_H);
    PHASE_BEGIN
        { GemmArgs g = mk_gemm(hin, DM, WSP(bf16, O_WT_R) + (size_t)L * 256 * DM, T, 256, DM); EpiLogit e{WSP(float, B_LOGIT)}; ph_gemm(g, e, lds); }
#ifndef HOST_EMU
        { GemmArgs g = mk_gemm(WSP(bf16, B_H8), DM / 2, (const bf16*)(WSP(unsigned char, O_WT_SGU) + (size_t)L * 512 * DM), T, 512, DM / 2); EpiSwiglu8 e{WSP(unsigned char, B_ASH)}; ph_gemm<EpiSwiglu8, true>(g, e, lds); }
#else
        { GemmArgs g = mk_gemm(hin, DM, WSP(bf16, O_WT_SGU) + (size_t)L * 512 * DM, T, 512, DM); EpiSwiglu e{WSP(bf16, B_ASH)}; ph_gemm(g, e, lds); }
#endif
    PHASE_END
    PHASE_BEGIN
#ifndef HOST_EMU
        { GemmArgs g = mk_gemm(WSP(bf16, B_ASH), 128, (const bf16*)(WSP(unsigned char, O_WT_SD) + (size_t)L * DM * 256), T, DM, 128); EpiResBfT<true> e{p.out, PREB, hin, DM}; e.sc = F8_ACC_INV; ph_gemm<EpiResBfT<true>, true>(g, e, lds); }
#else
        { GemmArgs g = mk_gemm(WSP(bf16, B_ASH), 256, WSP(bf16, O_WT_SD) + (size_t)L * DM * 256, T, DM, 256); EpiResBfT<true> e{p.out, PREB, hin, DM}; ph_gemm(g, e, lds); }
#endif
        ph_route(p, L, 0, lds);
    PHASE_END
    (void)mi;
    moe_chunk<L, 0>(p, lds, gbar);
    if constexpr (NCH == 2) moe_chunk<L, 1>(p, lds, gbar);
}
template <int L> __device__ __forceinline__ void xpose_experts(const P& p, unsigned char* lds, int rank = -1, int nranks = 0) {
    constexpr int mi = MOE_IN0[L];
#ifndef HOST_EMU
#define XPOSE_EXP(j_) ph_xpose8(j_, lds, rank, nranks)
#else
#define XPOSE_EXP(j_) ph_xpose(j_, lds)
    (void)rank; (void)nranks;
#endif
    XPOSE_EXP(mk_xpose(p.in[mi + 2], WSP(bf16, O_WT_GU), DM, 256, 256, GU_IL, 2 * GU_IL, 0, 64, (long)DM * 256, (long)512 * DM));
    XPOSE_EXP(mk_xpose(p.in[mi + 3], WSP(bf16, O_WT_GU), DM, 256, 256, GU_IL, 2 * GU_IL, GU_IL, 64, (long)DM * 256, (long)512 * DM));
    XPOSE_EXP(mk_xpose(p.in[mi + 4], WSP(bf16, O_WT_D), 256, DM, DM, DM, 0, 0, 64, (long)256 * DM, (long)DM * 256));
#undef XPOSE_EXP
}
__device__ __forceinline__ void program(PROGRAM_ARGS) {
    bf16* const PREB = (bf16*)p.out;
    PHASE_BEGIN
        int xo = 0;
#define XP(fn_, job_) do { XposeJob j_ = job_; j_.first = xo % p.grid; xo += (j_.K / 64) * ((j_.Ncover + 255) / 256) * j_.batch; fn_(j_, lds); } while (0)
#ifndef HOST_EMU
        XP(ph_xpose8, mk_xpose(p.in[I_L0_WIN], WSP(bf16, O_WT_IN0), DM, PROJ_N, PROJ_NP, PROJ_NP, 0, 0, 1, 0, 0));
        { int t8 = threadIdx.x; asm volatile("" : "+v"(t8));
          for (long i = ((long)blockIdx.x * NTHR + t8) * 8; i < (long)T * DM; i += (long)p.grid * NTHR * 8) { const f8 a = ld_f8(p.in[I_X] + i);
              uint2 w; w.x = pk4_fp8(a.v[0] * A8_SCALE, a.v[1] * A8_SCALE, a.v[2] * A8_SCALE, a.v[3] * A8_SCALE); w.y = pk4_fp8(a.v[4] * A8_SCALE, a.v[5] * A8_SCALE, a.v[6] * A8_SCALE, a.v[7] * A8_SCALE); *(uint2*)(WSP(unsigned char, O_H) + i) = w; } }
#else
        XP(ph_xpose, mk_xpose(p.in[I_L0_WIN], WSP(bf16, O_WT_IN0), DM, PROJ_N, PROJ_NP, PROJ_NP, 0, 0, 1, 0, 0));
        ph_cvt(p, p.in[I_X], WSP(bf16, O_H), (long)T * DM);
#endif
        XP(ph_xpose, mk_xpose(p.in[I_KW1], WSP(bf16, O_WT_K1), 2048, 256, 256, 256, 0, 0, 1, 0, 0));
        XP(ph_xpose, mk_xpose(p.in[I_VW1], WSP(bf16, O_WT_V1), 2048, 256, 256, 256, 0, 0, 1, 0, 0));
#ifndef HOST_EMU
        XP(ph_xpose8, mk_xpose(p.in[I_L0_WOUT], WSP(bf16, O_WT_OUT0), 1024, DM, DM, DM, 0, 0, 1, 0, 0));
#else
        XP(ph_xpose, mk_xpose(p.in[I_L0_WOUT], WSP(bf16, O_WT_OUT0), 1024, DM, DM, DM, 0, 0, 1, 0, 0));
#endif
        XP(ph_xpose, mk_xpose(p.in[I_KW2], WSP(bf16, O_WT_K2), 256, 64, 256, 256, 0, 0, 1, 0, 0));
        XP(ph_xpose, mk_xpose(p.in[I_VW2], WSP(bf16, O_WT_K2) + 256 * 256, 256, 64, 256, 256, 0, 0, 1, 0, 0));
#pragma unroll
        for (int l = 0; l < 2; ++l) { const int mi = (l == 0) ? I_L0_ROUTER : I_L1_ROUTER;
            XP(ph_xpose, mk_xpose(p.in[mi], WSP(bf16, O_WT_R) + (size_t)l * 256 * DM, DM, 64, 256, 256, 0, 0, 1, 0, 0));
#ifndef HOST_EMU
            XP(ph_xpose8, mk_xpose(p.in[mi + 5], (bf16*)(WSP(unsigned char, O_WT_SGU) + (size_t)l * 512 * DM), DM, 256, 256, GU_IL, 2 * GU_IL, 0, 1, 0, 0));
            XP(ph_xpose8, mk_xpose(p.in[mi + 6], (bf16*)(WSP(unsigned char, O_WT_SGU) + (size_t)l * 512 * DM), DM, 256, 256, GU_IL, 2 * GU_IL, GU_IL, 1, 0, 0));
            XP(ph_xpose8, mk_xpose(p.in[mi + 7], (bf16*)(WSP(unsigned char, O_WT_SD) + (size_t)l * DM * 256), 256, DM, DM, DM, 0, 0, 1, 0, 0)); }
#else
            XP(ph_xpose, mk_xpose(p.in[mi + 5], WSP(bf16, O_WT_SGU) + (size_t)l * 512 * DM, DM, 256, 256, GU_IL, 2 * GU_IL, 0, 1, 0, 0));
            XP(ph_xpose, mk_xpose(p.in[mi + 6], WSP(bf16, O_WT_SGU) + (size_t)l * 512 * DM, DM, 256, 256, GU_IL, 2 * GU_IL, GU_IL, 1, 0, 0));
            XP(ph_xpose, mk_xpose(p.in[mi + 7], WSP(bf16, O_WT_SD) + (size_t)l * DM * 256, 256, DM, DM, DM, 0, 0, 1, 0, 0)); }
#endif
#ifndef HOST_EMU
        XP(ph_xpose8, mk_xpose(p.in[I_L1_WIN], WSP(bf16, O_WT_IN1), DM, DM, DM, DM, 0, 0, 1, 0, 0));
#else
        XP(ph_xpose, mk_xpose(p.in[I_L1_WIN], WSP(bf16, O_WT_IN1), DM, DM, DM, DM, 0, 0, 1, 0, 0));
#endif
#ifndef HOST_EMU
        XP(ph_xpose8, mk_xpose(p.in[I_WGLU], WSP(bf16, O_WT_GLU), DM, DM, DM, DM, 0, 0, 1, 0, 0));
#else
        XP(ph_xpose, mk_xpose(p.in[I_WGLU], WSP(bf16, O_WT_GLU), DM, DM, DM, DM, 0, 0, 1, 0, 0));
#endif
#ifndef HOST_EMU
        XP(ph_xpose8, mk_xpose(p.in[I_L1_WOUT], WSP(bf16, O_WT_OUT1), DM, DM, DM, DM, 0, 0, 1, 0, 0));
#else
        XP(ph_xpose, mk_xpose(p.in[I_L1_WOUT], WSP(bf16, O_WT_OUT1), DM, DM, DM, DM, 0, 0, 1, 0, 0));
#endif
#undef XP
        ph_tables(p);
#ifdef HOST_EMU
        xpose_experts<0>(p, lds);
#endif
    PHASE_END
#ifndef HOST_EMU
    PHASE_BEGIN ph_bias_finish(p); { GemmArgs g = mk_gemm(WSP(bf16, O_H), DM / 2, WSP(bf16, O_WT_IN0), T, PROJ_NP, DM / 2); EpiProj0R e{p.ws, F8_ACC_INV}; ph_gemm<EpiProj0R, true>(g, e, lds); } PHASE_END
#else
    PHASE_BEGIN { GemmArgs g = mk_gemm(WSP(bf16, O_H), DM, WSP(bf16, O_WT_IN0), T, PROJ_NP, DM); EpiProj0 e{p.ws}; ph_gemm(g, e, lds); } PHASE_END
    PHASE_BEGIN ph_rope(p); ph_bias_finish(p); PHASE_END
#endif
    PHASE_BEGIN
        static_assert(A_VC == A_KC + (size_t)NB * 2 * NCP * 1024 * 2 && O_WT_V1 == O_WT_K1 + (size_t)256 * 2048 * 2 && O_BIASV == O_BIASK + 1024 && (NB * 2 * NCP) % 256 == 0, "batched cmp GEMM: k then v, contiguous");
        { GemmArgs g = mk_gemm(WSP(bf16, A_KC), 1024, WSP(bf16, O_WT_K1), 2 * NB * 2 * NCP, 256, 2048); g.tile_e = WSP(int, O_CMPTE); g.b_estride = (long)256 * 2048; EpiCmp1 e{WSP(bf16, A_HCK), WSP(float, O_BIASK)}; ph_gemm(g, e, lds); }
        { GemmArgs g = mk_gemm(WSP(bf16, A_HCK), 256, WSP(bf16, O_WT_K2), 2 * NB * 2 * NCP, 256, 256); g.tile_e = WSP(int, O_CMPTE); g.b_estride = (long)256 * 256; EpiCmp2 e{WSP(bf16, A_KCMP), WSP(bf16, A_VCMP)}; ph_gemm(g, e, lds); }
#ifndef HOST_EMU
        { constexpr int NCW = 2 * NB * 2 * NCP / 256; if (p.grid > NCW) { if ((int)blockIdx.x >= NCW) xpose_experts<0>(p, lds, (int)blockIdx.x - NCW, p.grid - NCW); } else xpose_experts<0>(p, lds); }
#endif
    PHASE_END
#ifdef HOST_EMU
    PHASE_BEGIN ph_nsa(p, lds); ph_sb(p); PHASE_END
#else
    PHASE_BEGIN ph_nsa2(p, lds); ph_sb2(p, lds); PHASE_END
#endif
#ifndef HOST_EMU
    PHASE_BEGIN { GemmArgs g = mk_gemm(WSP(bf16, A_ATT), 512, WSP(bf16, O_WT_OUT0), T, DM, 512); EpiResF32 e{PREB, p.in[I_X], DM}; e.sc = F8_ACC_INV; ph_gemm<EpiResF32, true>(g, e, lds); } PHASE_END
#else
    PHASE_BEGIN { GemmArgs g = mk_gemm(WSP(bf16, A_ATT), 1024, WSP(bf16, O_WT_OUT0), T, DM, 1024); EpiResF32 e{PREB, p.in[I_X], DM}; ph_gemm(g, e, lds); } PHASE_END
#endif
    PHASE_BEGIN { LnJob j; j.grid = p.grid; j.pad = 0; j.pre = p.out; j.preb = PREB; j.y = nullptr; j.pos = nullptr; j.gate = nullptr; j.g = p.in[I_L0_LN1G]; j.b = p.in[I_L0_LN1B]; j.obf = WSP(bf16, O_H); j.of32 = nullptr; j.of8 = WSP(unsigned char, B_H8); j.t_beg = 0; j.t_cnt = T; ph_ln(j, lds); } PHASE_END
    moe_layer<0>(p, lds, gbar);
    PHASE_BEGIN
#ifndef HOST_EMU
        { GemmArgs g = mk_gemm(WSP(bf16, B_H28), DM / 2, WSP(bf16, O_WT_IN1), T, DM, DM / 2); EpiBf e{WSP(bf16, C_U), DM}; e.sc = F8_ACC_INV; ph_gemm<EpiBf, true>(g, e, lds); }
#else
        { GemmArgs g = mk_gemm(WSP(bf16, O_H2), DM, WSP(bf16, O_WT_IN1), T, DM, DM); EpiBf e{WSP(bf16, C_U), DM}; ph_gemm(g, e, lds); }
#endif
#ifdef HOST_EMU
        xpose_experts<1>(p, lds);
#endif
    PHASE_END
#ifdef HOST_EMU
    PHASE_BEGIN ph_s5(p, lds); PHASE_END
#else
    PHASE_BEGIN ph_s5b(p, lds, WSP(bf16, C_YS)); ph_xpose_side<1>(p, lds); PHASE_END
#endif
#ifndef HOST_EMU
    PHASE_BEGIN { GemmArgs g = mk_gemm(WSP(bf16, C_YS), DM / 2, WSP(bf16, O_WT_GLU), T, DM, DM / 2); EpiGlu8 e{WSP(unsigned char, C_Y2), WSP(unsigned char, C_YS), DM}; ph_gemm<EpiGlu8, true>(g, e, lds); } PHASE_END
    PHASE_BEGIN { GemmArgs g = mk_gemm(WSP(bf16, C_Y2), DM / 2, WSP(bf16, O_WT_OUT1), T, DM, DM / 2); EpiResBfT<true> e{p.out, PREB, WSP(bf16, O_H2), DM}; e.sc = F8_ACC_INV; ph_gemm<EpiResBfT<true>, true>(g, e, lds); } PHASE_END
#else
    PHASE_BEGIN { GemmArgs g = mk_gemm(WSP(bf16, C_YS), DM, WSP(bf16, O_WT_GLU), T, DM, DM); EpiGlu e{WSP(bf16, C_Y2), WSP(bf16, C_YS), DM}; ph_gemm(g, e, lds); } PHASE_END
    PHASE_BEGIN { GemmArgs g = mk_gemm(WSP(bf16, C_Y2), DM, WSP(bf16, O_WT_OUT1), T, DM, DM); EpiResBfT<true> e{p.out, PREB, WSP(bf16, O_H2), DM}; ph_gemm(g, e, lds); } PHASE_END
#endif
    PHASE_BEGIN { LnJob j; j.grid = p.grid; j.pad = 0; j.pre = p.out; j.preb = PREB; j.y = nullptr; j.pos = nullptr; j.gate = nullptr; j.g = p.in[I_L1_LN1G]; j.b = p.in[I_L1_LN1B]; j.obf = WSP(bf16, O_H); j.of32 = nullptr; j.of8 = WSP(unsigned char, B_H8); j.t_beg = 0; j.t_cnt = T; ph_ln(j, lds); } PHASE_END
    moe_layer<1>(p, lds, gbar);
}

#ifndef HOST_EMU
__global__ void __launch_bounds__(512, 2) mega(const P p) {
    LDS_DECL;
    if (threadIdx.x == 0) *(uint4*)lds = make_uint4(0u, 0u, 0u, 0u);
    __syncthreads();
    const XcdBarrier gbar = xcd_barrier_post((unsigned*)(p.ws + O_CTL), (volatile LAS unsigned*)lds, (unsigned)p.grid);
    program(p, lds + 256, gbar);
}
#else
static int hipMemsetAsync(void* p, int v, size_t n, hipStream_t) { memset(p, v, n); return 0; }
#endif

extern "C" void kernel_launch(void* const* d_in, const int* in_sizes, int n_in, void* d_out, int out_size, void* d_ws, size_t ws_size, hipStream_t stream) {
    (void)in_sizes; (void)out_size;
    if (n_in < 44 || ws_size < WS_NEED) return;
    P p; memset(&p, 0, sizeof(p));
    for (int i = 0; i < 44; ++i) p.in[i] = (const float*)d_in[i];
    p.out = (float*)d_out; p.ws = (unsigned char*)d_ws;
    (void)hipMemsetAsync(p.ws + O_CTL, 0, CTL_BYTES, stream);
#ifndef HOST_EMU
    static int grid = 0;
    if (!grid) {
        int dev = 0, cus = 0, per_cu = 0;
        (void)hipGetDevice(&dev);
        (void)hipDeviceGetAttribute(&cus, hipDeviceAttributeMultiprocessorCount, dev);
        (void)hipFuncSetAttribute((const void*)mega, hipFuncAttributeMaxDynamicSharedMemorySize, MEGA_LDS);
        (void)hipOccupancyMaxActiveBlocksPerMultiprocessor(&per_cu, mega, 512, MEGA_LDS);
        grid = cus * (per_cu < 1 ? per_cu : 1);
    }
    p.grid = grid;
    if (grid > 0) mega<<<grid, 512, MEGA_LDS, stream>>>(p);
#else
    e_gridDim.x = EMU_GRID; e_blockDim.x = 512; p.grid = EMU_GRID;
    program(p, g_emu_lds, 0);
#endif
}
```

```cpp
#ifndef HOST_EMU
#include <hip/hip_runtime.h>
#endif
#include <stdint.h>
#include <stddef.h>
#include <math.h>
#include <string.h>

#ifndef CFG_B
#define CFG_B 32
#define CFG_S 2048
#define CFG_D 1024
#endif

#ifdef HOST_EMU
#include <stdio.h>
#include <stdlib.h>
#define __global__
#define __device__
#define __host__
#define __forceinline__ inline
struct EmuDim { int x; };
static EmuDim e_blockIdx, e_gridDim, e_blockDim;
#define BIDX (e_blockIdx.x)
#define GDIM_OF(a_) (e_gridDim.x)
#define NTHR (e_blockDim.x)
#define PAR_BEGIN for (int tid = 0; tid < NTHR; ++tid) {
#define PAR_END }
template <class T> static inline T emu_atomic_add(T* p, T v) { T o = *p; *p = o + v; return o; }
#define ATOMIC_ADD(p, v) emu_atomic_add((p), (v))
typedef int hipStream_t;
static unsigned char g_emu_lds[163840];
#define LDS_DECL unsigned char* lds = g_emu_lds
#else
#define BIDX ((int)blockIdx.x)
#define GDIM_OF(a_) ((a_).grid)
#define NTHR 512
#define PAR_BEGIN { int tid = (int)threadIdx.x; asm volatile("" : "+v"(tid));
#define PAR_END } __syncthreads();
#define ATOMIC_ADD(p, v) atomicAdd((p), (v))
#define LDS_DECL extern __shared__ __attribute__((aligned(16))) unsigned char lds[]
#endif

typedef unsigned short bf16;

constexpr int NB = CFG_B, S = CFG_S, DM = CFG_D, T = NB * S;
constexpr int NCH = 1, TC = T / NCH;
constexpr int MOE_ROWS = ((TC * 6 + 64 * 255 + 255) / 256) * 256, MOE_TILES = MOE_ROWS / 256;
constexpr int NG = DM / 16;
constexpr int NCP = S / 16, NCMP = NCP - 1, NSLC = S / 64;
constexpr int PROJ_N = 2840, PROJ_NP = 3072;
constexpr int GU_IL = 128;
constexpr float DN_ALPHA = 1.4142135623730951f;
constexpr float LN_EPS = 1e-5f;
constexpr float QSCALE = 0.125f * 1.4426950408889634f;

constexpr size_t al256(size_t x) { return (x + 255) & ~(size_t)255; }
constexpr size_t O_CTL = 0, CTL_BYTES = 65536;
constexpr size_t O_CNT = O_CTL + 16384;
constexpr size_t O_PADSTART = O_CTL + CTL_BYTES;
constexpr size_t O_TILEE = O_PADSTART + 512;
constexpr size_t O_CMPTE = al256(O_TILEE + (size_t)MOE_TILES * 4);
constexpr size_t O_BIASK = al256(O_CMPTE + 1024);
constexpr size_t O_BIASV = O_BIASK + 1024;
constexpr size_t O_BIASP = O_BIASV + 1024;
constexpr size_t O_WT_K2 = O_BIASP + (size_t)64 * 512 * 4;
constexpr size_t O_ROPE = O_WT_K2 + (size_t)2 * 256 * 256 * 2;
constexpr size_t O_ABAR = O_ROPE + (size_t)S * 16 * 4;
constexpr size_t O_BBAR = al256(O_ABAR + (size_t)NG * 64 * 2 * 4);
constexpr size_t O_S5BT = al256(O_BBAR + (size_t)NG * 64 * 16 * 2 * 4);
constexpr size_t O_S5AP = al256(O_S5BT + (size_t)NG * 128 * 16 * 2);
constexpr size_t O_S5CT = al256(O_S5AP + (size_t)NG * 64 * 8 * 4);
constexpr size_t O_WT_IN0 = al256(O_S5CT + (size_t)NG * 32 * 128 * 2);
constexpr size_t O_WT_K1 = al256(O_WT_IN0 + (size_t)PROJ_NP * DM * 2);
constexpr size_t O_WT_V1 = O_WT_K1 + (size_t)256 * 2048 * 2;
constexpr size_t O_WT_OUT0 = O_WT_V1 + (size_t)256 * 2048 * 2;
constexpr size_t O_WT_R = al256(O_WT_OUT0 + (size_t)DM * 1024 * 2);
constexpr size_t O_WT_SGU = al256(O_WT_R + (size_t)2 * 256 * DM * 2);
constexpr size_t O_WT_SD = al256(O_WT_SGU + (size_t)2 * 512 * DM * 2);
constexpr size_t O_WT_GU = al256(O_WT_SD + (size_t)2 * DM * 256 * 2);
constexpr size_t O_WT_D = al256(O_WT_GU + (size_t)64 * 512 * DM * 2);
constexpr size_t O_WT_IN1 = al256(O_WT_D + (size_t)64 * DM * 256 * 2);
constexpr size_t O_WT_GLU = O_WT_IN1 + (size_t)DM * DM * 2;
constexpr size_t O_WT_OUT1 = O_WT_GLU + (size_t)DM * DM * 2;
constexpr size_t O_H = al256(O_WT_OUT1 + (size_t)DM * DM * 2);
constexpr size_t O_H2 = al256(O_H + (size_t)T * DM * 2);
constexpr size_t O_SCR = al256(O_H2 + (size_t)T * DM * 2);
constexpr size_t HB = (size_t)NB * 8 * S * 64 * 2, GB = (size_t)NB * 2 * S * 64 * 2;
constexpr size_t A_QA = O_SCR, A_KA = A_QA + HB, A_VA = A_KA + HB, A_QB = A_VA + HB;
constexpr size_t A_KC = A_QB + HB, A_VC = A_KC + GB, A_KS = A_VC + GB, A_VS = A_KS + GB, A_KW = A_VS + GB, A_VW = A_KW + GB;
constexpr size_t A_GRAW = A_VW + GB;
constexpr size_t A_HCK = al256(A_GRAW + (size_t)T * 24 * 4);
constexpr size_t A_HCV = A_HCK + (size_t)NB * 2 * NCP * 256 * 2;
constexpr size_t A_KCMP = A_HCV + (size_t)NB * 2 * NCP * 256 * 2;
constexpr size_t A_VCMP = A_KCMP + (size_t)NB * 2 * NCP * 64 * 4;
constexpr size_t A_ATT = al256(A_VCMP + (size_t)NB * 2 * NCP * 64 * 4);
constexpr size_t A_END = A_ATT + (size_t)T * 1024 * 2;
constexpr size_t B_EIDX = O_SCR;
constexpr size_t B_GATE = al256(B_EIDX + (size_t)T * 6 * 4);
constexpr size_t B_POS = al256(B_GATE + (size_t)T * 6 * 4);
constexpr size_t B_ROWTOK = al256(B_POS + (size_t)T * 6 * 4);
constexpr size_t B_ROWGATE = al256(B_ROWTOK + (size_t)MOE_ROWS * 4);
constexpr size_t B_AEX = al256(B_ROWGATE + (size_t)MOE_ROWS * 4);
constexpr size_t B_H8 = al256(B_AEX + (size_t)MOE_ROWS * 256);
static_assert(B_H8 + (size_t)T * DM <= B_AEX + (size_t)MOE_ROWS * 256 * 2, "h8 fits behind the fp8 AEX");
constexpr size_t B_ASH = B_AEX;
constexpr size_t B_Y = al256(B_AEX + (size_t)MOE_ROWS * 256 * 2);
constexpr size_t B_LOGIT = B_Y;
constexpr size_t B_END = B_Y + (size_t)MOE_ROWS * DM;
static_assert((size_t)T * 256 * 2 <= (size_t)MOE_ROWS * 256 * 2 && (size_t)T * 64 * 4 <= (size_t)MOE_ROWS * DM, "MoE overlays");
constexpr size_t B_H28 = B_AEX;
constexpr size_t C_U = O_SCR + ((size_t)128 << 20), C_YS = C_U + (size_t)T * DM * 2, C_Y2 = C_YS + (size_t)T * DM * 2, C_END = C_Y2 + (size_t)T * DM * 2;
static_assert(B_H28 + (size_t)T * DM <= B_H8 && B_H28 + (size_t)T * DM <= O_SCR + ((size_t)128 << 20), "h2 fp8 copy: inside the AEX half, below stage C");
constexpr size_t WS_NEED = (A_END > B_END ? (A_END > C_END ? A_END : C_END) : (B_END > C_END ? B_END : C_END)) + 4096;

__host__ __device__ __forceinline__ float bf2f(bf16 v) { unsigned u = ((unsigned)v) << 16; float f; memcpy(&f, &u, 4); return f; }
__host__ __device__ __forceinline__ bf16 f2bf(float f) { unsigned u; memcpy(&u, &f, 4); u = (u + 0x7fffu + ((u >> 16) & 1u)) >> 16; return (bf16)u; }
#ifdef HOST_EMU
__host__ __device__ __forceinline__ float sigmoidf_(float x) { return 1.0f / (1.0f + expf(-x)); }
#else
__device__ __forceinline__ float sigmoidf_(float x) { return __builtin_amdgcn_rcpf(1.0f + __builtin_amdgcn_exp2f(-1.4426950408889634f * x)); }
#endif
__host__ __device__ __forceinline__ float gelu_tanh(float x) { return 0.5f * x * (1.0f + tanhf(0.7978845608028654f * (x + 0.044715f * x * x * x))); }
__host__ __device__ __forceinline__ float siluf_(float x) { return x * sigmoidf_(x); }


constexpr float Y8_SCALE = 16.0f, Y8_INV = 1.0f / 16.0f;
__host__ __device__ __forceinline__ float fp82f(unsigned c) { const unsigned e = (c >> 3) & 15u, m = c & 7u; const float v = e ? (1.0f + (float)m * 0.125f) * exp2f((float)e - 7.0f) : (float)m * 0.001953125f; return (c & 0x80u) ? -v : v; }
#ifdef HOST_EMU
static inline unsigned f2fp8(float f) { const unsigned sg = f < 0.f ? 0x80u : 0u; float a = fabsf(f); if (!(a == a)) return 0x7fu; if (a >= 448.f) return sg | 0x7eu;
    if (a < 0.015625f) { const int q = (int)nearbyintf(a * 512.0f); return sg | (unsigned)q; }
    int e; float m = frexpf(a, &e); m *= 2.f; e -= 1; int q = (int)nearbyintf((m - 1.0f) * 8.0f); if (q == 8) { q = 0; e += 1; } unsigned c = ((unsigned)(e + 7) << 3) | (unsigned)q; if (c > 0x7eu) c = 0x7eu; return sg | c; }
#endif
struct f4 { float v[4]; };
__host__ __device__ __forceinline__ f4 ld_f4(const float* p) {
    f4 r;
#ifdef HOST_EMU
    for (int i = 0; i < 4; ++i) r.v[i] = p[i];
#else
    const float4 w = *(const float4*)p; r.v[0] = w.x; r.v[1] = w.y; r.v[2] = w.z; r.v[3] = w.w;
#endif
    return r;
}
__host__ __device__ __forceinline__ void st_bf4(bf16* p, float a, float b, float c, float d) {
#ifdef HOST_EMU
    p[0] = f2bf(a); p[1] = f2bf(b); p[2] = f2bf(c); p[3] = f2bf(d);
#else
    uint2 w; w.x = (unsigned)f2bf(a) | ((unsigned)f2bf(b) << 16); w.y = (unsigned)f2bf(c) | ((unsigned)f2bf(d) << 16); *(uint2*)p = w;
#endif
}
__host__ __device__ __forceinline__ void cp16(bf16* d, const bf16* s_) {
#ifdef HOST_EMU
    for (int i = 0; i < 8; ++i) d[i] = s_[i];
#else
    *(uint4*)d = *(const uint4*)s_;
#endif
}
struct f8 { float v[8]; };
__host__ __device__ __forceinline__ void st_bf8(bf16* p, const f8& x) {
#ifdef HOST_EMU
    for (int i = 0; i < 8; ++i) p[i] = f2bf(x.v[i]);
#else
    uint4 w; w.x = (unsigned)f2bf(x.v[0]) | ((unsigned)f2bf(x.v[1]) << 16); w.y = (unsigned)f2bf(x.v[2]) | ((unsigned)f2bf(x.v[3]) << 16);
    w.z = (unsigned)f2bf(x.v[4]) | ((unsigned)f2bf(x.v[5]) << 16); w.w = (unsigned)f2bf(x.v[6]) | ((unsigned)f2bf(x.v[7]) << 16); *(uint4*)p = w;
#endif
}
__host__ __device__ __forceinline__ f8 ld_bf8(const bf16* p) {
    f8 r;
#ifdef HOST_EMU
    for (int i = 0; i < 8; ++i) r.v[i] = bf2f(p[i]);
#else
    const uint4 w = *(const uint4*)p; r.v[0] = bf2f((bf16)(w.x & 0xffffu)); r.v[1] = bf2f((bf16)(w.x >> 16)); r.v[2] = bf2f((bf16)(w.y & 0xffffu)); r.v[3] = bf2f((bf16)(w.y >> 16));
    r.v[4] = bf2f((bf16)(w.z & 0xffffu)); r.v[5] = bf2f((bf16)(w.z >> 16)); r.v[6] = bf2f((bf16)(w.w & 0xffffu)); r.v[7] = bf2f((bf16)(w.w >> 16));
#endif
    return r;
}
__host__ __device__ __forceinline__ f8 ld_f8(const float* p) { f8 r; const f4 a = ld_f4(p), b = ld_f4(p + 4); for (int i = 0; i < 4; ++i) { r.v[i] = a.v[i]; r.v[4 + i] = b.v[i]; } return r; }
__host__ __device__ __forceinline__ void st_f8(float* p, const f8& x) {
#ifdef HOST_EMU
    for (int i = 0; i < 8; ++i) p[i] = x.v[i];
#else
    *(float4*)p = make_float4(x.v[0], x.v[1], x.v[2], x.v[3]); *(float4*)(p + 4) = make_float4(x.v[4], x.v[5], x.v[6], x.v[7]);
#endif
}


struct P {
    const float* in[44];
    float* out;
    unsigned char* ws;
    int grid, pad0, pad1, pad2;
};
#define WSP(T_, off) ((T_*)(p.ws + (off)))

enum { I_X = 0, I_L0_WIN, I_POSK, I_POSV, I_KW1, I_KW2, I_VW1, I_VW2, I_L0_WOUT, I_L0_LN1G, I_L0_LN1B,
       I_L0_ROUTER, I_L0_RBIAS, I_L0_WG, I_L0_WU, I_L0_WD, I_L0_SG, I_L0_SU, I_L0_SD, I_L0_LN2G, I_L0_LN2B,
       I_L1_WIN, I_LRE, I_LIM, I_BRE, I_BIM, I_CRE, I_CIM, I_DSK, I_LOGDT, I_WGLU, I_L1_WOUT, I_L1_LN1G, I_L1_LN1B,
       I_L1_ROUTER, I_L1_RBIAS, I_L1_WG, I_L1_WU, I_L1_WD, I_L1_SG, I_L1_SU, I_L1_SD, I_L1_LN2G, I_L1_LN2B };
constexpr int MOE_IN0[2] = { I_L0_ROUTER, I_L1_ROUTER };

struct XposeJob { const float* src; bf16* dst; int K, N, Ncover, il, il2, add, batch, grid; long sstride, dstride; int first; };
__device__ __forceinline__ void ph_xpose(const XposeJob j, unsigned char* lds) {
    bf16* tile = (bf16*)lds;
    const int tk = j.K / 64, tn = (j.Ncover + 255) / 256, per = tk * tn;
    for (int item = (BIDX - j.first + GDIM_OF(j)) % GDIM_OF(j); item < per * j.batch; item += GDIM_OF(j)) {
        const int bt = item / per, it = item % per, k0 = (it / tn) * 64, n0 = (it % tn) * 256;
        const float* src = j.src + (long)bt * j.sstride; bf16* dst = j.dst + (long)bt * j.dstride;
        PAR_BEGIN
            for (int e = tid; e < 16 * 64; e += NTHR) { const int k4 = (e >> 6) * 4, n4 = (e & 63) * 4, n = n0 + n4;
                float v[4][4];
                for (int r = 0; r < 4; ++r) { const float* row = src + (long)(k0 + k4 + r) * j.N;
                    if (n + 3 < j.N && (j.N & 3) == 0) { const f4 q = ld_f4(row + n); v[r][0] = q.v[0]; v[r][1] = q.v[1]; v[r][2] = q.v[2]; v[r][3] = q.v[3]; }
                    else for (int c = 0; c < 4; ++c) v[r][c] = (n + c < j.N) ? row[n + c] : 0.f; }
                for (int c = 0; c < 4; ++c) st_bf4(tile + (n4 + c) * 72 + k4, v[0][c], v[1][c], v[2][c], v[3][c]); }
        PAR_END
        PAR_BEGIN
            for (int e = tid; e < 256 * 8; e += NTHR) { const int nn = e >> 3, c8 = (e & 7) * 8, n = n0 + nn;
                if (n < j.Ncover) { const long row = (long)(n / j.il) * j.il2 + (n % j.il) + j.add; cp16(dst + row * j.K + k0 + c8, tile + nn * 72 + c8); } }
        PAR_END
    }
}

__device__ __forceinline__ void ph_cvt(const P& p, const float* src, bf16* dst, long n) {
    PAR_BEGIN
        for (long i = ((long)BIDX * NTHR + tid) * 8; i < n; i += (long)GDIM_OF(p) * NTHR * 8) st_bf8(dst + i, ld_f8(src + i));
    PAR_END
}

__device__ __forceinline__ void ph_tables(const P& p) {
    PAR_BEGIN
        const long gt = (long)BIDX * NTHR + tid, gs = (long)GDIM_OF(p) * NTHR;
        for (long i = gt; i < 2 * (NB * 2 * NCP / 256); i += gs) WSP(int, O_CMPTE)[i] = (i >= NB * 2 * NCP / 256) ? 1 : 0;
        for (long i = gt; i < 64 * 512; i += gs) {
            const int sl = (int)(i >> 9), which = (int)((i >> 8) & 1), c = (int)(i & 255);
            const float* pos = p.in[which ? I_POSV : I_POSK]; const float* w1 = p.in[which ? I_VW1 : I_KW1];
            float s = 0.f; for (int jx = 32 * sl; jx < 32 * sl + 32; ++jx) s += pos[jx] * w1[(long)jx * 256 + c];
            WSP(float, O_BIASP)[i] = s;
        }
        for (long i = gt; i < (long)S * 8; i += gs) { const int jx = (int)(i & 7), sp = (int)(i >> 3); const float inv = powf(500000.0f, -(float)jx / 8.0f), ang = (float)sp * inv;
            WSP(float, O_ROPE)[i * 2] = cosf(ang); WSP(float, O_ROPE)[i * 2 + 1] = sinf(ang); }
        for (long i = gt; i < (long)NG * 64; i += gs) {
            const int g = (int)(i >> 6);
            const float lre = p.in[I_LRE][i], lim = p.in[I_LIM][i], step = expf(p.in[I_LOGDT][g]);
            const float mag = expf(lre * step), are = mag * cosf(lim * step), aim = mag * sinf(lim * step);
            const float den = lre * lre + lim * lim;
            const float zre = ((are - 1.0f) * lre + aim * lim) / den, zim = (aim * lre - (are - 1.0f) * lim) / den;
            WSP(float, O_ABAR)[i * 2] = are; WSP(float, O_ABAR)[i * 2 + 1] = aim;
            const int ps = (int)(i & 63);
            for (int h = 0; h < 16; ++h) { const float br = p.in[I_BRE][i * 16 + h], bi = p.in[I_BIM][i * 16 + h]; const float bbr = zre * br - zim * bi, bbi = zre * bi + zim * br;
                WSP(float, O_BBAR)[(i * 16 + h) * 2] = bbr; WSP(float, O_BBAR)[(i * 16 + h) * 2 + 1] = bbi;
                WSP(bf16, O_S5BT)[((long)g * 128 + ps) * 16 + h] = f2bf(bbr); WSP(bf16, O_S5BT)[((long)g * 128 + 64 + ps) * 16 + h] = f2bf(bbi);
                WSP(bf16, O_S5CT)[((long)g * 32 + h) * 128 + ps] = f2bf(p.in[I_CRE][((long)g * 16 + h) * 64 + ps]); WSP(bf16, O_S5CT)[((long)g * 32 + h) * 128 + 64 + ps] = f2bf(-p.in[I_CIM][((long)g * 16 + h) * 64 + ps]);
                WSP(bf16, O_S5CT)[((long)g * 32 + 16 + h) * 128 + ps] = 0; WSP(bf16, O_S5CT)[((long)g * 32 + 16 + h) * 128 + 64 + ps] = 0; }
            { float* ap = WSP(float, O_S5AP) + i * 8; const float a2r = are * are - aim * aim, a2i = 2.f * are * aim, a3r = a2r * are - a2i * aim, a3i = a2r * aim + a2i * are, a4r = a2r * a2r - a2i * a2i, a4i = 2.f * a2r * a2i;
              ap[0] = are; ap[1] = aim; ap[2] = a2r; ap[3] = a2i; ap[4] = a3r; ap[5] = a3i; ap[6] = a4r; ap[7] = a4i; }
        }
    PAR_END
}

__device__ __forceinline__ void ph_bias_finish(const P& p) {
    PAR_BEGIN
        for (long i = (long)BIDX * NTHR + tid; i < 512; i += (long)GDIM_OF(p) * NTHR) { float s = 0.f; for (int sl = 0; sl < 64; ++sl) s += WSP(float, O_BIASP)[sl * 512 + i]; WSP(float, O_BIASK)[i] = s; }
    PAR_END
}
__device__ __forceinline__ void ph_rope(const P& p) {
    PAR_BEGIN
        const long rows_q = (long)NB * 8 * S, rows_k = (long)NB * 2 * S, total = rows_q + 3 * rows_k;
        for (long i = (long)BIDX * NTHR + tid; i < total; i += (long)GDIM_OF(p) * NTHR) {
            long row = i; bf16* base;
            if (row < rows_q) base = WSP(bf16, A_QB);
            else { row -= rows_q; const int w = (int)(row / rows_k); row -= (long)w * rows_k; base = WSP(bf16, w == 0 ? A_KC : (w == 1 ? A_KS : A_KW)); }
            const int sp = (int)(row % S); const float* cs = WSP(float, O_ROPE) + (long)sp * 16;
            bf16* r = base + row * 64; const f8 x1 = ld_bf8(r), x2 = ld_bf8(r + 8), t0 = ld_f8(cs), t1 = ld_f8(cs + 8);
            f8 o1, o2;
            for (int jx = 0; jx < 8; ++jx) { const float c = jx < 4 ? t0.v[2 * jx] : t1.v[2 * jx - 8], sn = jx < 4 ? t0.v[2 * jx + 1] : t1.v[2 * jx - 7];
                o1.v[jx] = x1.v[jx] * c - x2.v[jx] * sn; o2.v[jx] = x2.v[jx] * c + x1.v[jx] * sn; }
            st_bf8(r, o1); st_bf8(r + 8, o2);
        }
    PAR_END
}

__device__ __forceinline__ void ph_cmpw2(const P& p) {
    PAR_BEGIN
        const long rows = (long)NB * 2 * NCP, total = rows * 64 * 2;
        for (long i = (long)BIDX * NTHR + tid; i < total; i += (long)GDIM_OF(p) * NTHR) {
            const int which = (int)(i / (rows * 64)); const long r = (i / 64) % rows; const int d = (int)(i & 63);
            const bf16* hc = WSP(bf16, which ? A_HCV : A_HCK) + r * 256; const float* w2 = p.in[which ? I_VW2 : I_KW2];
            float s = 0.f; for (int c = 0; c < 256; ++c) s += bf2f(hc[c]) * w2[c * 64 + d];
            WSP(bf16, which ? A_VCMP : A_KCMP)[r * 64 + d] = f2bf(s);
        }
    PAR_END
}

__device__ __forceinline__ void ph_sb(const P& p) {
    PAR_BEGIN
        const bf16* QA = WSP(bf16, A_QA); const bf16* KA = WSP(bf16, A_KA); const bf16* VA = WSP(bf16, A_VA); bf16* ATT = WSP(bf16, A_ATT);
        for (long gq = (long)BIDX * NTHR + tid; gq < (long)NB * 8 * S; gq += (long)GDIM_OF(p) * NTHR) {
            const int t = (int)(gq % S); const long bh = gq / S; const int h = (int)(bh & 7); const long b = bh >> 3;
            float q[64], acc[64];
#pragma unroll
            for (int d = 0; d < 64; ++d) { q[d] = bf2f(QA[gq * 64 + d]) * (0.125f / QSCALE); acc[d] = 0.f; }
            float run = 0.f;
            for (int s = t - 1; s >= 0; --s) {
                const bf16* kr = KA + (bh * S + s) * 64; const bf16* vr = VA + (bh * S + s) * 64;
                float z = 0.f;
#pragma unroll
                for (int d = 0; d < 64; ++d) z += q[d] * bf2f(kr[d]);
                const float l1p = log1pf(expf(-fabsf(z)));
                const float sp_pos = fmaxf(z, 0.f) + l1p, sp_neg = fmaxf(-z, 0.f) + l1p;
                const float w = expf(run - sp_neg);
#pragma unroll
                for (int d = 0; d < 64; ++d) acc[d] += w * bf2f(vr[d]);
                run -= sp_pos;
                if (run < -120.f) break;
            }
            bf16* o = ATT + (b * S + t) * 1024 + h * 64;
#pragma unroll
            for (int d = 0; d < 64; ++d) o[d] = f2bf(acc[d]);
        }
    PAR_END
}

constexpr int NSA_LDS_PER = (4 * 64 + 4 * 512 + 4 * 64 + 64 + 64 + 32 + 16 + 16 + 16) * 4;
__device__ __forceinline__ void ph_nsa(const P& p, unsigned char* lds) {
    const int per = NTHR / 256; const long items = (long)NB * 2 * S;
    const bf16* QB = WSP(bf16, A_QB); bf16* ATT = WSP(bf16, A_ATT);
    const bf16* KCMP = WSP(bf16, A_KCMP); const bf16* VCMP = WSP(bf16, A_VCMP);
    for (long it0 = (long)BIDX * per; it0 < items; it0 += (long)GDIM_OF(p) * per) {
#define NSA_SETUP const int sub = tid >> 8, lt = tid & 255; const long item = it0 + sub; const bool act = item < items; \
        const int t = act ? (int)(item % S) : 0; const long bg = act ? item / S : 0; const int g = (int)(bg & 1); const long b = bg >> 1; \
        float* L = (float*)(lds + (size_t)sub * NSA_LDS_PER); float* qs = L; float* sc = qs + 256; float* osum = sc + 2048; float* pm = osum + 256; float* pl = pm + 64; \
        float* imp = pl + 64; int* sel = (int*)(imp + 32); float* st = (float*)(sel + 16); float* gts = st + 16; (void)lt; (void)g; (void)b; (void)t; (void)qs; (void)sc; (void)osum; (void)pm; (void)pl; (void)imp; (void)sel; (void)st; (void)gts;
#define NSA_SOFTMAX(NEXPR) \
        PAR_BEGIN NSA_SETUP if (act && lt < 64) { const int r = lt >> 4, part = lt & 15, n = (NEXPR); float m = -3e38f; \
            for (int jx = part; jx < n; jx += 16) m = fmaxf(m, sc[r * 512 + jx]); float l = 0.f; \
            for (int jx = part; jx < n; jx += 16) { const float v = sc[r * 512 + jx]; if (v > -1e29f) l += expf(v - m); } pm[lt] = m; pl[lt] = l; } PAR_END \
        PAR_BEGIN NSA_SETUP if (act && lt < 4) { float m = -3e38f; for (int q2 = 0; q2 < 16; ++q2) m = fmaxf(m, pm[lt * 16 + q2]); float l = 0.f; \
            for (int q2 = 0; q2 < 16; ++q2) { const float pmv = pm[lt * 16 + q2]; if (pmv > -1e29f) l += pl[lt * 16 + q2] * expf(pmv - m); } st[lt] = m; st[4 + lt] = l; } PAR_END \
        PAR_BEGIN NSA_SETUP if (act) { const int n = (NEXPR); for (int idx = lt; idx < 4 * n; idx += 256) { const int r = idx / n, jx = idx % n; const float v = sc[r * 512 + jx]; \
            const float l = st[4 + r]; sc[r * 512 + jx] = (v > -1e29f && l > 0.f) ? expf(v - st[r]) / l : 0.f; } } PAR_END
        PAR_BEGIN NSA_SETUP
            if (act) { const int r = lt >> 6, d = lt & 63; qs[lt] = bf2f(QB[((b * 8 + g * 4 + r) * S + t) * 64 + d]) * (0.125f / QSCALE); osum[lt] = 0.f;
                if (lt < 12) gts[lt] = sigmoidf_(WSP(float, A_GRAW)[(b * S + t) * 24 + g * 12 + lt]); }
        PAR_END
        PAR_BEGIN NSA_SETUP
            if (act) for (int idx = lt; idx < 4 * NCP; idx += 256) { const int r = idx / NCP, n = idx % NCP; float v = -1e30f;
                if (n < NCMP && 16 * n + 31 <= t) { const bf16* kr = KCMP + (bg * NCP + n) * 64; v = 0.f; for (int d = 0; d < 64; ++d) v += qs[r * 64 + d] * bf2f(kr[d]); }
                sc[r * 512 + n] = v; }
        PAR_END
        NSA_SOFTMAX(NCP)
        PAR_BEGIN NSA_SETUP
            if (act) { const int r = lt >> 6, d = lt & 63; float o = 0.f; for (int n = 0; n < NCMP; ++n) o += sc[r * 512 + n] * bf2f(VCMP[(bg * NCP + n) * 64 + d]); osum[lt] += gts[r * 3 + 0] * o; }
        PAR_END
        PAR_BEGIN NSA_SETUP
            if (act && lt < 32) { float s = 0.f; if (lt < NSLC) { const int n0 = 4 * lt - 1 < 0 ? 0 : 4 * lt - 1, n1 = 4 * lt + 3 > NCMP - 1 ? NCMP - 1 : 4 * lt + 3;
                for (int r = 0; r < 4; ++r) for (int n = n0; n <= n1; ++n) s += sc[r * 512 + n]; } imp[lt] = s; }
        PAR_END
        PAR_BEGIN NSA_SETUP
            if (act && lt == 0) { const int cur = t >> 6;
                for (int m = 0; m < NSLC; ++m) { const bool valid = m <= cur, forced = (m == 0) || (valid && m > cur - 2); imp[m] = forced ? imp[m] + 1e4f : (valid ? imp[m] : -1e30f); }
                int ns = 0;
                for (int i = 0; i < 8; ++i) { int best = 0; float bv = -3.4e38f; for (int m = 0; m < NSLC; ++m) if (imp[m] > bv) { bv = imp[m]; best = m; } imp[best] = -3.4e38f; if (best <= cur) sel[ns++] = best; }
                sel[8] = ns; }
        PAR_END
        PAR_BEGIN NSA_SETUP
            if (act) { const int n = sel[8] * 64; const bf16* KS = WSP(bf16, A_KS);
                for (int idx = lt; idx < 4 * n; idx += 256) { const int r = idx / n, jx = idx % n, pos = sel[jx >> 6] * 64 + (jx & 63); float v = -1e30f;
                    if (pos <= t) { const bf16* kr = KS + (bg * S + pos) * 64; v = 0.f; for (int d = 0; d < 64; ++d) v += qs[r * 64 + d] * bf2f(kr[d]); }
                    sc[r * 512 + jx] = v; } }
        PAR_END
        NSA_SOFTMAX(sel[8] * 64)
        PAR_BEGIN NSA_SETUP
            if (act) { const int r = lt >> 6, d = lt & 63, n = sel[8] * 64; const bf16* VS = WSP(bf16, A_VS); float o = 0.f;
                for (int jx = 0; jx < n; ++jx) { const int pos = sel[jx >> 6] * 64 + (jx & 63); o += sc[r * 512 + jx] * bf2f(VS[(bg * S + pos) * 64 + d]); }
                osum[lt] += gts[r * 3 + 1] * o; }
        PAR_END
        PAR_BEGIN NSA_SETUP
            if (act) { const bf16* KW = WSP(bf16, A_KW);
                for (int idx = lt; idx < 4 * 512; idx += 256) { const int r = idx >> 9, jx = idx & 511, pos = t - 511 + jx; float v = -1e30f;
                    if (pos >= 0) { const bf16* kr = KW + (bg * S + pos) * 64; v = 0.f; for (int d = 0; d < 64; ++d) v += qs[r * 64 + d] * bf2f(kr[d]); }
                    sc[r * 512 + jx] = v; } }
        PAR_END
        NSA_SOFTMAX(512)
        PAR_BEGIN NSA_SETUP
            if (act) { const int r = lt >> 6, d = lt & 63; const bf16* VW = WSP(bf16, A_VW); float o = 0.f;
                for (int jx = 0; jx < 512; ++jx) { const int pos = t - 511 + jx; if (pos >= 0) o += sc[r * 512 + jx] * bf2f(VW[(bg * S + pos) * 64 + d]); }
                osum[lt] += gts[r * 3 + 2] * o;
                ATT[(b * S + t) * 1024 + 512 + (g * 4 + r) * 64 + d] = f2bf(osum[lt]); }
        PAR_END
    }
}

constexpr int S5_LDS_PER = (8 * 128 + 8 * 16 + 128) * 4;
__device__ __forceinline__ void ph_s5(const P& p, unsigned char* lds) {
    const int per = NTHR / 64; const long items = (long)NB * NG;
    const bf16* U = WSP(bf16, C_U); bf16* YS = WSP(bf16, C_YS);
    const float* ABAR = WSP(float, O_ABAR); const float* BBAR = WSP(float, O_BBAR);
    for (long it0 = (long)BIDX * per; it0 < items; it0 += (long)GDIM_OF(p) * per) {
#define S5_SETUP const int sub = tid >> 6, lt = tid & 63; const long item = it0 + sub; const bool act = item < items; const int g = act ? (int)(item % NG) : 0; const long b = act ? item / NG : 0; \
        float* L = (float*)(lds + (size_t)sub * S5_LDS_PER); float* hbuf = L; float* ubuf = hbuf + 1024; float* hst = ubuf + 128; (void)lt; (void)g; (void)b; (void)hbuf; (void)ubuf; (void)hst;
        PAR_BEGIN S5_SETUP if (act) { hst[lt] = 0.f; hst[64 + lt] = 0.f; } PAR_END
        for (int t0 = 0; t0 < S; t0 += 8) {
            PAR_BEGIN S5_SETUP
                if (act) for (int e = lt; e < 128; e += 64) ubuf[e] = bf2f(U[(b * S + t0 + (e >> 4)) * DM + g * 16 + (e & 15)]);
            PAR_END
            PAR_BEGIN S5_SETUP
                if (act) { const long gp = (long)g * 64 + lt; const float are = ABAR[gp * 2], aim = ABAR[gp * 2 + 1]; float bre[16], bim[16];
#pragma unroll
                    for (int h = 0; h < 16; ++h) { bre[h] = BBAR[(gp * 16 + h) * 2]; bim[h] = BBAR[(gp * 16 + h) * 2 + 1]; }
                    float hr = hst[lt], hi = hst[64 + lt];
                    for (int i = 0; i < 8; ++i) { float ur = 0.f, ui = 0.f;
#pragma unroll
                        for (int h = 0; h < 16; ++h) { const float u = ubuf[i * 16 + h]; ur += u * bre[h]; ui += u * bim[h]; }
                        const float nr = are * hr - aim * hi + ur, ni = are * hi + aim * hr + ui; hr = nr; hi = ni;
                        hbuf[i * 128 + lt] = hr; hbuf[i * 128 + 64 + lt] = hi; }
                    hst[lt] = hr; hst[64 + lt] = hi; }
            PAR_END
            PAR_BEGIN S5_SETUP
                if (act) { const int hh = lt & 15, iq = lt >> 4; const float* cre = p.in[I_CRE] + ((long)g * 16 + hh) * 64; const float* cim = p.in[I_CIM] + ((long)g * 16 + hh) * 64;
                    const float dsk = p.in[I_DSK][g * 16 + hh];
                    for (int i = iq * 2; i < iq * 2 + 2; ++i) { float y = 0.f;
                        for (int pp = 0; pp < 64; ++pp) y += cre[pp] * hbuf[i * 128 + pp] - cim[pp] * hbuf[i * 128 + 64 + pp];
                        y += dsk * ubuf[i * 16 + hh];
                        YS[(b * S + t0 + i) * DM + g * 16 + hh] = f2bf(gelu_tanh(y)); } }
            PAR_END
        }
    }
}

__device__ __forceinline__ void ph_route(const P& p, const int layer, const int chunk, unsigned char* lds) {
    const int NT_ = 256; float* rb = (float*)lds;
    int* hist = (int*)(rb + (size_t)NT_ * 72); int* base = hist + 64; int* lr = base + 64;
    const float* LOGIT = WSP(float, B_LOGIT); const float* rbias = p.in[layer == 0 ? I_L0_RBIAS : I_L1_RBIAS];
    int* gcnt = WSP(int, O_CNT) + (layer * NCH + chunk) * 64;
    const long tbeg = (long)chunk * TC;
    for (long t0 = (long)BIDX * NT_; t0 < TC; t0 += (long)GDIM_OF(p) * NT_) {
        PAR_BEGIN if (tid < 64) hist[tid] = 0; PAR_END
        PAR_BEGIN
            const long tl = t0 + tid;
            if (tid < NT_ && tl < TC) { const long tok = tbeg + tl; float* sb = rb + (size_t)tid * 72; float* gs = sb + 64;
                for (int e = 0; e < 64; ++e) sb[e] = sigmoidf_(LOGIT[tok * 64 + e]) + rbias[e];
                for (int gq = 0; gq < 8; ++gq) { float m1 = -3e38f, m2 = -3e38f; for (int jx = 0; jx < 8; ++jx) { const float v = sb[gq * 8 + jx]; if (v > m1) { m2 = m1; m1 = v; } else if (v > m2) m2 = v; } gs[gq] = m1 + m2; }
                unsigned keep = 0u;
                for (int i = 0; i < 4; ++i) { int best = 0; float bv = -3.4e38f; for (int gq = 0; gq < 8; ++gq) if (!((keep >> gq) & 1u) && gs[gq] > bv) { bv = gs[gq]; best = gq; } keep |= 1u << best; }
                unsigned long long taken = 0ull; int ei[6]; float gv[6]; float gsum = 0.f;
#pragma unroll
                for (int i = 0; i < 6; ++i) { int best = 0; float bv = -3.4e38f;
                    for (int e = 0; e < 64; ++e) if (((keep >> (e >> 3)) & 1u) && !((taken >> e) & 1ull) && sb[e] > bv) { bv = sb[e]; best = e; }
                    taken |= 1ull << best; ei[i] = best; gv[i] = sb[best] - rbias[best]; gsum += gv[i]; }
#pragma unroll
                for (int i = 0; i < 6; ++i) { WSP(int, B_EIDX)[tok * 6 + i] = ei[i]; WSP(float, B_GATE)[tok * 6 + i] = gv[i] / gsum * 2.5f; lr[tid * 6 + i] = ATOMIC_ADD(&hist[ei[i]], 1); }
            }
        PAR_END
        PAR_BEGIN if (tid < 64) base[tid] = ATOMIC_ADD(&gcnt[tid], hist[tid]); PAR_END
        PAR_BEGIN
            const long tl = t0 + tid;
            if (tid < NT_ && tl < TC) { const long tok = tbeg + tl; for (int i = 0; i < 6; ++i) WSP(int, B_POS)[tok * 6 + i] = base[WSP(int, B_EIDX)[tok * 6 + i]] + lr[tid * 6 + i]; }
        PAR_END
    }
}

__device__ __forceinline__ void ph_offsets(const P& p, const int layer, const int chunk) {
    if (BIDX == 0) {
    const int* gcnt = WSP(int, O_CNT) + (layer * NCH + chunk) * 64; int* ps = WSP(int, O_PADSTART); int* te = WSP(int, O_TILEE);
    PAR_BEGIN if (tid == 0) { int acc = 0; for (int e = 0; e < 64; ++e) { ps[e] = acc; acc += (gcnt[e] + 255) / 256 * 256; } ps[64] = acc; } PAR_END
    PAR_BEGIN for (int i = tid; i < MOE_TILES; i += NTHR) { const int r = i * 256; int e = -1; if (r < ps[64]) { e = 0; while (ps[e + 1] <= r) ++e; } te[i] = e; } PAR_END
    }
}
__device__ __forceinline__ void ph_clear_rows(const P& p) {
    PAR_BEGIN for (long i = (long)BIDX * NTHR + tid; i < MOE_ROWS; i += (long)GDIM_OF(p) * NTHR) { WSP(int, B_ROWTOK)[i] = 0; WSP(float, B_ROWGATE)[i] = 0.f; } PAR_END
}
__device__ __forceinline__ void ph_scatter(const P& p, const int chunk) {
    PAR_BEGIN
        const int* ps = WSP(int, O_PADSTART);
        for (long i = (long)BIDX * NTHR + tid; i < (long)TC * 6; i += (long)GDIM_OF(p) * NTHR) { const long gi = (long)chunk * TC * 6 + i;
            const int e = WSP(int, B_EIDX)[gi], dest = ps[e] + WSP(int, B_POS)[gi];
            WSP(int, B_ROWTOK)[dest] = (int)(gi / 6); WSP(float, B_ROWGATE)[dest] = WSP(float, B_GATE)[gi]; WSP(int, B_POS)[gi] = dest; }
    PAR_END
}


__device__ __forceinline__ void ph_place(const P& p, const int layer, const int chunk, unsigned char* lds) {
    const int* gcnt = WSP(int, O_CNT) + (layer * NCH + chunk) * 64; int* psl = (int*)lds;
    PAR_BEGIN if (tid == 0) { int acc = 0; for (int e = 0; e < 64; ++e) { const int c = gcnt[e]; psl[e] = acc; psl[65 + e] = c; acc += (c + 255) / 256 * 256; } psl[64] = acc; } PAR_END
    PAR_BEGIN
        for (long i = (long)BIDX * NTHR + tid; i < (long)TC * 6; i += (long)GDIM_OF(p) * NTHR) { const long gi = (long)chunk * TC * 6 + i;
            const int e = WSP(int, B_EIDX)[gi], dest = psl[e] + WSP(int, B_POS)[gi];
            WSP(int, B_ROWTOK)[dest] = (int)(gi / 6); WSP(float, B_ROWGATE)[dest] = WSP(float, B_GATE)[gi]; WSP(int, B_POS)[gi] = dest; }
        for (long i = (long)BIDX * NTHR + tid; i < 64 * 256; i += (long)GDIM_OF(p) * NTHR) { const int e = (int)(i >> 8), k = (int)(i & 255), row = psl[e] + psl[65 + e] + k;
            if (row < psl[e + 1]) { WSP(int, B_ROWTOK)[row] = 0; WSP(float, B_ROWGATE)[row] = 0.f; } }
        if (BIDX == 0) { int* ps = WSP(int, O_PADSTART); int* te = WSP(int, O_TILEE);
            for (int i = tid; i < 65; i += NTHR) ps[i] = psl[i];
            for (int i = tid; i < MOE_TILES; i += NTHR) { const int r = i * 256; int e = -1; if (r < psl[64]) { e = 0; while (psl[e + 1] <= r) ++e; } te[i] = e; } }
    PAR_END
}
struct LnJob { const float* pre; const bf16* preb; const unsigned char* y; const int* pos; const float* gate; const float* g; const float* b; bf16* obf; float* of32; unsigned char* of8; long t_beg, t_cnt; int grid, pad; };
constexpr int LN_LDS_PER = (DM + 64) * 4;
__device__ __forceinline__ void ph_ln(const LnJob j, unsigned char* lds) {
    const int per = NTHR / 256;
    for (long r0 = (long)BIDX * per; r0 < j.t_cnt; r0 += (long)GDIM_OF(j) * per) {
#define LN_SETUP const int sub = tid >> 8, lt = tid & 255; const long rl = r0 + sub; const bool act = rl < j.t_cnt; const long tok = j.t_beg + (act ? rl : 0); \
        float* vals = (float*)(lds + (size_t)sub * LN_LDS_PER); float* red = vals + DM; (void)lt; (void)tok; (void)red;
        PAR_BEGIN LN_SETUP
            if (act) for (int c = lt; c < DM; c += 256) { float v = j.preb ? bf2f(j.preb[tok * DM + c]) : j.pre[tok * DM + c]; if (j.y) { float ys = 0.f; for (int k = 0; k < 6; ++k) ys += fp82f(j.y[(long)j.pos[tok * 6 + k] * DM + c]); v += ys * Y8_INV; } vals[c] = v; }
        PAR_END
        PAR_BEGIN LN_SETUP if (act && lt < 16) { float s = 0.f; for (int c = lt * (DM / 16); c < (lt + 1) * (DM / 16); ++c) s += vals[c]; red[lt] = s; } PAR_END
        PAR_BEGIN LN_SETUP if (act && lt == 0) { float s = 0.f; for (int i = 0; i < 16; ++i) s += red[i]; red[32] = s / (float)DM; } PAR_END
        PAR_BEGIN LN_SETUP if (act && lt < 16) { const float mu = red[32]; float s = 0.f; for (int c = lt * (DM / 16); c < (lt + 1) * (DM / 16); ++c) { const float d = vals[c] - mu; s += d * d; } red[lt] = s; } PAR_END
        PAR_BEGIN LN_SETUP if (act && lt == 0) { float s = 0.f; for (int i = 0; i < 16; ++i) s += red[i]; red[33] = 1.0f / sqrtf(s / (float)DM + LN_EPS); } PAR_END
        PAR_BEGIN LN_SETUP
            if (act) { const float mu = red[32], rs = red[33];
                for (int c = lt; c < DM; c += 256) { const float o = (vals[c] - mu) * rs * j.g[c] + j.b[c]; if (j.obf) j.obf[tok * DM + c] = f2bf(o); else j.of32[tok * DM + c] = o; } }
        PAR_END
    }
}


#ifndef HOST_EMU
constexpr float W8_SCALE = 64.0f, A8_SCALE = 8.0f, F8_ACC_INV = 1.0f / (W8_SCALE * A8_SCALE);
__device__ __forceinline__ float clamp8(float x) { return __builtin_amdgcn_fmed3f(x, -448.0f, 448.0f); }
__device__ __forceinline__ unsigned pk4_fp8(float a, float b, float c, float d) { int w = __builtin_amdgcn_cvt_pk_fp8_f32(clamp8(a), clamp8(b), 0, false); w = __builtin_amdgcn_cvt_pk_fp8_f32(clamp8(c), clamp8(d), w, true); return (unsigned)w; }
__device__ __forceinline__ float wave_sum(float v) {
    v += __builtin_bit_cast(float, __builtin_amdgcn_mov_dpp(__builtin_bit_cast(int, v), 0xB1, 0xf, 0xf, true));
    v += __builtin_bit_cast(float, __builtin_amdgcn_mov_dpp(__builtin_bit_cast(int, v), 0x4E, 0xf, 0xf, true));
    v += __builtin_bit_cast(float, __builtin_amdgcn_ds_swizzle(__builtin_bit_cast(int, v), 0x101F));
    v += __builtin_bit_cast(float, __builtin_amdgcn_ds_swizzle(__builtin_bit_cast(int, v), 0x201F));
    v += __builtin_bit_cast(float, __builtin_amdgcn_ds_swizzle(__builtin_bit_cast(int, v), 0x401F));
    auto rr = __builtin_amdgcn_permlane32_swap(__float_as_uint(v), __float_as_uint(v), false, false);
    return __uint_as_float(rr[0]) + __uint_as_float(rr[1]); }
__device__ __forceinline__ void ph_ln2(const LnJob j) {
    static_assert(DM == 1024, "ln2: a lane owns 16 consecutive columns; a wave takes two adjacent rows per pass (their loads overlap)");
    int tid = threadIdx.x; asm volatile("" : "+v"(tid));
    const int lane = tid & 63, wid = __builtin_amdgcn_readfirstlane(tid >> 6);
    for (long r = ((long)blockIdx.x * 8 + wid) * 2; r < j.t_cnt; r += (long)j.grid * 16) {
        int c0 = lane * 16; asm volatile("" : "+v"(c0));
        const long tok0 = j.t_beg + r; float v[2][16]; int yrow[2][6];
#pragma unroll
        for (int u = 0; u < 2; ++u) { const long o = (tok0 + u) * DM + c0;
            if (j.y) {
#pragma unroll
                for (int k = 0; k < 6; ++k) yrow[u][k] = j.pos[(tok0 + u) * 6 + k]; }
            if (j.preb) { const f8 a = ld_bf8(j.preb + o), b = ld_bf8(j.preb + o + 8);
#pragma unroll
                for (int q = 0; q < 8; ++q) { v[u][q] = a.v[q]; v[u][8 + q] = b.v[q]; } }
            else { const f8 a = ld_f8(j.pre + o), b = ld_f8(j.pre + o + 8);
#pragma unroll
                for (int q = 0; q < 8; ++q) { v[u][q] = a.v[q]; v[u][8 + q] = b.v[q]; } } }
        if (j.y) {
#pragma unroll
            for (int kb = 0; kb < 6; kb += 3) {
                uint4 w[2][3]; float gk[2][3];
#pragma unroll
                for (int u = 0; u < 2; ++u)
#pragma unroll
                    for (int k = 0; k < 3; ++k) { w[u][k] = *(const uint4*)(j.y + (long)yrow[u][kb + k] * DM + c0); gk[u][k] = j.gate ? j.gate[(tok0 + u) * 6 + kb + k] * Y8_INV : Y8_INV; }
#pragma unroll
                for (int u = 0; u < 2; ++u)
#pragma unroll
                    for (int k = 0; k < 3; ++k) { const unsigned ww[4] = {w[u][k].x, w[u][k].y, w[u][k].z, w[u][k].w};
#pragma unroll
                        for (int q = 0; q < 4; ++q) { const auto lo = __builtin_amdgcn_cvt_pk_f32_fp8((int)ww[q], false), hi2 = __builtin_amdgcn_cvt_pk_f32_fp8((int)ww[q], true);
                            v[u][4 * q] += lo[0] * gk[u][k]; v[u][4 * q + 1] += lo[1] * gk[u][k]; v[u][4 * q + 2] += hi2[0] * gk[u][k]; v[u][4 * q + 3] += hi2[1] * gk[u][k]; } }
            }
        }
        int c0b = lane * 16; asm volatile("" : "+v"(c0b));
        const f8 g0 = ld_f8(j.g + c0b), g1 = ld_f8(j.g + c0b + 8), b0 = ld_f8(j.b + c0b), b1 = ld_f8(j.b + c0b + 8);
#pragma unroll
        for (int u = 0; u < 2; ++u) {
            float s = 0.f;
#pragma unroll
            for (int i = 0; i < 16; ++i) s += v[u][i];
            const float mu = wave_sum(s) * (1.0f / (float)DM);
            float q2 = 0.f;
#pragma unroll
            for (int i = 0; i < 16; ++i) { const float d = v[u][i] - mu; q2 += d * d; }
            const float rs = 1.0f / sqrtf(wave_sum(q2) * (1.0f / (float)DM) + LN_EPS);
            f8 o0, o1;
#pragma unroll
            for (int q = 0; q < 8; ++q) { o0.v[q] = (v[u][q] - mu) * rs * g0.v[q] + b0.v[q]; o1.v[q] = (v[u][8 + q] - mu) * rs * g1.v[q] + b1.v[q]; }
            const long o = (tok0 + u) * DM + c0;
            if (j.obf) { st_bf8(j.obf + o, o0); st_bf8(j.obf + o + 8, o1); } else { st_f8(j.of32 + o, o0); st_f8(j.of32 + o + 8, o1); }
            if (j.of8) { uint4 w8; w8.x = pk4_fp8(o0.v[0] * A8_SCALE, o0.v[1] * A8_SCALE, o0.v[2] * A8_SCALE, o0.v[3] * A8_SCALE); w8.y = pk4_fp8(o0.v[4] * A8_SCALE, o0.v[5] * A8_SCALE, o0.v[6] * A8_SCALE, o0.v[7] * A8_SCALE);
                w8.z = pk4_fp8(o1.v[0] * A8_SCALE, o1.v[1] * A8_SCALE, o1.v[2] * A8_SCALE, o1.v[3] * A8_SCALE); w8.w = pk4_fp8(o1.v[4] * A8_SCALE, o1.v[5] * A8_SCALE, o1.v[6] * A8_SCALE, o1.v[7] * A8_SCALE); *(uint4*)(j.of8 + o) = w8; }
        }
    }
}
#define ph_ln(j, lds) ph_ln2(j)
#endif

struct GemmArgs { const bf16* A; const bf16* Bt; const int* rowidx; const int* tile_e; const int* m_rt; long lda; long b_estride; int M, N, K, grid; };
constexpr int GEMM_LDS = 131072, GEMM_TE_LDS = 8192;
static_assert(MOE_TILES <= 2048, "tile table");
struct EpiProj0 { static constexpr bool HAS_LD = false; unsigned char* ws;
    __device__ __forceinline__ void oct(int row, int col, const f8& v, const f8&) const {
        if (col >= PROJ_N) return; const long b = row / S, s = row % S;
        if (col < 2048) { const int seg = col >> 9, h = (col >> 6) & 7, d = col & 63; bf16* base = (bf16*)(ws + A_QA + (size_t)seg * HB); const float sc = (seg == 3 || seg == 0) ? QSCALE : 1.0f;
            f8 o; for (int i = 0; i < 8; ++i) o.v[i] = v.v[i] * sc; st_bf8(base + ((b * 8 + h) * S + s) * 64 + d, o); }
        else if (col < 2816) { const int c2 = col - 2048, seg = c2 >> 7, g = (c2 >> 6) & 1, d = c2 & 63; bf16* base = (bf16*)(ws + A_KC + (size_t)seg * GB); st_bf8(base + ((b * 2 + g) * S + s) * 64 + d, v); }
        else st_f8((float*)(ws + A_GRAW) + (long)row * 24 + (col - 2816), v); } };
#ifndef HOST_EMU
struct EpiProj0R { static constexpr bool HAS_LD = false; unsigned char* ws; float asc;
    __device__ __forceinline__ void oct(int row, int col, const f8& v0, const f8&) const {
        if (col >= PROJ_N) return; const long b = row / S, s = row % S;
        f8 v; for (int i = 0; i < 8; ++i) v.v[i] = v0.v[i] * asc;
        f8 x = v;
        const bool rs = (col >= 1536 && col < 2048) || (col >= 2048 && col < 2816 && ((((col - 2048) >> 7) & 1) == 0));
        if (rs && (col & 32) == 0) {
            f8 pv; for (int i = 0; i < 8; ++i) pv.v[i] = __builtin_bit_cast(float, __builtin_amdgcn_ds_swizzle(__builtin_bit_cast(int, v.v[i]), 0x401F));
            if ((col & 16) == 0) { const float* cs = (const float*)(ws + O_ROPE) + s * 16; const f8 t0 = ld_f8(cs), t1 = ld_f8(cs + 8); const float sg = (col & 8) ? 1.0f : -1.0f;
                for (int jx = 0; jx < 8; ++jx) { const float c = jx < 4 ? t0.v[2 * jx] : t1.v[2 * jx - 8], sn = jx < 4 ? t0.v[2 * jx + 1] : t1.v[2 * jx - 7]; x.v[jx] = v.v[jx] * c + sg * pv.v[jx] * sn; } } }
        if (col < 2048) { const int seg = col >> 9, h = (col >> 6) & 7, d = col & 63; bf16* base = (bf16*)(ws + A_QA + (size_t)seg * HB); const float sc = (seg == 3 || seg == 0) ? QSCALE : 1.0f;
            f8 o; for (int i = 0; i < 8; ++i) o.v[i] = x.v[i] * sc; st_bf8(base + ((b * 8 + h) * S + s) * 64 + d, o); }
        else if (col < 2816) { const int c2 = col - 2048, seg = c2 >> 7, g = (c2 >> 6) & 1, d = c2 & 63; bf16* base = (bf16*)(ws + A_KC + (size_t)seg * GB); st_bf8(base + ((b * 2 + g) * S + s) * 64 + d, x); }
        else st_f8((float*)(ws + A_GRAW) + (long)row * 24 + (col - 2816), x); } };
#endif
struct EpiCmp1 { static constexpr bool HAS_LD = true; bf16* out; const float* bias;
    __device__ __forceinline__ f8 ld(int row, int col) const { return ld_f8(bias + (row >= NB * 2 * NCP ? 256 : 0) + col); }
    __device__ __forceinline__ void fin(int row, int col, const f8& v, const f8&, const f8& bv) const { f8 o; for (int i = 0; i < 8; ++i) o.v[i] = gelu_tanh(v.v[i] + bv.v[i]); st_bf8(out + (long)row * 256 + col, o); }
    __device__ __forceinline__ void oct(int row, int col, const f8& v, const f8& v2) const { fin(row, col, v, v2, ld(row, col)); } };
struct EpiCmp2 { static constexpr bool HAS_LD = false; bf16* outk; bf16* outv;
    __device__ __forceinline__ void oct(int row, int col, const f8& v, const f8&) const { if (col < 64) { bf16* o = row >= NB * 2 * NCP ? outv + (long)(row - NB * 2 * NCP) * 64 : outk + (long)row * 64; st_bf8(o + col, v); } } };
struct EpiResF32 { static constexpr bool HAS_LD = true; bf16* out; const float* res; int ld_; float sc = 1.0f;
    __device__ __forceinline__ f8 ld(int row, int col) const { return ld_f8(res + (long)row * ld_ + col); }
    __device__ __forceinline__ void fin(int row, int col, const f8& v, const f8&, const f8& r) const { f8 o; for (int i = 0; i < 8; ++i) o.v[i] = DN_ALPHA * r.v[i] + v.v[i] * sc; st_bf8(out + (long)row * ld_ + col, o); }
    __device__ __forceinline__ void oct(int row, int col, const f8& v, const f8& v2) const { fin(row, col, v, v2, ld(row, col)); } };
template <bool OUT_BF> struct EpiResBfT { static constexpr bool HAS_LD = true; float* out; bf16* outb; const bf16* res; int ld_; float sc = 1.0f;
    __device__ __forceinline__ f8 ld(int row, int col) const { return ld_bf8(res + (long)row * ld_ + col); }
    __device__ __forceinline__ void fin(int row, int col, const f8& v, const f8&, const f8& r) const { f8 o; for (int i = 0; i < 8; ++i) o.v[i] = DN_ALPHA * r.v[i] + v.v[i] * sc;
        if (OUT_BF) st_bf8(outb + (long)row * ld_ + col, o); else st_f8(out + (long)row * ld_ + col, o); }
    __device__ __forceinline__ void oct(int row, int col, const f8& v, const f8& v2) const { fin(row, col, v, v2, ld(row, col)); } };
struct EpiLogit { static constexpr bool HAS_LD = false; float* out;
    __device__ __forceinline__ void oct(int row, int col, const f8& v, const f8&) const { if (col < 64) st_f8(out + (long)row * 64 + col, v); } };
struct EpiSwiglu { static constexpr bool HAS_LD = false; bf16* out;
    __device__ __forceinline__ void oct(int row, int col, const f8& v, const f8& v2) const { if ((col & GU_IL) == 0) { f8 o; for (int i = 0; i < 8; ++i) o.v[i] = siluf_(v.v[i]) * v2.v[i];
        st_bf8(out + (long)row * 256 + (col >> 8) * GU_IL + (col & (GU_IL - 1)), o); } } };
#ifndef HOST_EMU
struct EpiSwiglu8 { static constexpr bool HAS_LD = false; unsigned char* out;
    __device__ __forceinline__ void oct(int row, int col, const f8& v, const f8& v2) const { if ((col & GU_IL) == 0) { float o[8]; for (int i = 0; i < 8; ++i) o[i] = siluf_(v.v[i] * F8_ACC_INV) * (v2.v[i] * (F8_ACC_INV * A8_SCALE));
        uint2 w; w.x = pk4_fp8(o[0], o[1], o[2], o[3]); w.y = pk4_fp8(o[4], o[5], o[6], o[7]); *(uint2*)(out + (long)row * 256 + (col >> 8) * GU_IL + (col & (GU_IL - 1))) = w; } } };
#endif
#ifndef HOST_EMU
struct EpiY8 { static constexpr bool HAS_LD = false; unsigned char* out; int ld_; float sc;
    __device__ __forceinline__ void oct(int row, int col, const f8& v, const f8&) const { const float f = Y8_SCALE * sc;
        uint2 w; w.x = pk4_fp8(v.v[0] * f, v.v[1] * f, v.v[2] * f, v.v[3] * f); w.y = pk4_fp8(v.v[4] * f, v.v[5] * f, v.v[6] * f, v.v[7] * f); *(uint2*)(out + (long)row * ld_ + col) = w; } };
#endif
struct EpiY { static constexpr bool HAS_LD = true; unsigned char* out; const float* rowgate; int ld_; float sc = 1.0f;
    __device__ __forceinline__ f8 ld(int row, int) const { f8 r; r.v[0] = rowgate[row]; for (int i = 1; i < 8; ++i) r.v[i] = 0.f; return r; }
    __device__ __forceinline__ void fin(int row, int col, const f8& v, const f8&, const f8& rg) const { const float gt = rg.v[0] * (Y8_SCALE * sc); unsigned char* o = out + (long)row * ld_ + col;
#ifdef HOST_EMU
        for (int i = 0; i < 8; ++i) o[i] = (unsigned char)f2fp8(v.v[i] * gt);
#else
        int w0 = __builtin_amdgcn_cvt_pk_fp8_f32(v.v[0] * gt, v.v[1] * gt, 0, false); w0 = __builtin_amdgcn_cvt_pk_fp8_f32(v.v[2] * gt, v.v[3] * gt, w0, true);
        int w1 = __builtin_amdgcn_cvt_pk_fp8_f32(v.v[4] * gt, v.v[5] * gt, 0, false); w1 = __builtin_amdgcn_cvt_pk_fp8_f32(v.v[6] * gt, v.v[7] * gt, w1, true);
        uint2 w; w.x = (unsigned)w0; w.y = (unsigned)w1; *(uint2*)o = w;
#endif
    }
    __device__ __forceinline__ void oct(int row, int col, const f8& v, const f8& v2) const { fin(row, col, v, v2, ld(row, col)); } };
struct EpiBf { static constexpr bool HAS_LD = false; bf16* out; int ld; float sc = 1.0f;
    __device__ __forceinline__ void oct(int row, int col, const f8& v, const f8&) const { f8 o; for (int i = 0; i < 8; ++i) o.v[i] = v.v[i] * sc; st_bf8(out + (long)row * ld + col, o); } };
#ifndef HOST_EMU
struct EpiGlu8 { static constexpr bool HAS_LD = true; unsigned char* out; const unsigned char* ys; int ld_; int pad = 0;
    __device__ __forceinline__ f8 ld(int row, int col) const { const uint2 w = *(const uint2*)(ys + (long)row * ld_ + col); f8 r;
        const auto a0 = __builtin_amdgcn_cvt_pk_f32_fp8((int)w.x, false), a1 = __builtin_amdgcn_cvt_pk_f32_fp8((int)w.x, true), a2 = __builtin_amdgcn_cvt_pk_f32_fp8((int)w.y, false), a3 = __builtin_amdgcn_cvt_pk_f32_fp8((int)w.y, true);
        r.v[0] = a0[0]; r.v[1] = a0[1]; r.v[2] = a1[0]; r.v[3] = a1[1]; r.v[4] = a2[0]; r.v[5] = a2[1]; r.v[6] = a3[0]; r.v[7] = a3[1]; return r; }
    __device__ __forceinline__ void fin(int row, int col, const f8& v, const f8&, const f8& y) const { float o[8]; for (int i = 0; i < 8; ++i) o[i] = y.v[i] * sigmoidf_(v.v[i] * F8_ACC_INV);
        uint2 w; w.x = pk4_fp8(o[0], o[1], o[2], o[3]); w.y = pk4_fp8(o[4], o[5], o[6], o[7]); *(uint2*)(out + (long)row * ld_ + col) = w; }
    __device__ __forceinline__ void oct(int row, int col, const f8& v, const f8& v2) const { fin(row, col, v, v2, ld(row, col)); } };
#endif
struct EpiGlu { static constexpr bool HAS_LD = true; bf16* out; const bf16* ys; int ld_; int pad = 0;
    __device__ __forceinline__ f8 ld(int row, int col) const { return ld_bf8(ys + (long)row * ld_ + col); }
    __device__ __forceinline__ void fin(int row, int col, const f8& v, const f8&, const f8& y) const { f8 o; for (int i = 0; i < 8; ++i) o.v[i] = y.v[i] * sigmoidf_(v.v[i]); st_bf8(out + (long)row * ld_ + col, o); }
    __device__ __forceinline__ void oct(int row, int col, const f8& v, const f8& v2) const { fin(row, col, v, v2, ld(row, col)); } };

struct Unit { int pm, pn; };
struct StaticOrder {
    int nM, nN, nwg, G, c;
    __host__ __device__ void init(int M, int N, int G_, int c_) { nM = M / 256; nN = N / 256; nwg = nM * nN; G = G_; c = c_; }
    __host__ __device__ bool next(int i, Unit& u) const {
        const long L = (long)i * G + c; if (L >= nwg) return false;
        int wgid = (int)L; { const int q = nwg / 8, r = nwg % 8, xcd = wgid % 8, off = wgid / 8; wgid = (xcd < r ? xcd * (q + 1) : r * (q + 1) + (xcd - r) * q) + off; }
        const int nig = 8 * nN, gid = wgid / nig, fm = gid * 8, gsz = (nM - fm) < 8 ? (nM - fm) : 8;
        u.pm = fm + ((wgid % nig) % gsz); u.pn = (wgid % nig) / gsz; return true;
    }
};

#ifndef HOST_EMU
typedef short bf16x8_t __attribute__((ext_vector_type(8)));
typedef float f32x4_t __attribute__((ext_vector_type(4)));
#define LAS __attribute__((address_space(3)))
constexpr int HTB = 128 * 64 * 2;
__device__ __forceinline__ int lds_byte(int r, int c) { const int st = (r >> 4) * 2 + (c >> 5), rr = r & 15, cc = c & 31, ob = rr * 64 + cc * 2; return st * 1024 + (ob ^ (((ob >> 9) & 1) << 5)); }
__device__ __forceinline__ void stage_rc(int b, int& R, int& C) { const int st = b / 1024, sb = b % 1024, swz = sb ^ (((sb >> 9) & 1) << 5); R = (st >> 1) * 16 + swz / 64; C = (st & 1) * 32 + (swz % 64) / 2; }

typedef int i32x4_t __attribute__((ext_vector_type(4)));
typedef int i32x8_t __attribute__((ext_vector_type(8)));
template <class Epi, bool F8 = false, bool TE_LDS = false>
__device__ __forceinline__ void ph_gemm(const GemmArgs g, const Epi E, unsigned char* lds_) {
    LAS unsigned char* lds = (LAS unsigned char*)lds_;
    int tid = threadIdx.x; asm volatile("" : "+v"(tid));
    const int wid = __builtin_amdgcn_readfirstlane(tid >> 6), lane = tid & 63, wr = wid >> 2, wc = wid & 3, fr = lane & 15, fq = lane >> 4;
    const int K = g.K, nt = K / 64;
    const int Mrt = g.m_rt ? __builtin_amdgcn_readfirstlane(*g.m_rt) : g.M;
    StaticOrder S; S.init(Mrt, g.N, g.grid, (int)blockIdx.x);
    int RA[2]; unsigned CA2[2], voffB[2];
#pragma unroll
    for (int i = 0; i < 2; ++i) { int R, C; stage_rc(tid * 16 + i * 8192, R, C); RA[i] = R; CA2[i] = (unsigned)C * 2u;
        const int rho = R & 31, Rb = (R & ~31) + 8 * ((rho & 15) >> 2) + 4 * (rho >> 4) + (rho & 3);
        voffB[i] = (unsigned)(Rb * K + C) * 2u; }
    const size_t kstep = 128;
    const size_t hstepB = (size_t)128 * K * 2, tstepB = 2 * hstepB;
    const unsigned lda2 = (unsigned)g.lda * 2u;
    const unsigned ldsw = (unsigned)wid * 1024u;
    const int aoff = lds_byte(wr * 64 + fr, fq * 8), boff = lds_byte(wc * 32 + fr, fq * 8);
    const char* gA = (const char*)g.A;
#define PG8_SA(b, h) (((b) * 2 + (h)) * HTB)
#define PG8_SB(b, h) ((4 + (b) * 2 + (h)) * HTB)
#define PG8_STAGE_B(bufoff, gbase) do { _Pragma("unroll") for (int _i = 0; _i < 2; ++_i) \
        __builtin_amdgcn_global_load_lds((const unsigned*)((const char*)(gbase) + voffB[_i]), (LAS unsigned*)(lds + (bufoff) + ldsw + _i * 8192), 16, 0, 0); } while (0)
#define PG8_STAGE_A(bufoff, kbase, o0, o1) do { \
        __builtin_amdgcn_global_load_lds((const unsigned*)((kbase) + (o0)), (LAS unsigned*)(lds + (bufoff) + ldsw), 16, 0, 0); \
        __builtin_amdgcn_global_load_lds((const unsigned*)((kbase) + (o1)), (LAS unsigned*)(lds + (bufoff) + ldsw + 8192), 16, 0, 0); } while (0)
#define PG8_LDA(dst, b, h) do { _Pragma("unroll") for (int m = 0; m < 4; ++m) { dst[m].lo = *(const LAS i32x4_t*)(lds + PG8_SA(b, h) + aoff + m * 2048); dst[m].hi = *(const LAS i32x4_t*)(lds + PG8_SA(b, h) + aoff + m * 2048 + 1024); } } while (0)
#define PG8_LDB(dst, b, h) do { _Pragma("unroll") for (int n = 0; n < 2; ++n) { dst[n].lo = *(const LAS i32x4_t*)(lds + PG8_SB(b, h) + boff + n * 2048); dst[n].hi = *(const LAS i32x4_t*)(lds + PG8_SB(b, h) + boff + n * 2048 + 1024); } } while (0)
#define F8_SC 0
#define PG8_MMA(ai, bj, At, Bt) do { __builtin_amdgcn_s_setprio(1); \
        if constexpr (F8) { _Pragma("unroll") for (int m = 0; m < 4; ++m) _Pragma("unroll") for (int n = 0; n < 2; ++n) \
            asm volatile("v_mfma_f32_16x16x128_f8f6f4 %0, %1, %2, %0" : "+v"(acc[ai][bj][m][n]) : "v"(Bt[n]), "v"(At[m])); } \
        else { _Pragma("unroll") for (int m = 0; m < 4; ++m) _Pragma("unroll") for (int n = 0; n < 2; ++n) _Pragma("unroll") for (int k = 0; k < 2; ++k) \
            acc[ai][bj][m][n] = __builtin_amdgcn_mfma_f32_16x16x32_bf16(__builtin_bit_cast(bf16x8_t, k ? Bt[n].hi : Bt[n].lo), __builtin_bit_cast(bf16x8_t, k ? At[m].hi : At[m].lo), acc[ai][bj][m][n], 0, 0, 0); } \
        __builtin_amdgcn_s_setprio(0); } while (0)
#define PG8_WAIT_V(n) asm volatile("s_waitcnt vmcnt(" #n ")" ::: "memory")
#define PG8_WAIT_L(n) asm volatile("s_waitcnt lgkmcnt(" #n ")" ::: "memory")
#define PG8_BAR __builtin_amdgcn_s_barrier()
#define PG8_SCHED __builtin_amdgcn_sched_barrier(0)
#define PG8_OFFS(u, o) do { _Pragma("unroll") for (int _h = 0; _h < 2; ++_h) _Pragma("unroll") for (int _i = 0; _i < 2; ++_i) { const int _row = (u).pm * 256 + _h * 128 + RA[_i]; \
        const unsigned _ri = g.rowidx ? (unsigned)g.rowidx[_row] : (unsigned)_row; o[_h][_i] = _ri * lda2 + CA2[_i]; } } while (0)
#define PG8_BBASE(u) ((const char*)g.Bt + (g.tile_e ? (size_t)__builtin_amdgcn_readfirstlane(TE_LDS ? *(const LAS int*)(lds + GEMM_LDS + 4 * (u).pm) : g.tile_e[(u).pm]) * (size_t)g.b_estride * 2 : (size_t)0) + (size_t)(u).pn * tstepB)
    Unit cur, nxt; int ui = 0;
    if (!S.next(0, cur)) return;
    f32x4_t acc[2][2][4][2];
#pragma unroll
    for (int a = 0; a < 2; ++a)
#pragma unroll
        for (int b = 0; b < 2; ++b)
#pragma unroll
            for (int m = 0; m < 4; ++m)
#pragma unroll
                for (int n = 0; n < 2; ++n) acc[a][b][m][n] = (f32x4_t){0.f, 0.f, 0.f, 0.f};
    i32x8_t At[4], B0[2], B1[2];
    unsigned oc[2][2], on[2][2];
    PG8_OFFS(cur, oc);
    const char* cB = PG8_BBASE(cur);
    PG8_STAGE_B(PG8_SB(0, 0), cB); PG8_STAGE_B(PG8_SB(0, 1), cB + hstepB); PG8_STAGE_A(PG8_SA(0, 0), gA, oc[0][0], oc[0][1]); PG8_STAGE_A(PG8_SA(0, 1), gA, oc[1][0], oc[1][1]);
    if (wr == 1) PG8_BAR;
    PG8_WAIT_V(2); PG8_BAR;
    PG8_STAGE_B(PG8_SB(1, 0), cB + kstep); PG8_STAGE_A(PG8_SA(1, 0), gA + kstep, oc[0][0], oc[0][1]); PG8_STAGE_B(PG8_SB(1, 1), cB + hstepB + kstep);
    PG8_WAIT_V(6); PG8_BAR;
    for (;;) {
        const bool has_next = S.next(ui + 1, nxt);
        const char* nB = cB;
        if (has_next) { PG8_OFFS(nxt, on); nB = PG8_BBASE(nxt); }
        else {
#pragma unroll
            for (int h = 0; h < 2; ++h)
#pragma unroll
                for (int i = 0; i < 2; ++i) on[h][i] = oc[h][i];
        }
        for (int t = 0; t < nt; t += 2) {
            const bool last = (t == nt - 2);
            const char* a1 = gA + (size_t)(t + 1) * kstep;
            const char* a2 = last ? gA : gA + (size_t)(t + 2) * kstep; const char* b2 = last ? nB : cB + (size_t)(t + 2) * kstep;
            const char* a3 = a2 + kstep; const char* b3 = b2 + kstep;
            const unsigned o00 = last ? on[0][0] : oc[0][0], o01 = last ? on[0][1] : oc[0][1], o10 = last ? on[1][0] : oc[1][0], o11 = last ? on[1][1] : oc[1][1];
            PG8_LDB(B0, 0, 0); PG8_LDB(B1, 0, 1); PG8_SCHED; PG8_LDA(At, 0, 0); PG8_STAGE_A(PG8_SA(1, 1), a1, oc[1][0], oc[1][1]);
            PG8_WAIT_V(8); PG8_WAIT_L(0); PG8_BAR; PG8_MMA(0, 0, At, B0); PG8_MMA(0, 1, At, B1); PG8_BAR; PG8_SCHED;
            PG8_LDA(At, 0, 1); PG8_STAGE_B(PG8_SB(0, 0), b2); PG8_STAGE_B(PG8_SB(0, 1), b2 + hstepB); PG8_STAGE_A(PG8_SA(0, 0), a2, o00, o01);
            PG8_WAIT_V(8); PG8_WAIT_L(0); PG8_BAR; PG8_MMA(1, 0, At, B0); PG8_MMA(1, 1, At, B1); PG8_BAR; PG8_SCHED;
            PG8_LDB(B0, 1, 0); PG8_LDB(B1, 1, 1); PG8_SCHED; PG8_LDA(At, 1, 0); PG8_STAGE_A(PG8_SA(0, 1), a2, o10, o11);
            PG8_WAIT_V(8); PG8_WAIT_L(0); PG8_BAR; PG8_MMA(0, 0, At, B0); PG8_MMA(0, 1, At, B1); PG8_BAR; PG8_SCHED;
            PG8_LDA(At, 1, 1); PG8_STAGE_B(PG8_SB(1, 0), b3); PG8_STAGE_B(PG8_SB(1, 1), b3 + hstepB); PG8_STAGE_A(PG8_SA(1, 0), a3, o00, o01);
            PG8_WAIT_V(8); PG8_WAIT_L(0); PG8_BAR; PG8_MMA(1, 0, At, B0); PG8_MMA(1, 1, At, B1); PG8_BAR; PG8_SCHED;
        }
        if (wr == 0) PG8_BAR;
        if constexpr (F8) asm volatile("s_nop 15\n\ts_nop 15" ::: "memory");
        {
            f8 raw[4], rawn[4];
#define PG8_EPI_LD(dst, ai_, mp_) do { _Pragma("unroll") for (int mm = 0; mm < 2; ++mm) _Pragma("unroll") for (int bj = 0; bj < 2; ++bj) \
                dst[mm * 2 + bj] = E.ld(cur.pm * 256 + (ai_) * 128 + wr * 64 + ((mp_) * 2 + mm) * 16 + fr, cur.pn * 256 + bj * 128 + wc * 32 + fq * 8); } while (0)
            if constexpr (Epi::HAS_LD) PG8_EPI_LD(rawn, 0, 0);
#pragma unroll
            for (int b4 = 0; b4 < 4; ++b4) { const int ai = b4 >> 1, mp = b4 & 1;
                if constexpr (Epi::HAS_LD) {
#pragma unroll
                    for (int i = 0; i < 4; ++i) raw[i] = rawn[i];
                    if (b4 < 3) PG8_EPI_LD(rawn, (b4 + 1) >> 1, (b4 + 1) & 1);
                }
#pragma unroll
                for (int mm = 0; mm < 2; ++mm) { const int m = mp * 2 + mm, row = cur.pm * 256 + ai * 128 + wr * 64 + m * 16 + fr;
#pragma unroll
                    for (int bj = 0; bj < 2; ++bj) { f8 v, v2;
#pragma unroll
                        for (int n = 0; n < 2; ++n)
#pragma unroll
                            for (int q = 0; q < 4; ++q) { v.v[4 * n + q] = acc[ai][bj][m][n][q]; v2.v[4 * n + q] = acc[ai][bj ^ 1][m][n][q]; }
                        const int col = cur.pn * 256 + bj * 128 + wc * 32 + fq * 8;
                        if constexpr (Epi::HAS_LD) E.fin(row, col, v, v2, raw[mm * 2 + bj]); else E.oct(row, col, v, v2); } }
            }
#undef PG8_EPI_LD
        }
        if (!has_next) break;
#pragma unroll
        for (int a = 0; a < 2; ++a)
#pragma unroll
            for (int b = 0; b < 2; ++b)
#pragma unroll
                for (int m = 0; m < 4; ++m)
#pragma unroll
                    for (int n = 0; n < 2; ++n) acc[a][b][m][n] = (f32x4_t){0.f, 0.f, 0.f, 0.f};
        cur = nxt; cB = nB; ++ui;
#pragma unroll
        for (int h = 0; h < 2; ++h)
#pragma unroll
            for (int i = 0; i < 2; ++i) oc[h][i] = on[h][i];
        if (wr == 1) PG8_BAR;
    }
    PG8_WAIT_V(0);
    PG8_BAR;
#undef PG8_SA
#undef PG8_SB
#undef PG8_STAGE_A
#undef PG8_STAGE_B
#undef PG8_LDA
#undef PG8_LDB
#undef PG8_MMA
#undef PG8_WAIT_V
#undef PG8_WAIT_L
#undef PG8_BAR
#undef PG8_SCHED
#undef PG8_OFFS
#undef PG8_BBASE
}
#else
template <class Epi> static void ph_gemm(const GemmArgs g, const Epi E, unsigned char*) {
    static float Ct[256][256];
    const int Mrt = g.m_rt ? *g.m_rt : g.M;
    StaticOrder S; S.init(Mrt, g.N, GDIM_OF(g), BIDX); Unit u;
    for (int i = 0; S.next(i, u); ++i) {
        const int brow = u.pm * 256, bcol = u.pn * 256; const bf16* Bg = g.Bt + (g.tile_e ? (long)g.tile_e[u.pm] * g.b_estride : 0);
        for (int r = 0; r < 256; ++r) { const long ridx = g.rowidx ? g.rowidx[brow + r] : brow + r; const bf16* a = g.A + ridx * g.lda;
            for (int c = 0; c < 256; ++c) { const bf16* bt = Bg + (long)(bcol + c) * g.K; float s = 0.f; for (int k = 0; k < g.K; ++k) s += bf2f(a[k]) * bf2f(bt[k]); Ct[r][c] = s; } }
        for (int r = 0; r < 256; ++r) for (int c = 0; c < 256; c += 8) { f8 v, v2; for (int q = 0; q < 8; ++q) { v.v[q] = Ct[r][c + q]; v2.v[q] = Ct[r][(c ^ 128) + q]; } E.oct(brow + r, bcol + c, v, v2); }
    }
}
#endif
__host__ __device__ __forceinline__ GemmArgs mk_gemm_(int grid, const bf16* A, long lda, const bf16* Bt, int M, int N, int K) {
    GemmArgs g; g.grid = grid; g.A = A; g.Bt = Bt; g.rowidx = nullptr; g.tile_e = nullptr; g.m_rt = nullptr; g.lda = lda; g.b_estride = 0; g.M = M; g.N = N; g.K = K; return g; }
#define mk_gemm(...) mk_gemm_(p.grid, __VA_ARGS__)
__host__ __device__ __forceinline__ XposeJob mk_xpose_(int grid, const float* src, bf16* dst, int K, int N, int Ncover, int il, int il2, int add, int batch, long ss, long ds) {
    XposeJob j; j.grid = grid; j.src = src; j.dst = dst; j.K = K; j.N = N; j.Ncover = Ncover; j.il = il; j.il2 = il2; j.add = add; j.batch = batch; j.sstride = ss; j.dstride = ds; j.first = 0; return j; }
#define mk_xpose(...) mk_xpose_(p.grid, __VA_ARGS__)

#ifndef HOST_EMU
#define XB_TMO      128
#define XB_XCNT(j)  (256  + 64 * (j))
#define XB_XSUB(j)  (1280 + 64 * (j))
#define XB_XGEN(j)  (2304 + 64 * (j))
#define XB_TOP      3328
#define XB_TOPGEN   3392
#define XCD_BAR_WORDS 3456
#define XB_SPIN_CAP (1u << 18)
__device__ __forceinline__ unsigned xb_ld(unsigned* p)              { return __hip_atomic_load(p, __ATOMIC_RELAXED, __HIP_MEMORY_SCOPE_AGENT); }
__device__ __forceinline__ unsigned xb_add(unsigned* p, unsigned v) { return __hip_atomic_fetch_add(p, v, __ATOMIC_RELAXED, __HIP_MEMORY_SCOPE_AGENT); }
__device__ __forceinline__ unsigned xb_xcc_id() { return (unsigned)__builtin_amdgcn_s_getreg((3 << 11) | 20) & 0xFu; }
#define XB_SPIN(cond, bar) do { unsigned _sp = 0; while (cond) { __builtin_amdgcn_s_sleep(1); \
    if ((++_sp & 255u) == 0u) { if (xb_ld(&(bar)[XB_TMO])) break; if (_sp > XB_SPIN_CAP) { atomicAdd(&(bar)[XB_TMO], 1u); break; } } } } while (0)
struct XcdBarrier { unsigned* bar; unsigned x; volatile LAS unsigned* st; unsigned G; };
__device__ __forceinline__ XcdBarrier xcd_barrier_post(unsigned* bar, volatile LAS unsigned* st, unsigned G) {
    XcdBarrier b; b.bar = bar; b.x = xb_xcc_id(); b.st = st; b.G = G;
    if (threadIdx.x == 0) (void)xb_add(&bar[XB_XCNT(b.x)], 1u);
    return b;
}
__device__ __forceinline__ void xcd_barrier_complete(unsigned* bar, unsigned x, unsigned G, unsigned& nloc, unsigned& nx) {
    unsigned sum, cnt, mine, sp = 0u;
    for (;;) {
        sum = 0u; cnt = 0u; mine = 0u;
#pragma unroll
        for (unsigned j = 0; j < 16; ++j) { const unsigned c = xb_ld(&bar[XB_XCNT(j)]); sum += c; cnt += (c > 0u) ? 1u : 0u; mine = (j == x) ? c : mine; }
        if (sum == G) break;
        __builtin_amdgcn_s_sleep(1);
        if ((++sp & 255u) == 0u) { if (xb_ld(&bar[XB_TMO])) break; if (sp > XB_SPIN_CAP) { atomicAdd(&bar[XB_TMO], 1u); break; } }
    }
    nloc = mine > 0u ? mine : 1u; nx = cnt > 0u ? cnt : 1u;
}
__device__ __forceinline__ void xcd_barrier(const XcdBarrier& b) {
    asm volatile("s_waitcnt vmcnt(0)" ::: "memory");
    __syncthreads();
    if (threadIdx.x == 0) {
        unsigned* bar = b.bar;
        __builtin_amdgcn_s_waitcnt(0);
        unsigned nloc = b.st[0], nx = b.st[1];
        if (nloc == 0u) { xcd_barrier_complete(bar, b.x, b.G, nloc, nx); b.st[0] = nloc; b.st[1] = nx; }
        const unsigned old = xb_add(&bar[XB_XSUB(b.x)], 1u);
        const unsigned gen = old / nloc;
        if (old + 1u == (gen + 1u) * nloc) {
            __builtin_amdgcn_fence(__ATOMIC_RELEASE, "agent");
            asm volatile("s_waitcnt vmcnt(0)" ::: "memory");
            const unsigned og = xb_add(&bar[XB_TOP], 1u);
            const unsigned tg = og / nx;
            if (og + 1u == (tg + 1u) * nx) xb_add(&bar[XB_TOPGEN], 1u);
            else XB_SPIN(xb_ld(&bar[XB_TOPGEN]) == tg, bar);
            __builtin_amdgcn_fence(__ATOMIC_ACQUIRE, "agent");
            xb_add(&bar[XB_XGEN(b.x)], 1u);
            asm volatile("s_waitcnt vmcnt(0)" ::: "memory");
        } else {
            XB_SPIN(xb_ld(&bar[XB_XGEN(b.x)]) == gen, bar);
            __builtin_amdgcn_fence(__ATOMIC_ACQUIRE, "agent");
            asm volatile("s_waitcnt vmcnt(0)" ::: "memory");
        }
    }
    __syncthreads();
}
#define PHASE_BEGIN {
#define PHASE_END } xcd_barrier(gbar);
#define PROGRAM_ARGS const P& p, unsigned char* lds, const XcdBarrier& gbar
#else
constexpr int EMU_GRID = 4;
#define PHASE_BEGIN for (int _b = 0; _b < EMU_GRID; ++_b) { e_blockIdx.x = _b;
#define PHASE_END }
#define PROGRAM_ARGS const P& p, unsigned char* lds, int gbar
#endif


#ifndef HOST_EMU
typedef float f32x16_t __attribute__((ext_vector_type(16)));
typedef short s16x4_t __attribute__((ext_vector_type(4)));
typedef float f32x2_t __attribute__((ext_vector_type(2)));
typedef __bf16 bf16x2_t __attribute__((ext_vector_type(2)));
typedef unsigned u32x4_t __attribute__((ext_vector_type(4)));
typedef unsigned u32x2_t __attribute__((ext_vector_type(2)));
__device__ __forceinline__ int crow(int r, int hi) { return (r & 3) + 8 * (r >> 2) + 4 * hi; }
__device__ __forceinline__ unsigned cvtpk(float lo, float hi) { f32x2_t v = {lo, hi}; bf16x2_t b = __builtin_convertvector(v, bf16x2_t); return __builtin_bit_cast(unsigned, b); }
__device__ __forceinline__ float xhalf_max(float m) { auto rr = __builtin_amdgcn_permlane32_swap(__float_as_uint(m), __float_as_uint(m), false, false); return fmaxf(__uint_as_float(rr[0]), __uint_as_float(rr[1])); }
__device__ __forceinline__ float xhalf_sum(float m) { auto rr = __builtin_amdgcn_permlane32_swap(__float_as_uint(m), __float_as_uint(m), false, false); return __uint_as_float(rr[0]) + __uint_as_float(rr[1]); }
constexpr int N2_SLOT = 16384;
constexpr int N2_IMPA = 2 * N2_SLOT, N2_IMPB = N2_IMPA + 32768, N2_IMPT = N2_IMPB + 32768, N2_SEL = N2_IMPT + 8192, N2_END = N2_SEL + 512;
static_assert(N2_END <= GEMM_LDS, "nsa lds");
__device__ __forceinline__ void n2_qk(f32x16_t& p0, f32x16_t& p1, const LAS unsigned char* Ks, const bf16x8_t (&qr)[4], int r32, int hi) {
#pragma unroll
    for (int r = 0; r < 16; ++r) { p0[r] = 0.f; p1[r] = 0.f; }
    asm volatile("" : "+v"(p0), "+v"(p1));
#pragma unroll
    for (int ks = 0; ks < 4; ++ks) { const int c = ((2 * ks + hi) ^ (r32 & 7)) * 16;
        const bf16x8_t k0 = *(const LAS bf16x8_t*)(Ks + r32 * 128 + c), k1 = *(const LAS bf16x8_t*)(Ks + (32 + r32) * 128 + c);
        p0 = __builtin_amdgcn_mfma_f32_32x32x16_bf16(k0, qr[ks], p0, 0, 0, 0); p1 = __builtin_amdgcn_mfma_f32_32x32x16_bf16(k1, qr[ks], p1, 0, 0, 0); }
}
__device__ __forceinline__ void n2_pv(f32x16_t& o0, f32x16_t& o1, const LAS unsigned char* Vs, const f32x16_t& p0, const f32x16_t& p1, int lane) {
    const int hi = lane >> 5; const LAS unsigned char* vb = Vs + (4 * hi + ((lane & 15) >> 2)) * 128 + (((lane >> 4) & 1) * 16 + (lane & 3) * 4) * 2;
#pragma unroll
    for (int s = 0; s < 4; ++s) {
        bf16x8_t pb;
        { const f32x16_t& pp = (s < 2) ? p0 : p1; const int r0 = 8 * (s & 1);
          union { unsigned u[4]; bf16x8_t v; } pk; pk.u[0] = cvtpk(pp[r0], pp[r0 + 1]); pk.u[1] = cvtpk(pp[r0 + 2], pp[r0 + 3]); pk.u[2] = cvtpk(pp[r0 + 4], pp[r0 + 5]); pk.u[3] = cvtpk(pp[r0 + 6], pp[r0 + 7]); pb = pk.v; }
#pragma unroll
        for (int d0 = 0; d0 < 2; ++d0) {
            const s16x4_t lo = __builtin_bit_cast(s16x4_t, __builtin_amdgcn_ds_read_tr16_b64_v4i16((LAS s16x4_t*)(vb + s * 2048 + d0 * 64)));
            const s16x4_t hh = __builtin_bit_cast(s16x4_t, __builtin_amdgcn_ds_read_tr16_b64_v4i16((LAS s16x4_t*)(vb + s * 2048 + 1024 + d0 * 64)));
            const bf16x8_t vf = (bf16x8_t){lo[0], lo[1], lo[2], lo[3], hh[0], hh[1], hh[2], hh[3]};
            if (d0 == 0) o0 = __builtin_amdgcn_mfma_f32_32x32x16_bf16(vf, pb, o0, 0, 0, 0); else o1 = __builtin_amdgcn_mfma_f32_32x32x16_bf16(vf, pb, o1, 0, 0, 0);
        }
    }
}
__device__ __forceinline__ void ph_nsa2(const P& p, unsigned char* lds_) {
    LAS unsigned char* lds = (LAS unsigned char*)lds_;
    int tid = threadIdx.x; asm volatile("" : "+v"(tid));
    const int lane = tid & 63, wid = __builtin_amdgcn_readfirstlane(tid >> 6), r32 = lane & 31, hi = lane >> 5;
    const int hr = wid >> 1, tsub = (wid & 1) * 32 + r32;
    const int skey = tid >> 3, sch = tid & 7;
    const unsigned soff = (unsigned)(skey * 128 + sch * 16);
    const bf16* QB = WSP(bf16, A_QB); bf16* ATT = WSP(bf16, A_ATT);
    const bf16* KCMP = WSP(bf16, A_KCMP); const bf16* VCMP = WSP(bf16, A_VCMP);
    const bf16* KS = WSP(bf16, A_KS); const bf16* VS = WSP(bf16, A_VS); const bf16* KW = WSP(bf16, A_KW); const bf16* VW = WSP(bf16, A_VW);
    LAS float* IMPA = (LAS float*)(lds + N2_IMPA); LAS float* IMPB = (LAS float*)(lds + N2_IMPB); LAS float* IMPT = (LAS float*)(lds + N2_IMPT); LAS unsigned* SEL = (LAS unsigned*)(lds + N2_SEL);
    constexpr int NQT = S / 64, NBG = NB * 2, NUNITS = NBG * NQT;
#define N2_LOAD(Kp, Vp, row0, kreg, vreg) do { const long rb_ = (long)(row0) * 128;     \
        kreg = *(const u32x4_t*)((const char*)(Kp) + rb_ + soff); vreg = *(const u32x4_t*)((const char*)(Vp) + rb_ + soff); } while (0)
#define N2_STORE(slot, kreg, vreg) do { *(LAS u32x4_t*)(lds + (slot) * N2_SLOT + skey * 128 + ((sch ^ (skey & 7)) * 16)) = kreg; *(LAS u32x4_t*)(lds + (slot) * N2_SLOT + 8192 + skey * 128 + sch * 16) = vreg; } while (0)
    for (int unit0 = blockIdx.x; unit0 < NUNITS; unit0 += p.grid) {
        int unit = unit0;
        if (p.grid % NBG == 0) { const int per = p.grid / NBG, k = unit0 / p.grid, c0 = (unit0 % p.grid) / NBG; if ((k & 1) && (k + 1) * p.grid <= NUNITS) unit = k * p.grid + (per - 1 - c0) * NBG + unit0 % NBG; }
        const int bg = unit % NBG, qt = unit / NBG, g = bg & 1, b = bg >> 1, t0 = qt * 64, t = t0 + tsub, cur = qt;
        const long kvrow = (long)bg * S;
        bf16x8_t qr[4];
        { const bf16* qrow = QB + ((long)(b * 8 + g * 4 + hr) * S + t) * 64;
#pragma unroll
          for (int ks = 0; ks < 4; ++ks) qr[ks] = *(const bf16x8_t*)(qrow + ks * 16 + hi * 8); }
        float gate[3];
        { const float* gr = WSP(float, A_GRAW) + ((long)b * S + t) * 24 + (g * 4 + hr) * 3;
#pragma unroll
          for (int i = 0; i < 3; ++i) gate[i] = sigmoidf_(gr[i]); }
        f32x16_t oa0, oa1;
#pragma unroll
        for (int r = 0; r < 16; ++r) { oa0[r] = 0.f; oa1[r] = 0.f; }
        asm volatile("" : "+v"(oa0), "+v"(oa1));
        u32x4_t kreg, vreg;
        N2_LOAD(KCMP, VCMP, (long)bg * NCP, kreg, vreg); N2_STORE(0, kreg, vreg);
        N2_LOAD(KCMP, VCMP, (long)bg * NCP + 64, kreg, vreg); N2_STORE(1, kreg, vreg);
        if (tid < 64) SEL[64 + 0] = 0u;
        __syncthreads();
        {
            f32x16_t c0, c1, c2, c3;
            n2_qk(c0, c1, lds, qr, r32, hi); n2_qk(c2, c3, lds + N2_SLOT, qr, r32, hi);
            float m = -1e30f;
            int nlim = (t >= 31) ? ((t - 31) >> 4) : -1; nlim = (nlim > NCMP - 1 ? NCMP - 1 : nlim) - 4 * hi;
            asm volatile("" : "+v"(nlim));
#pragma unroll
            for (int r = 0; r < 16; ++r) { const int nc = (r & 3) + 8 * (r >> 2);
                if (nc > nlim) c0[r] = -INFINITY;
                if (nc + 32 > nlim) c1[r] = -INFINITY;
                if (nc + 64 > nlim) c2[r] = -INFINITY;
                if (nc + 96 > nlim) c3[r] = -INFINITY;
                m = fmaxf(fmaxf(m, c0[r]), fmaxf(c1[r], fmaxf(c2[r], c3[r]))); }
            m = xhalf_max(m);
            float l = 0.f;
#pragma unroll
            for (int r = 0; r < 16; ++r) { c0[r] = __builtin_amdgcn_exp2f(c0[r] - m); c1[r] = __builtin_amdgcn_exp2f(c1[r] - m); c2[r] = __builtin_amdgcn_exp2f(c2[r] - m); c3[r] = __builtin_amdgcn_exp2f(c3[r] - m); l += (c0[r] + c1[r]) + (c2[r] + c3[r]); }
            l = xhalf_sum(l);
            const float inv = l > 0.f ? 1.0f / l : 0.f;
#pragma unroll
            for (int r = 0; r < 16; ++r) { c0[r] *= inv; c1[r] *= inv; c2[r] *= inv; c3[r] *= inv; }
            asm volatile("" : "+v"(c0), "+v"(c1), "+v"(c2), "+v"(c3));
            { LAS float* ia = IMPA + ((wid * 2 + hi) * 32 + r32) * 16; LAS float* ib = IMPB + ((wid * 2 + hi) * 32 + r32) * 16;
#pragma unroll
              for (int gi = 0; gi < 4; ++gi) {
                  ia[0 + gi] = (c0[4 * gi] + c0[4 * gi + 1]) + (c0[4 * gi + 2] + c0[4 * gi + 3]); ib[0 + gi] = c0[4 * gi + 3];
                  ia[4 + gi] = (c1[4 * gi] + c1[4 * gi + 1]) + (c1[4 * gi + 2] + c1[4 * gi + 3]); ib[4 + gi] = c1[4 * gi + 3];
                  ia[8 + gi] = (c2[4 * gi] + c2[4 * gi + 1]) + (c2[4 * gi + 2] + c2[4 * gi + 3]); ib[8 + gi] = c2[4 * gi + 3];
                  ia[12 + gi] = (c3[4 * gi] + c3[4 * gi + 1]) + (c3[4 * gi + 2] + c3[4 * gi + 3]); ib[12 + gi] = c3[4 * gi + 3]; } }
#pragma unroll
            for (int r = 0; r < 16; ++r) { c0[r] *= gate[0]; c1[r] *= gate[0]; c2[r] *= gate[0]; c3[r] *= gate[0]; }
            n2_pv(oa0, oa1, lds + 8192, c0, c1, lane); n2_pv(oa0, oa1, lds + N2_SLOT + 8192, c2, c3, lane);
        }
        __syncthreads();
        if (tid < 64) {
            const int tt = tid, th = tt >> 5, tr = tt & 31; LAS float* im = IMPT + tt * 32;
            for (int m = 0; m < 32; ++m) { float sacc = 0.f;
                if (m < NSLC) {
#pragma unroll
                    for (int r = 0; r < 4; ++r) { const int w = 2 * r + th; sacc += IMPA[((w * 2 + (m & 1)) * 32 + tr) * 16 + (m >> 1)]; if (m >= 1) sacc += IMPB[((w * 2 + ((m - 1) & 1)) * 32 + tr) * 16 + ((m - 1) >> 1)]; } }
                const bool valid = m <= cur, forced = (m == 0) || (valid && m > cur - 2);
                im[m] = (m < NSLC) ? (forced ? sacc + 1e4f : (valid ? sacc : -1e30f)) : -3.4e38f; }
            unsigned sm = 0u;
            for (int i = 0; i < 8; ++i) { int best = 0; float bv = -3.4e38f; for (int m = 0; m < NSLC; ++m) { const float v = im[m]; if (v > bv) { bv = v; best = m; } } im[best] = -3.4e38f; if (best <= cur) sm |= 1u << best; }
            SEL[tt] = sm; atomicOr((unsigned*)&SEL[64], sm);
        }
        __syncthreads();
        const unsigned mysel = SEL[tsub];
#pragma unroll
        for (int br = 0; br < 2; ++br) {
            const bf16* Kp = br == 0 ? KS : KW; const bf16* Vp = br == 0 ? VS : VW;
            unsigned bm;
            if (br == 0) bm = (unsigned)__builtin_amdgcn_readfirstlane((int)SEL[64]);
            else { const int lo = cur - 8 < 0 ? 0 : cur - 8; bm = (cur >= 31 ? 0xffffffffu : ((1u << (cur + 1)) - 1u)) & ~((1u << lo) - 1u); }
            int ja = __builtin_ctz(bm); bm &= bm - 1u; int jb = bm ? __builtin_ctz(bm) : -1; bm &= bm - 1u;
            N2_LOAD(Kp, Vp, kvrow + 64 * ja, kreg, vreg); N2_STORE(0, kreg, vreg);
            if (jb >= 0) { N2_LOAD(Kp, Vp, kvrow + 64 * jb, kreg, vreg); N2_STORE(1, kreg, vreg); }
            __syncthreads();
            int ps = 0; float m = -1e30f, l = 0.f; f32x16_t o0, o1;
#pragma unroll
            for (int r = 0; r < 16; ++r) { o0[r] = 0.f; o1[r] = 0.f; }
            asm volatile("" : "+v"(o0), "+v"(o1));
#define N2_STEP(jj, sub) do { \
                f32x16_t p0, p1; \
                n2_qk(p0, p1, lds + (sub) * N2_SLOT, qr, r32, hi); \
                const bool dead = (br == 0) && !((mysel >> (jj)) & 1u); \
                const bool diag = ((jj) == cur), tail = (br == 1) && ((jj) == cur - 8); \
                float rm = -1e30f; \
                int khi = dead ? -1000 : (diag ? tsub - 4 * hi : 1000), klo = tail ? tsub - 4 * hi : -1000;     \
                asm volatile("" : "+v"(khi), "+v"(klo)); \
                _Pragma("unroll") for (int r = 0; r < 16; ++r) { const int kc = (r & 3) + 8 * (r >> 2); \
                    if (kc > khi || kc <= klo) p0[r] = -INFINITY; \
                    if (kc + 32 > khi || kc + 32 <= klo) p1[r] = -INFINITY; \
                    rm = fmaxf(rm, fmaxf(p0[r], p1[r])); } \
                rm = xhalf_max(rm); \
                const float mn = fmaxf(m, rm), sc = __builtin_amdgcn_exp2f(m - mn); m = mn; \
                float rs = 0.f; \
                _Pragma("unroll") for (int r = 0; r < 16; ++r) { p0[r] = __builtin_amdgcn_exp2f(p0[r] - mn); p1[r] = __builtin_amdgcn_exp2f(p1[r] - mn); rs += p0[r] + p1[r]; } \
                l = l * sc + rs; \
                _Pragma("unroll") for (int r = 0; r < 16; ++r) { o0[r] *= sc; o1[r] *= sc; } \
                n2_pv(o0, o1, lds + (sub) * N2_SLOT + 8192, p0, p1, lane); } while (0)
            for (;;) {
                const int na = bm ? __builtin_ctz(bm) : -1; bm &= bm - 1u; const int nb = bm ? __builtin_ctz(bm) : -1; bm &= bm - 1u;
                if (na >= 0) N2_LOAD(Kp, Vp, kvrow + 64 * na, kreg, vreg);
                N2_STEP(ja, 2 * ps);
                if (na >= 0) N2_STORE(2 * (ps ^ 1), kreg, vreg);
                if (jb >= 0) {
                    if (nb >= 0) N2_LOAD(Kp, Vp, kvrow + 64 * nb, kreg, vreg);
                    N2_STEP(jb, 2 * ps + 1);
                    if (nb >= 0) N2_STORE(2 * (ps ^ 1) + 1, kreg, vreg); }
                __syncthreads();
                if (na < 0) break;
                ja = na; jb = nb; ps ^= 1;
            }
#undef N2_STEP
            l = xhalf_sum(l);
            const float f = (l > 0.f ? 1.0f / l : 0.f) * gate[1 + br];
#pragma unroll
            for (int r = 0; r < 16; ++r) { oa0[r] += f * o0[r]; oa1[r] += f * o1[r]; }
        }
        { unsigned char* orow = (unsigned char*)ATT + ((long)b * S + t) * 1024 + 512 + (g * 4 + hr) * 64;
#pragma unroll
          for (int gi = 0; gi < 4; ++gi) {
              *(unsigned*)(orow + 8 * gi + 4 * hi) = pk4_fp8(oa0[4 * gi] * A8_SCALE, oa0[4 * gi + 1] * A8_SCALE, oa0[4 * gi + 2] * A8_SCALE, oa0[4 * gi + 3] * A8_SCALE);
              *(unsigned*)(orow + 32 + 8 * gi + 4 * hi) = pk4_fp8(oa1[4 * gi] * A8_SCALE, oa1[4 * gi + 1] * A8_SCALE, oa1[4 * gi + 2] * A8_SCALE, oa1[4 * gi + 3] * A8_SCALE); } }
    }
#undef N2_LOAD
#undef N2_STORE
}

__device__ __forceinline__ void ph_sb2(const P& p, unsigned char* lds_) {
    LAS unsigned char* lds = (LAS unsigned char*)lds_;
    int tid = threadIdx.x; asm volatile("" : "+v"(tid));
    const int lane = tid & 63, wid = __builtin_amdgcn_readfirstlane(tid >> 6), r32 = lane & 31, hi = lane >> 5;
    const int skey = tid >> 3, sch = tid & 7;
    const unsigned soff = (unsigned)(skey * 128 + sch * 16);
    const bf16* QA = WSP(bf16, A_QA); const bf16* KA = WSP(bf16, A_KA); const bf16* VA = WSP(bf16, A_VA); bf16* ATT = WSP(bf16, A_ATT);
    LAS unsigned* FLG = (LAS unsigned*)(lds + 2 * N2_SLOT);
    constexpr int NQB = S / 256, NBH = NB * 8, NUNITS = NBH * NQB;
#define N2_LOAD(Kp, Vp, row0, kreg, vreg) do { const long rb_ = (long)(row0) * 128;     \
        kreg = *(const u32x4_t*)((const char*)(Kp) + rb_ + soff); vreg = *(const u32x4_t*)((const char*)(Vp) + rb_ + soff); } while (0)
#define N2_STORE(slot, kreg, vreg) do { *(LAS u32x4_t*)(lds + (slot) * N2_SLOT + skey * 128 + ((sch ^ (skey & 7)) * 16)) = kreg; *(LAS u32x4_t*)(lds + (slot) * N2_SLOT + 8192 + skey * 128 + sch * 16) = vreg; } while (0)
    for (int unit = blockIdx.x; unit < NUNITS; unit += p.grid) {
        const int bh = unit % NBH, qb = unit / NBH, t0 = qb * 256, tw = t0 + 32 * wid, t = tw + r32;
        const long kvrow = (long)bh * S;
        bf16x8_t qr[4];
        { const bf16* qrow = QA + (kvrow + t) * 64;
#pragma unroll
          for (int ks = 0; ks < 4; ++ks) qr[ks] = *(const bf16x8_t*)(qrow + ks * 16 + hi * 8); }
        f32x16_t o0, o1;
#pragma unroll
        for (int r = 0; r < 16; ++r) { o0[r] = 0.f; o1[r] = 0.f; }
        asm volatile("" : "+v"(o0), "+v"(o1));
        float R = 0.f;
        u32x4_t kreg, vreg;
        int j = 4 * qb + 3, slot = 0, iter = 0;
        N2_LOAD(KA, VA, kvrow + 64 * j, kreg, vreg); N2_STORE(0, kreg, vreg);
        __syncthreads();
        for (;;) {
            const int jn = j - 1;
            if (jn >= 0) N2_LOAD(KA, VA, kvrow + 64 * jn, kreg, vreg);
            if (64 * j < tw + 31 && !__all(R > 175.f)) {
                f32x16_t p0, p1, s0, s1;
                n2_qk(p0, p1, lds + slot * N2_SLOT, qr, r32, hi);
                int lim = t - 64 * j - 4 * hi;
                asm volatile("" : "+v"(lim));
#pragma unroll
                for (int r = 0; r < 16; ++r) { const int kc = (r & 3) + 8 * (r >> 2);
                    { const float z = p0[r], c = __builtin_amdgcn_logf(1.0f + __builtin_amdgcn_exp2f(-fabsf(z))); const bool ok = kc < lim; s0[r] = ok ? fmaxf(z, 0.f) + c : 0.f; p0[r] = ok ? -(fmaxf(-z, 0.f) + c) : -INFINITY; }
                    { const float z = p1[r], c = __builtin_amdgcn_logf(1.0f + __builtin_amdgcn_exp2f(-fabsf(z))); const bool ok = kc + 32 < lim; s1[r] = ok ? fmaxf(z, 0.f) + c : 0.f; p1[r] = ok ? -(fmaxf(-z, 0.f) + c) : -INFINITY; } }
                float own[8], part[8], T[8];
#pragma unroll
                for (int i = 0; i < 4; ++i) { own[i] = (s0[4 * i] + s0[4 * i + 1]) + (s0[4 * i + 2] + s0[4 * i + 3]); own[4 + i] = (s1[4 * i] + s1[4 * i + 1]) + (s1[4 * i + 2] + s1[4 * i + 3]); }
#pragma unroll
                for (int i = 0; i < 8; ++i) { auto rr = __builtin_amdgcn_permlane32_swap(__float_as_uint(own[i]), __float_as_uint(own[i]), false, false); part[i] = __uint_as_float(hi ? rr[0] : rr[1]); }
                float sp = R;
#pragma unroll
                for (int i = 7; i >= 0; --i) { T[i] = sp + (hi ? 0.f : part[i]); sp += own[i] + part[i]; }
                R = sp;
#pragma unroll
                for (int i = 0; i < 4; ++i) {
                    { const float e3 = T[i], e2 = e3 + s0[4 * i + 3], e1 = e2 + s0[4 * i + 2], e0 = e1 + s0[4 * i + 1];
                      p0[4 * i] = __builtin_amdgcn_exp2f(p0[4 * i] - e0); p0[4 * i + 1] = __builtin_amdgcn_exp2f(p0[4 * i + 1] - e1); p0[4 * i + 2] = __builtin_amdgcn_exp2f(p0[4 * i + 2] - e2); p0[4 * i + 3] = __builtin_amdgcn_exp2f(p0[4 * i + 3] - e3); }
                    { const float e3 = T[4 + i], e2 = e3 + s1[4 * i + 3], e1 = e2 + s1[4 * i + 2], e0 = e1 + s1[4 * i + 1];
                      p1[4 * i] = __builtin_amdgcn_exp2f(p1[4 * i] - e0); p1[4 * i + 1] = __builtin_amdgcn_exp2f(p1[4 * i + 1] - e1); p1[4 * i + 2] = __builtin_amdgcn_exp2f(p1[4 * i + 2] - e2); p1[4 * i + 3] = __builtin_amdgcn_exp2f(p1[4 * i + 3] - e3); } }
                n2_pv(o0, o1, lds + slot * N2_SLOT + 8192, p0, p1, lane);
            }
            if (jn >= 0) N2_STORE(slot ^ 1, kreg, vreg);
            const bool wdone = __all(R > 175.f);
            if (lane == 0) FLG[(iter & 1) * 8 + wid] = wdone ? 1u : 0u;
            __syncthreads();
            if (jn < 0) break;
            unsigned nd = 0u;
#pragma unroll
            for (int w = 0; w < 8; ++w) nd += FLG[(iter & 1) * 8 + w];
            if (__builtin_amdgcn_readfirstlane((int)nd) == 8) break;
            j = jn; slot ^= 1; ++iter;
        }
        { unsigned char* orow = (unsigned char*)ATT + ((long)(bh >> 3) * S + t) * 1024 + (bh & 7) * 64;
#pragma unroll
          for (int gi = 0; gi < 4; ++gi) {
              *(unsigned*)(orow + 8 * gi + 4 * hi) = pk4_fp8(o0[4 * gi] * A8_SCALE, o0[4 * gi + 1] * A8_SCALE, o0[4 * gi + 2] * A8_SCALE, o0[4 * gi + 3] * A8_SCALE);
              *(unsigned*)(orow + 32 + 8 * gi + 4 * hi) = pk4_fp8(o1[4 * gi] * A8_SCALE, o1[4 * gi + 1] * A8_SCALE, o1[4 * gi + 2] * A8_SCALE, o1[4 * gi + 3] * A8_SCALE); } }
    }
#undef N2_LOAD
#undef N2_STORE
}

__device__ __forceinline__ float gelu_fast(float v) { const float u = 0.7978845608028654f * (v + 0.044715f * v * v * v); return v * __builtin_amdgcn_rcpf(1.0f + __builtin_amdgcn_exp2f(-2.8853900817779268f * u)); }
__device__ __forceinline__ float xhalf_other(float v) { float a = v, b = v; asm volatile("s_nop 4\n\tv_permlane32_swap_b32 %0, %1\n\ts_nop 4" : "+v"(a), "+v"(b)); return (threadIdx.x & 32) ? a : b; }
__device__ __forceinline__ void xhalf_other8(const float (&v)[8], float (&o)[8]) {
    float a0 = v[0], a1 = v[1], a2 = v[2], a3 = v[3], a4 = v[4], a5 = v[5], a6 = v[6], a7 = v[7], b0 = a0, b1 = a1, b2 = a2, b3 = a3, b4 = a4, b5 = a5, b6 = a6, b7 = a7;
    asm volatile("s_nop 4\n\tv_permlane32_swap_b32 %0, %8\n\tv_permlane32_swap_b32 %1, %9\n\tv_permlane32_swap_b32 %2, %10\n\tv_permlane32_swap_b32 %3, %11\n\tv_permlane32_swap_b32 %4, %12\n\tv_permlane32_swap_b32 %5, %13\n\tv_permlane32_swap_b32 %6, %14\n\tv_permlane32_swap_b32 %7, %15\n\ts_nop 4"
                 : "+v"(a0), "+v"(a1), "+v"(a2), "+v"(a3), "+v"(a4), "+v"(a5), "+v"(a6), "+v"(a7), "+v"(b0), "+v"(b1), "+v"(b2), "+v"(b3), "+v"(b4), "+v"(b5), "+v"(b6), "+v"(b7));
    const bool up = (threadIdx.x & 32) != 0;
    o[0] = up ? a0 : b0; o[1] = up ? a1 : b1; o[2] = up ? a2 : b2; o[3] = up ? a3 : b3; o[4] = up ? a4 : b4; o[5] = up ? a5 : b5; o[6] = up ? a6 : b6; o[7] = up ? a7 : b7;
}
constexpr int S5B_ROW = 72, S5B_IMG = 128 * S5B_ROW, S5B_LDS_PER = S5B_IMG + 8192;
constexpr int S5B_SIDE = 4 * S5B_LDS_PER;
__device__ __forceinline__ float opq(float v) { asm("" : "+v"(v)); return v; }
__device__ __forceinline__ void ph_s5b(const P& p, unsigned char* lds_, bf16* YS) {
    int tid = threadIdx.x; asm volatile("" : "+v"(tid));
    const int lane = tid & 63, wid = __builtin_amdgcn_readfirstlane(tid >> 6), r32 = lane & 31, hi = lane >> 5;
    LAS unsigned char* HB = (LAS unsigned char*)lds_ + wid * S5B_LDS_PER;
    const bf16* U = WSP(bf16, C_U);
    const bf16* BT = WSP(bf16, O_S5BT); const bf16* CTB = WSP(bf16, O_S5CT); const float* APW = WSP(float, O_S5AP);
    const LAS unsigned char* hrd = HB + (8 * hi + ((lane & 15) >> 2)) * S5B_ROW + (((lane >> 4) & 1) * 16 + (lane & 3) * 4) * 2;
    for (int item = blockIdx.x * 4 + wid; wid < 4 && item < NB * NG; item += p.grid * 4) {
        const int g = item % NG; const long b = item / NG;
        const bf16* btp = BT + ((long)g * 128 + r32) * 16 + 8 * hi;
        const bf16* cfp = CTB + ((long)g * 32 + r32) * 128 + 8 * hi;
        LAS unsigned char* CF = HB + S5B_IMG + lane * 16;
#pragma unroll
        for (int ks = 0; ks < 8; ++ks) *(LAS bf16x8_t*)(CF + ks * 1024) = *(const bf16x8_t*)(cfp + 16 * ks);
        float ap[2][8];
#pragma unroll
        for (int s = 0; s < 2; ++s)
#pragma unroll
            for (int k = 0; k < 8; ++k) ap[s][k] = APW[((long)g * 64 + 32 * s + r32) * 8 + k];
        float hs[2][2] = {{0.f, 0.f}, {0.f, 0.f}};
        const bf16* urow = U + ((long)b * S + r32) * DM + g * 16;
        bf16x8_t uf = *(const bf16x8_t*)(urow + 8 * hi);
        bf16x8_t btf[4];
#pragma unroll
        for (int ct = 0; ct < 4; ++ct) btf[ct] = *(const bf16x8_t*)(btp + ct * 512);
        unsigned pend0 = 0u, pend1 = 0u; unsigned char* pend_row = (unsigned char*)YS;
#pragma nounroll
        for (int c = 0; c < S / 32; ++c) {
            const bf16* ucur = urow + (long)c * 32 * DM;
            const int cn = (c + 1 < S / 32) ? c + 1 : c;
            const u32x2_t uq0 = *(const u32x2_t*)(ucur + 4 * hi), uq1 = *(const u32x2_t*)(ucur + 8 + 4 * hi);
            const bf16x8_t ufn = *(const bf16x8_t*)(urow + (long)cn * 32 * DM + 8 * hi);
            if (c > 0) { *(unsigned*)(pend_row + 4 * hi) = pend0; *(unsigned*)(pend_row + 8 + 4 * hi) = pend1; }
            f32x16_t x[4], z16;
#pragma unroll
            for (int r = 0; r < 16; ++r) z16[r] = 0.f;
            asm volatile("" : "+v"(z16));
#pragma unroll
            for (int ct = 0; ct < 4; ++ct) x[ct] = __builtin_amdgcn_mfma_f32_32x32x16_bf16(uf, btf[ct], z16, 0, 0, 0);
#pragma unroll
            for (int s = 0; s < 2; ++s) {
                f32x16_t& xr = x[s]; f32x16_t& xi = x[2 + s];
                const float ar = ap[s][0], ai = ap[s][1], a4r = ap[s][6], a4i = ap[s][7];
                float er[4], ei[4], pr[4], pi[4], cgr[4], cgi[4];
#pragma unroll
                for (int gi = 0; gi < 4; ++gi) {
#pragma unroll
                    for (int k = 1; k < 4; ++k) { const float nr = opq(__builtin_fmaf(-ai, xi[4 * gi + k - 1], opq(__builtin_fmaf(ar, xr[4 * gi + k - 1], xr[4 * gi + k])))), ni = opq(__builtin_fmaf(ai, xr[4 * gi + k - 1], opq(__builtin_fmaf(ar, xi[4 * gi + k - 1], xi[4 * gi + k])))); xr[4 * gi + k] = nr; xi[4 * gi + k] = ni; }
                    er[gi] = xr[4 * gi + 3]; ei[gi] = xi[4 * gi + 3]; }
#pragma unroll
                for (int gi = 0; gi < 4; ++gi) { pr[gi] = 0.f; pi[gi] = 0.f; }
                { const float vin[8] = {er[0], er[1], er[2], er[3], ei[0], ei[1], ei[2], ei[3]}; float vout[8]; xhalf_other8(vin, vout);
#pragma unroll
                  for (int gi = 0; gi < 4; ++gi) { pr[gi] = vout[gi]; pi[gi] = vout[4 + gi]; } }
                float cr = hs[s][0], ci = hs[s][1];
#pragma unroll
                for (int gi = 0; gi < 4; ++gi) {
                    const float evr = hi ? pr[gi] : er[gi], evi = hi ? pi[gi] : ei[gi], odr = hi ? er[gi] : pr[gi], odi = hi ? ei[gi] : pi[gi];
                    const float c0r = cr, c0i = ci;
                    float nr = opq(__builtin_fmaf(-a4i, ci, opq(__builtin_fmaf(a4r, cr, evr)))), ni = opq(__builtin_fmaf(a4i, cr, opq(__builtin_fmaf(a4r, ci, evi)))); cr = nr; ci = ni;
                    cgr[gi] = hi ? cr : c0r; cgi[gi] = hi ? ci : c0i;
                    nr = opq(__builtin_fmaf(-a4i, ci, opq(__builtin_fmaf(a4r, cr, odr)))); ni = opq(__builtin_fmaf(a4i, cr, opq(__builtin_fmaf(a4r, ci, odi)))); cr = nr; ci = ni; }
                hs[s][0] = cr; hs[s][1] = ci;
#pragma unroll
                for (int gi = 0; gi < 4; ++gi)
#pragma unroll
                    for (int k = 0; k < 4; ++k) { const float pwr = ap[s][2 * k], pwi = ap[s][2 * k + 1]; xr[4 * gi + k] = opq(__builtin_fmaf(-pwi, cgi[gi], opq(__builtin_fmaf(pwr, cgr[gi], xr[4 * gi + k])))); xi[4 * gi + k] = opq(__builtin_fmaf(pwi, cgr[gi], opq(__builtin_fmaf(pwr, cgi[gi], xi[4 * gi + k])))); }
            }
#pragma unroll
            for (int ct = 0; ct < 4; ++ct)
#pragma unroll
                for (int gi = 0; gi < 4; ++gi) { u32x2_t w; w.x = cvtpk(x[ct][4 * gi], x[ct][4 * gi + 1]); w.y = cvtpk(x[ct][4 * gi + 2], x[ct][4 * gi + 3]); *(LAS u32x2_t*)(HB + (32 * ct + r32) * S5B_ROW + (8 * gi + 4 * hi) * 2) = w; }
            const float4 dka = *(const float4*)(p.in[I_DSK] + g * 16 + 4 * hi), dkb = *(const float4*)(p.in[I_DSK] + g * 16 + 8 + 4 * hi);
            asm volatile("s_waitcnt lgkmcnt(0)" ::: "memory");
            f32x16_t y;
#pragma unroll
            for (int r = 0; r < 16; ++r) y[r] = 0.f;
            asm volatile("" : "+v"(y));
#pragma unroll
            for (int ks = 0; ks < 8; ++ks) {
                const s16x4_t lo = __builtin_bit_cast(s16x4_t, __builtin_amdgcn_ds_read_tr16_b64_v4i16((LAS s16x4_t*)(hrd + (16 * ks) * S5B_ROW)));
                const s16x4_t hh = __builtin_bit_cast(s16x4_t, __builtin_amdgcn_ds_read_tr16_b64_v4i16((LAS s16x4_t*)(hrd + (16 * ks + 4) * S5B_ROW)));
                const bf16x8_t hf = (bf16x8_t){lo[0], lo[1], lo[2], lo[3], hh[0], hh[1], hh[2], hh[3]};
                const bf16x8_t cfk = *(const LAS bf16x8_t*)(CF + ks * 1024);
                y = __builtin_amdgcn_mfma_f32_32x32x16_bf16(cfk, hf, y, 0, 0, 0); }
#pragma unroll
            for (int ct = 0; ct < 4; ++ct) btf[ct] = *(const bf16x8_t*)(btp + ct * 512);
            asm volatile("s_waitcnt lgkmcnt(0)" ::: "memory");
            { unsigned char* yrow = (unsigned char*)YS + ((long)b * S + c * 32 + r32) * DM + g * 16; float dk[8];
              { dk[0] = dka.x; dk[1] = dka.y; dk[2] = dka.z; dk[3] = dka.w; dk[4] = dkb.x; dk[5] = dkb.y; dk[6] = dkb.z; dk[7] = dkb.w; }
              const float u0 = bf2f((bf16)(uq0.x & 0xffffu)), u1 = bf2f((bf16)(uq0.x >> 16)), u2 = bf2f((bf16)(uq0.y & 0xffffu)), u3 = bf2f((bf16)(uq0.y >> 16));
              const float u4 = bf2f((bf16)(uq1.x & 0xffffu)), u5 = bf2f((bf16)(uq1.x >> 16)), u6 = bf2f((bf16)(uq1.y & 0xffffu)), u7 = bf2f((bf16)(uq1.y >> 16));
              pend0 = pk4_fp8(gelu_fast(y[0] + dk[0] * u0) * A8_SCALE, gelu_fast(y[1] + dk[1] * u1) * A8_SCALE, gelu_fast(y[2] + dk[2] * u2) * A8_SCALE, gelu_fast(y[3] + dk[3] * u3) * A8_SCALE);
              pend1 = pk4_fp8(gelu_fast(y[4] + dk[4] * u4) * A8_SCALE, gelu_fast(y[5] + dk[5] * u5) * A8_SCALE, gelu_fast(y[6] + dk[6] * u6) * A8_SCALE, gelu_fast(y[7] + dk[7] * u7) * A8_SCALE); pend_row = yrow; }
            uf = ufn;
        }
        *(unsigned*)(pend_row + 4 * hi) = pend0; *(unsigned*)(pend_row + 8 + 4 * hi) = pend1;
    }
}
#endif


#ifndef HOST_EMU
__device__ __forceinline__ void ph_xpose8(const XposeJob j, unsigned char* lds_, int rank = -1, int nranks = 0) {
    LAS unsigned char* tile = (LAS unsigned char*)lds_;
    int tid = threadIdx.x; asm volatile("" : "+v"(tid));
    const int tk = j.K / 64, tn = j.Ncover / 256, per = tk * tn;
    if (rank < 0) { rank = ((int)blockIdx.x - j.first + j.grid) % j.grid; nranks = j.grid; }
    for (int item = rank; item < per * j.batch; item += nranks) {
        const int bt = item / per, it = item % per, k0 = (it / tn) * 64, n0 = (it % tn) * 256;
        const float* src = j.src + (long)bt * j.sstride + (long)k0 * j.N + n0; unsigned char* dst = (unsigned char*)j.dst + (long)bt * j.dstride + k0;
#pragma unroll
        for (int i = 0; i < 2; ++i) { const int e = tid + 512 * i, k4 = (e >> 6) * 4, n4 = (e & 63) * 4;
            float4 q0 = make_float4(0.f, 0.f, 0.f, 0.f), q1 = q0, q2 = q0, q3 = q0;
            if (n0 + n4 < j.N) { q0 = *(const float4*)(src + (long)(k4 + 0) * j.N + n4); q1 = *(const float4*)(src + (long)(k4 + 1) * j.N + n4); q2 = *(const float4*)(src + (long)(k4 + 2) * j.N + n4); q3 = *(const float4*)(src + (long)(k4 + 3) * j.N + n4); }
            *(LAS unsigned*)(tile + (n4 + 0) * 80 + k4) = pk4_fp8(q0.x * W8_SCALE, q1.x * W8_SCALE, q2.x * W8_SCALE, q3.x * W8_SCALE);
            *(LAS unsigned*)(tile + (n4 + 1) * 80 + k4) = pk4_fp8(q0.y * W8_SCALE, q1.y * W8_SCALE, q2.y * W8_SCALE, q3.y * W8_SCALE);
            *(LAS unsigned*)(tile + (n4 + 2) * 80 + k4) = pk4_fp8(q0.z * W8_SCALE, q1.z * W8_SCALE, q2.z * W8_SCALE, q3.z * W8_SCALE);
            *(LAS unsigned*)(tile + (n4 + 3) * 80 + k4) = pk4_fp8(q0.w * W8_SCALE, q1.w * W8_SCALE, q2.w * W8_SCALE, q3.w * W8_SCALE); }
        __syncthreads();
#pragma unroll
        for (int i = 0; i < 2; ++i) { const int e = tid + 512 * i, nn = e >> 2, c16 = (e & 3) * 16, n = n0 + nn; const long row = (long)(n / j.il) * j.il2 + (n % j.il) + j.add;
            *(u32x4_t*)(dst + row * j.K + c16) = *(const LAS u32x4_t*)(tile + nn * 80 + c16); }
        __syncthreads();
    }
}
__device__ __forceinline__ void xpose_wave8(const XposeJob j, LAS unsigned char* tl, int wave_rank, int n_waves, int lane) {
    const int tk = j.K / 64, tn = j.Ncover / 64, per = tk * tn;
    for (int item = wave_rank; item < per * j.batch; item += n_waves) {
        const int bt = item / per, it = item % per, k0 = (it / tn) * 64, n0 = (it % tn) * 64;
        const float* src = j.src + (long)bt * j.sstride + (long)k0 * j.N + n0; unsigned char* dst = (unsigned char*)j.dst + (long)bt * j.dstride + k0;
#pragma unroll
        for (int i = 0; i < 4; ++i) { const int e = lane + 64 * i, k4 = (e >> 4) * 4, n4 = (e & 15) * 4;
            const float4 q0 = *(const float4*)(src + (long)(k4 + 0) * j.N + n4), q1 = *(const float4*)(src + (long)(k4 + 1) * j.N + n4), q2 = *(const float4*)(src + (long)(k4 + 2) * j.N + n4), q3 = *(const float4*)(src + (long)(k4 + 3) * j.N + n4);
            *(LAS unsigned*)(tl + (n4 + 0) * 80 + k4) = pk4_fp8(q0.x * W8_SCALE, q1.x * W8_SCALE, q2.x * W8_SCALE, q3.x * W8_SCALE);
            *(LAS unsigned*)(tl + (n4 + 1) * 80 + k4) = pk4_fp8(q0.y * W8_SCALE, q1.y * W8_SCALE, q2.y * W8_SCALE, q3.y * W8_SCALE);
            *(LAS unsigned*)(tl + (n4 + 2) * 80 + k4) = pk4_fp8(q0.z * W8_SCALE, q1.z * W8_SCALE, q2.z * W8_SCALE, q3.z * W8_SCALE);
            *(LAS unsigned*)(tl + (n4 + 3) * 80 + k4) = pk4_fp8(q0.w * W8_SCALE, q1.w * W8_SCALE, q2.w * W8_SCALE, q3.w * W8_SCALE); }
        asm volatile("s_waitcnt lgkmcnt(0)" ::: "memory");
#pragma unroll
        for (int i = 0; i < 4; ++i) { const int e = lane + 64 * i, nn = e >> 2, c16 = (e & 3) * 16, n = n0 + nn; const long row = (long)(n / j.il) * j.il2 + (n % j.il) + j.add;
            *(u32x4_t*)(dst + row * j.K + c16) = *(const LAS u32x4_t*)(tl + nn * 80 + c16); }
        asm volatile("s_waitcnt lgkmcnt(0)" ::: "memory");
    }
}
__device__ __forceinline__ void xpose_wave(const XposeJob j, LAS unsigned char* tl, int wave_rank, int n_waves, int lane) {
    const int tk = j.K / 64, tn = j.Ncover / 64, per = tk * tn;
    for (int item = wave_rank; item < per * j.batch; item += n_waves) {
        const int bt = item / per, it = item % per, k0 = (it / tn) * 64, n0 = (it % tn) * 64;
        const float* src = j.src + (long)bt * j.sstride + (long)k0 * j.N + n0; bf16* dst = j.dst + (long)bt * j.dstride + k0;
#pragma unroll
        for (int i = 0; i < 4; ++i) { const int e = lane + 64 * i, k4 = (e >> 4) * 4, n4 = (e & 15) * 4;
            const float4 q0 = *(const float4*)(src + (long)(k4 + 0) * j.N + n4), q1 = *(const float4*)(src + (long)(k4 + 1) * j.N + n4), q2 = *(const float4*)(src + (long)(k4 + 2) * j.N + n4), q3 = *(const float4*)(src + (long)(k4 + 3) * j.N + n4);
            u32x2_t w;
            w.x = (unsigned)f2bf(q0.x) | ((unsigned)f2bf(q1.x) << 16); w.y = (unsigned)f2bf(q2.x) | ((unsigned)f2bf(q3.x) << 16); *(LAS u32x2_t*)(tl + ((n4 + 0) * 72 + k4) * 2) = w;
            w.x = (unsigned)f2bf(q0.y) | ((unsigned)f2bf(q1.y) << 16); w.y = (unsigned)f2bf(q2.y) | ((unsigned)f2bf(q3.y) << 16); *(LAS u32x2_t*)(tl + ((n4 + 1) * 72 + k4) * 2) = w;
            w.x = (unsigned)f2bf(q0.z) | ((unsigned)f2bf(q1.z) << 16); w.y = (unsigned)f2bf(q2.z) | ((unsigned)f2bf(q3.z) << 16); *(LAS u32x2_t*)(tl + ((n4 + 2) * 72 + k4) * 2) = w;
            w.x = (unsigned)f2bf(q0.w) | ((unsigned)f2bf(q1.w) << 16); w.y = (unsigned)f2bf(q2.w) | ((unsigned)f2bf(q3.w) << 16); *(LAS u32x2_t*)(tl + ((n4 + 3) * 72 + k4) * 2) = w; }
        asm volatile("s_waitcnt lgkmcnt(0)" ::: "memory");
#pragma unroll 4
        for (int i = 0; i < 8; ++i) { const int e = lane + 64 * i, nn = e >> 3, c8 = (e & 7) * 8, n = n0 + nn; const long row = (long)(n / j.il) * j.il2 + (n % j.il) + j.add;
            *(u32x4_t*)(dst + row * j.K + c8) = *(const LAS u32x4_t*)(tl + (nn * 72 + c8) * 2); }
        asm volatile("s_waitcnt lgkmcnt(0)" ::: "memory");
    }
}
template <int L> __device__ __forceinline__ void ph_xpose_side(const P& p, unsigned char* lds_) {
    int tid = threadIdx.x; asm volatile("" : "+v"(tid));
    const int lane = tid & 63, wid = __builtin_amdgcn_readfirstlane(tid >> 6);
    if (wid < 4) return;
    LAS unsigned char* tl = (LAS unsigned char*)lds_ + S5B_SIDE + (wid - 4) * 9216;
    const int wr_ = (int)blockIdx.x * 4 + (wid - 4), nw = p.grid * 4; constexpr int mi = MOE_IN0[L];
    xpose_wave8(mk_xpose(p.in[mi + 2], WSP(bf16, O_WT_GU), DM, 256, 256, GU_IL, 2 * GU_IL, 0, 64, (long)DM * 256, (long)512 * DM), tl, wr_, nw, lane);
    xpose_wave8(mk_xpose(p.in[mi + 3], WSP(bf16, O_WT_GU), DM, 256, 256, GU_IL, 2 * GU_IL, GU_IL, 64, (long)DM * 256, (long)512 * DM), tl, wr_, nw, lane);
    xpose_wave8(mk_xpose(p.in[mi + 4], WSP(bf16, O_WT_D), 256, DM, DM, DM, 0, 0, 64, (long)256 * DM, (long)DM * 256), tl, wr_, nw, lane);
}
static_assert(S5B_SIDE + 4 * 9216 <= GEMM_LDS, "s5 side lds");
#endif
constexpr int ROUTE_LDS = 256 * 72 * 4 + 128 * 4 + 256 * 6 * 4;
constexpr int MEGA_LDS_PH = GEMM_LDS;
static_assert(MEGA_LDS_PH >= 2 * NSA_LDS_PER && MEGA_LDS_PH >= 8 * S5_LDS_PER && MEGA_LDS_PH >= 2 * LN_LDS_PER && MEGA_LDS_PH >= ROUTE_LDS && MEGA_LDS_PH >= 256 * 72 * 2, "LDS map");
constexpr int MEGA_LDS = MEGA_LDS_PH + 256 + GEMM_TE_LDS;

#ifndef HOST_EMU
__device__ __forceinline__ void ph_te_load(const int* te, unsigned char* lds_) {
    int t2 = threadIdx.x; asm volatile("" : "+v"(t2));
    for (int i = t2; i < MOE_TILES; i += NTHR) *(LAS int*)((LAS unsigned char*)lds_ + GEMM_LDS + 4 * i) = te[i];
    __syncthreads();
}
#endif
template <int L, int CH> __device__ __forceinline__ void moe_chunk(PROGRAM_ARGS) {
    bf16* const PREB = (L == 0) ? (bf16*)p.out : WSP(bf16, O_H2);
    const int mi = MOE_IN0[L]; const bf16* hin = WSP(bf16, O_H);
    PHASE_BEGIN ph_place(p, L, CH, lds); PHASE_END
#ifndef HOST_EMU
    PHASE_BEGIN { GemmArgs g = mk_gemm(WSP(bf16, B_H8), DM / 2, WSP(bf16, O_WT_GU), MOE_ROWS, 512, DM / 2); g.rowidx = WSP(int, B_ROWTOK); g.tile_e = WSP(int, O_TILEE); g.m_rt = WSP(int, O_PADSTART) + 64; g.b_estride = (long)512 * DM / 2; EpiSwiglu8 e{WSP(unsigned char, B_AEX)}; ph_te_load(WSP(int, O_TILEE), lds); ph_gemm<EpiSwiglu8, true, true>(g, e, lds); } PHASE_END
    PHASE_BEGIN { GemmArgs g = mk_gemm(WSP(bf16, B_AEX), 128, WSP(bf16, O_WT_D), MOE_ROWS, DM, 128); g.tile_e = WSP(int, O_TILEE); g.m_rt = WSP(int, O_PADSTART) + 64; g.b_estride = (long)DM * 128; EpiY8 e{WSP(unsigned char, B_Y), DM, F8_ACC_INV}; ph_gemm<EpiY8, true, true>(g, e, lds); } PHASE_END
#else
    PHASE_BEGIN { GemmArgs g = mk_gemm(hin, DM, WSP(bf16, O_WT_GU), MOE_ROWS, 512, DM); g.rowidx = WSP(int, B_ROWTOK); g.tile_e = WSP(int, O_TILEE); g.m_rt = WSP(int, O_PADSTART) + 64; g.b_estride = (long)512 * DM; EpiSwiglu e{WSP(bf16, B_AEX)}; ph_gemm(g, e, lds); } PHASE_END
    PHASE_BEGIN { GemmArgs g = mk_gemm(WSP(bf16, B_AEX), 256, WSP(bf16, O_WT_D), MOE_ROWS, DM, 256); g.tile_e = WSP(int, O_TILEE); g.m_rt = WSP(int, O_PADSTART) + 64; g.b_estride = (long)DM * 256; EpiY e{WSP(unsigned char, B_Y), WSP(float, B_ROWGATE), DM}; ph_gemm(g, e, lds); } PHASE_END
#endif
    PHASE_BEGIN
        { LnJob j; j.grid = p.grid; j.pad = 0; j.pre = p.out; j.preb = PREB; j.y = WSP(unsigned char, B_Y); j.pos = WSP(int, B_POS); j.g = p.in[mi + 8];
#ifndef HOST_EMU
          j.gate = WSP(float, B_GATE);
#else
          j.gate = nullptr;
#endif
          j.b = p.in[mi + 9]; j.t_beg = (long)CH * TC; j.t_cnt = TC;
          j.obf = (L == 0) ? WSP(bf16, O_H2) : nullptr; j.of32 = (L == 0) ? nullptr : p.out; j.of8 = (L == 0) ? WSP(unsigned char, B_H28) : nullptr; ph_ln(j, lds); }
        if (CH + 1 < NCH) ph_route(p, L, CH + 1, lds);
    PHASE_END
}
template <int L> __device__ __forceinline__ void moe_layer(PROGRAM_ARGS) {
    bf16* const PREB = (L == 0) ? (bf16*)p.out : WSP(bf16, O_H2);
    const int mi = MOE_IN0[L]; const bf16* hin = WSP(bf16, O_H);
    PHASE_BEGIN
        { GemmArgs g = mk_gemm(hin, DM, WSP(bf16, O_WT_R) + (size_t)L * 256 * DM, T, 256, DM); EpiLogit e{WSP(float, B_LOGIT)}; ph_gemm(g, e, lds); }
#ifndef HOST_EMU
        { GemmArgs g = mk_gemm(WSP(bf16, B_H8), DM / 2, (const bf16*)(WSP(unsigned char, O_WT_SGU) + (size_t)L * 512 * DM), T, 512, DM / 2); EpiSwiglu8 e{WSP(unsigned char, B_ASH)}; ph_gemm<EpiSwiglu8, true>(g, e, lds); }
#else
        { GemmArgs g = mk_gemm(hin, DM, WSP(bf16, O_WT_SGU) + (size_t)L * 512 * DM, T, 512, DM); EpiSwiglu e{WSP(bf16, B_ASH)}; ph_gemm(g, e, lds); }
#endif
    PHASE_END
    PHASE_BEGIN
#ifndef HOST_EMU
        { GemmArgs g = mk_gemm(WSP(bf16, B_ASH), 128, (const bf16*)(WSP(unsigned char, O_WT_SD) + (size_t)L * DM * 256), T, DM, 128); EpiResBfT<true> e{p.out, PREB, hin, DM}; e.sc = F8_ACC_INV; ph_gemm<EpiResBfT<true>, true>(g, e, lds); }
#else
        { GemmArgs g = mk_gemm(WSP(bf16, B_ASH), 256, WSP(bf16, O_WT_SD) + (size_t)L * DM * 256, T, DM, 256); EpiResBfT<true> e{p.out, PREB, hin, DM}; ph_gemm(g, e, lds); }
#endif
        ph_route(p, L, 0, lds);
    PHASE_END
    (void)mi;
    moe_chunk<L, 0>(p, lds, gbar);
    if constexpr (NCH == 2) moe_chunk<L, 1>(p, lds, gbar);
}
template <int L> __device__ __forceinline__ void xpose_experts(const P& p, unsigned char* lds, int rank = -1, int nranks = 0) {
    constexpr int mi = MOE_IN0[L];
#ifndef HOST_EMU
#define XPOSE_EXP(j_) ph_xpose8(j_, lds, rank, nranks)
#else
#define XPOSE_EXP(j_) ph_xpose(j_, lds)
    (void)rank; (void)nranks;
#endif
    XPOSE_EXP(mk_xpose(p.in[mi + 2], WSP(bf16, O_WT_GU), DM, 256, 256, GU_IL, 2 * GU_IL, 0, 64, (long)DM * 256, (long)512 * DM));
    XPOSE_EXP(mk_xpose(p.in[mi + 3], WSP(bf16, O_WT_GU), DM, 256, 256, GU_IL, 2 * GU_IL, GU_IL, 64, (long)DM * 256, (long)512 * DM));
    XPOSE_EXP(mk_xpose(p.in[mi + 4], WSP(bf16, O_WT_D), 256, DM, DM, DM, 0, 0, 64, (long)256 * DM, (long)DM * 256));
#undef XPOSE_EXP
}
__device__ __forceinline__ void program(PROGRAM_ARGS) {
    bf16* const PREB = (bf16*)p.out;
    PHASE_BEGIN
        int xo = 0;
#define XP(fn_, job_) do { XposeJob j_ = job_; j_.first = xo % p.grid; xo += (j_.K / 64) * ((j_.Ncover + 255) / 256) * j_.batch; fn_(j_, lds); } while (0)
#ifndef HOST_EMU
        XP(ph_xpose8, mk_xpose(p.in[I_L0_WIN], WSP(bf16, O_WT_IN0), DM, PROJ_N, PROJ_NP, PROJ_NP, 0, 0, 1, 0, 0));
        { int t8 = threadIdx.x; asm volatile("" : "+v"(t8));
          for (long i = ((long)blockIdx.x * NTHR + t8) * 8; i < (long)T * DM; i += (long)p.grid * NTHR * 8) { const f8 a = ld_f8(p.in[I_X] + i);
              uint2 w; w.x = pk4_fp8(a.v[0] * A8_SCALE, a.v[1] * A8_SCALE, a.v[2] * A8_SCALE, a.v[3] * A8_SCALE); w.y = pk4_fp8(a.v[4] * A8_SCALE, a.v[5] * A8_SCALE, a.v[6] * A8_SCALE, a.v[7] * A8_SCALE); *(uint2*)(WSP(unsigned char, O_H) + i) = w; } }
#else
        XP(ph_xpose, mk_xpose(p.in[I_L0_WIN], WSP(bf16, O_WT_IN0), DM, PROJ_N, PROJ_NP, PROJ_NP, 0, 0, 1, 0, 0));
        ph_cvt(p, p.in[I_X], WSP(bf16, O_H), (long)T * DM);
#endif
        XP(ph_xpose, mk_xpose(p.in[I_KW1], WSP(bf16, O_WT_K1), 2048, 256, 256, 256, 0, 0, 1, 0, 0));
        XP(ph_xpose, mk_xpose(p.in[I_VW1], WSP(bf16, O_WT_V1), 2048, 256, 256, 256, 0, 0, 1, 0, 0));
#ifndef HOST_EMU
        XP(ph_xpose8, mk_xpose(p.in[I_L0_WOUT], WSP(bf16, O_WT_OUT0), 1024, DM, DM, DM, 0, 0, 1, 0, 0));
#else
        XP(ph_xpose, mk_xpose(p.in[I_L0_WOUT], WSP(bf16, O_WT_OUT0), 1024, DM, DM, DM, 0, 0, 1, 0, 0));
#endif
        XP(ph_xpose, mk_xpose(p.in[I_KW2], WSP(bf16, O_WT_K2), 256, 64, 256, 256, 0, 0, 1, 0, 0));
        XP(ph_xpose, mk_xpose(p.in[I_VW2], WSP(bf16, O_WT_K2) + 256 * 256, 256, 64, 256, 256, 0, 0, 1, 0, 0));
#pragma unroll
        for (int l = 0; l < 2; ++l) { const int mi = (l == 0) ? I_L0_ROUTER : I_L1_ROUTER;
            XP(ph_xpose, mk_xpose(p.in[mi], WSP(bf16, O_WT_R) + (size_t)l * 256 * DM, DM, 64, 256, 256, 0, 0, 1, 0, 0));
#ifndef HOST_EMU
            XP(ph_xpose8, mk_xpose(p.in[mi + 5], (bf16*)(WSP(unsigned char, O_WT_SGU) + (size_t)l * 512 * DM), DM, 256, 256, GU_IL, 2 * GU_IL, 0, 1, 0, 0));
            XP(ph_xpose8, mk_xpose(p.in[mi + 6], (bf16*)(WSP(unsigned char, O_WT_SGU) + (size_t)l * 512 * DM), DM, 256, 256, GU_IL, 2 * GU_IL, GU_IL, 1, 0, 0));
            XP(ph_xpose8, mk_xpose(p.in[mi + 7], (bf16*)(WSP(unsigned char, O_WT_SD) + (size_t)l * DM * 256), 256, DM, DM, DM, 0, 0, 1, 0, 0)); }
#else
            XP(ph_xpose, mk_xpose(p.in[mi + 5], WSP(bf16, O_WT_SGU) + (size_t)l * 512 * DM, DM, 256, 256, GU_IL, 2 * GU_IL, 0, 1, 0, 0));
            XP(ph_xpose, mk_xpose(p.in[mi + 6], WSP(bf16, O_WT_SGU) + (size_t)l * 512 * DM, DM, 256, 256, GU_IL, 2 * GU_IL, GU_IL, 1, 0, 0));
            XP(ph_xpose, mk_xpose(p.in[mi + 7], WSP(bf16, O_WT_SD) + (size_t)l * DM * 256, 256, DM, DM, DM, 0, 0, 1, 0, 0)); }
#endif
#ifndef HOST_EMU
        XP(ph_xpose8, mk_xpose(p.in[I_L1_WIN], WSP(bf16, O_WT_IN1), DM, DM, DM, DM, 0, 0, 1, 0, 0));
#else
        XP(ph_xpose, mk_xpose(p.in[I_L1_WIN], WSP(bf16, O_WT_IN1), DM, DM, DM, DM, 0, 0, 1, 0, 0));
#endif
#ifndef HOST_EMU
        XP(ph_xpose8, mk_xpose(p.in[I_WGLU], WSP(bf16, O_WT_GLU), DM, DM, DM, DM, 0, 0, 1, 0, 0));
#else
        XP(ph_xpose, mk_xpose(p.in[I_WGLU], WSP(bf16, O_WT_GLU), DM, DM, DM, DM, 0, 0, 1, 0, 0));
#endif
#ifndef HOST_EMU
        XP(ph_xpose8, mk_xpose(p.in[I_L1_WOUT], WSP(bf16, O_WT_OUT1), DM, DM, DM, DM, 0, 0, 1, 0, 0));
#else
        XP(ph_xpose, mk_xpose(p.in[I_L1_WOUT], WSP(bf16, O_WT_OUT1), DM, DM, DM, DM, 0, 0, 1, 0, 0));
#endif
#undef XP
        ph_tables(p);
#ifdef HOST_EMU
        xpose_experts<0>(p, lds);
#endif
    PHASE_END
#ifndef HOST_EMU
    PHASE_BEGIN ph_bias_finish(p); { GemmArgs g = mk_gemm(WSP(bf16, O_H), DM / 2, WSP(bf16, O_WT_IN0), T, PROJ_NP, DM / 2); EpiProj0R e{p.ws, F8_ACC_INV}; ph_gemm<EpiProj0R, true>(g, e, lds); } PHASE_END
#else
    PHASE_BEGIN { GemmArgs g = mk_gemm(WSP(bf16, O_H), DM, WSP(bf16, O_WT_IN0), T, PROJ_NP, DM); EpiProj0 e{p.ws}; ph_gemm(g, e, lds); } PHASE_END
    PHASE_BEGIN ph_rope(p); ph_bias_finish(p); PHASE_END
#endif
    PHASE_BEGIN
        static_assert(A_VC == A_KC + (size_t)NB * 2 * NCP * 1024 * 2 && O_WT_V1 == O_WT_K1 + (size_t)256 * 2048 * 2 && O_BIASV == O_BIASK + 1024 && (NB * 2 * NCP) % 256 == 0, "batched cmp GEMM: k then v, contiguous");
        { GemmArgs g = mk_gemm(WSP(bf16, A_KC), 1024, WSP(bf16, O_WT_K1), 2 * NB * 2 * NCP, 256, 2048); g.tile_e = WSP(int, O_CMPTE); g.b_estride = (long)256 * 2048; EpiCmp1 e{WSP(bf16, A_HCK), WSP(float, O_BIASK)}; ph_gemm(g, e, lds); }
        { GemmArgs g = mk_gemm(WSP(bf16, A_HCK), 256, WSP(bf16, O_WT_K2), 2 * NB * 2 * NCP, 256, 256); g.tile_e = WSP(int, O_CMPTE); g.b_estride = (long)256 * 256; EpiCmp2 e{WSP(bf16, A_KCMP), WSP(bf16, A_VCMP)}; ph_gemm(g, e, lds); }
#ifndef HOST_EMU
        { constexpr int NCW = 2 * NB * 2 * NCP / 256; if (p.grid > NCW) { if ((int)blockIdx.x >= NCW) xpose_experts<0>(p, lds, (int)blockIdx.x - NCW, p.grid - NCW); } else xpose_experts<0>(p, lds); }
#endif
    PHASE_END
#ifdef HOST_EMU
    PHASE_BEGIN ph_nsa(p, lds); ph_sb(p); PHASE_END
#else
    PHASE_BEGIN ph_nsa2(p, lds); ph_sb2(p, lds); PHASE_END
#endif
#ifndef HOST_EMU
    PHASE_BEGIN { GemmArgs g = mk_gemm(WSP(bf16, A_ATT), 512, WSP(bf16, O_WT_OUT0), T, DM, 512); EpiResF32 e{PREB, p.in[I_X], DM}; e.sc = F8_ACC_INV; ph_gemm<EpiResF32, true>(g, e, lds); } PHASE_END
#else
    PHASE_BEGIN { GemmArgs g = mk_gemm(WSP(bf16, A_ATT), 1024, WSP(bf16, O_WT_OUT0), T, DM, 1024); EpiResF32 e{PREB, p.in[I_X], DM}; ph_gemm(g, e, lds); } PHASE_END
#endif
    PHASE_BEGIN { LnJob j; j.grid = p.grid; j.pad = 0; j.pre = p.out; j.preb = PREB; j.y = nullptr; j.pos = nullptr; j.gate = nullptr; j.g = p.in[I_L0_LN1G]; j.b = p.in[I_L0_LN1B]; j.obf = WSP(bf16, O_H); j.of32 = nullptr; j.of8 = WSP(unsigned char, B_H8); j.t_beg = 0; j.t_cnt = T; ph_ln(j, lds); } PHASE_END
    moe_layer<0>(p, lds, gbar);
    PHASE_BEGIN
#ifndef HOST_EMU
        { GemmArgs g = mk_gemm(WSP(bf16, B_H28), DM / 2, WSP(bf16, O_WT_IN1), T, DM, DM / 2); EpiBf e{WSP(bf16, C_U), DM}; e.sc = F8_ACC_INV; ph_gemm<EpiBf, true>(g, e, lds); }
#else
        { GemmArgs g = mk_gemm(WSP(bf16, O_H2), DM, WSP(bf16, O_WT_IN1), T, DM, DM); EpiBf e{WSP(bf16, C_U), DM}; ph_gemm(g, e, lds); }
#endif
#ifdef HOST_EMU
        xpose_experts<1>(p, lds);
#endif
    PHASE_END
#ifdef HOST_EMU
    PHASE_BEGIN ph_s5(p, lds); PHASE_END
#else
    PHASE_BEGIN ph_s5b(p, lds, WSP(bf16, C_YS)); ph_xpose_side<1>(p, lds); PHASE_END
#endif
#ifndef HOST_EMU
    PHASE_BEGIN { GemmArgs g = mk_gemm(WSP(bf16, C_YS), DM / 2, WSP(bf16, O_WT_GLU), T, DM, DM / 2); EpiGlu8 e{WSP(unsigned char, C_Y2), WSP(unsigned char, C_YS), DM}; ph_gemm<EpiGlu8, true>(g, e, lds); } PHASE_END
    PHASE_BEGIN { GemmArgs g = mk_gemm(WSP(bf16, C_Y2), DM / 2, WSP(bf16, O_WT_OUT1), T, DM, DM / 2); EpiResBfT<true> e{p.out, PREB, WSP(bf16, O_H2), DM}; e.sc = F8_ACC_INV; ph_gemm<EpiResBfT<true>, true>(g, e, lds); } PHASE_END
#else
    PHASE_BEGIN { GemmArgs g = mk_gemm(WSP(bf16, C_YS), DM, WSP(bf16, O_WT_GLU), T, DM, DM); EpiGlu e{WSP(bf16, C_Y2), WSP(bf16, C_YS), DM}; ph_gemm(g, e, lds); } PHASE_END
    PHASE_BEGIN { GemmArgs g = mk_gemm(WSP(bf16, C_Y2), DM, WSP(bf16, O_WT_OUT1), T, DM, DM); EpiResBfT<true> e{p.out, PREB, WSP(bf16, O_H2), DM}; ph_gemm(g, e, lds); } PHASE_END
#endif
    PHASE_BEGIN { LnJob j; j.grid = p.grid; j.pad = 0; j.pre = p.out; j.preb = PREB; j.y = nullptr; j.pos = nullptr; j.gate = nullptr; j.g = p.in[I_L1_LN1G]; j.b = p.in[I_L1_LN1B]; j.obf = WSP(bf16, O_H); j.of32 = nullptr; j.of8 = WSP(unsigned char, B_H8); j.t_beg = 0; j.t_cnt = T; ph_ln(j, lds); } PHASE_END
    moe_layer<1>(p, lds, gbar);
}

#ifndef HOST_EMU
__global__ void __launch_bounds__(512, 2) mega(const P p) {
    LDS_DECL;
    if (threadIdx.x == 0) *(uint4*)lds = make_uint4(0u, 0u, 0u, 0u);
    __syncthreads();
    const XcdBarrier gbar = xcd_barrier_post((unsigned*)(p.ws + O_CTL), (volatile LAS unsigned*)lds, (unsigned)p.grid);
    program(p, lds + 256, gbar);
}
#else
static int hipMemsetAsync(void* p, int v, size_t n, hipStream_t) { memset(p, v, n); return 0; }
#endif

extern "C" void kernel_launch(void* const* d_in, const int* in_sizes, int n_in, void* d_out, int out_size, void* d_ws, size_t ws_size, hipStream_t stream) {
    (void)in_sizes; (void)out_size;
    if (n_in < 44 || ws_size < WS_NEED) return;
    P p; memset(&p, 0, sizeof(p));
    for (int i = 0; i < 44; ++i) p.in[i] = (const float*)d_in[i];
    p.out = (float*)d_out; p.ws = (unsigned char*)d_ws;
    (void)hipMemsetAsync(p.ws + O_CTL, 0, CTL_BYTES, stream);
#ifndef HOST_EMU
    static int grid = 0;
    if (!grid) {
        int dev = 0, cus = 0, per_cu = 0;
        (void)hipGetDevice(&dev);
        (void)hipDeviceGetAttribute(&cus, hipDeviceAttributeMultiprocessorCount, dev);
        (void)hipFuncSetAttribute((const void*)mega, hipFuncAttributeMaxDynamicSharedMemorySize, MEGA_LDS);
        (void)hipOccupancyMaxActiveBlocksPerMultiprocessor(&per_cu, mega, 512, MEGA_LDS);
        grid = cus * (per_cu < 1 ? per_cu : 1);
    }
    p.grid = grid;
    if (grid > 0) mega<<<grid, 512, MEGA_LDS, stream>>>(p);
#else
    e_gridDim.x = EMU_GRID; e_blockDim.x = 512; p.grid = EMU_GRID;
    program(p, g_emu_lds, 0);
#endif
}
```

```cpp
#ifndef HOST_EMU
#include <hip/hip_runtime.h>
#endif
#include <stdint.h>
#include <stddef.h>
#include <math.h>
#include <string.h>

#ifndef CFG_B
#define CFG_B 32
#define CFG_S 2048
#define CFG_D 1024
#endif

#ifdef HOST_EMU
#include <stdio.h>
#include <stdlib.h>
#define __global__
#define __device__
#define __host__
#define __forceinline__ inline
struct EmuDim { int x; };
static EmuDim e_blockIdx, e_gridDim, e_blockDim;
#define BIDX (e_blockIdx.x)
#define GDIM_OF(a_) (e_gridDim.x)
#define NTHR (e_blockDim.x)
#define PAR_BEGIN for (int tid = 0; tid < NTHR; ++tid) {
#define PAR_END }
template <class T> static inline T emu_atomic_add(T* p, T v) { T o = *p; *p = o + v; return o; }
#define ATOMIC_ADD(p, v) emu_atomic_add((p), (v))
typedef int hipStream_t;
static unsigned char g_emu_lds[163840];
#define LDS_DECL unsigned char* lds = g_emu_lds
#else
#define BIDX ((int)blockIdx.x)
#define GDIM_OF(a_) ((a_).grid)
#define NTHR 512
#define PAR_BEGIN { int tid = (int)threadIdx.x; asm volatile("" : "+v"(tid));
#define PAR_END } __syncthreads();
#define ATOMIC_ADD(p, v) atomicAdd((p), (v))
#define LDS_DECL extern __shared__ __attribute__((aligned(16))) unsigned char lds[]
#endif

typedef unsigned short bf16;

constexpr int NB = CFG_B, S = CFG_S, DM = CFG_D, T = NB * S;
constexpr int NCH = 1, TC = T / NCH;
constexpr int MOE_ROWS = ((TC * 6 + 64 * 255 + 255) / 256) * 256, MOE_TILES = MOE_ROWS / 256;
constexpr int NG = DM / 16;
constexpr int NCP = S / 16, NCMP = NCP - 1, NSLC = S / 64;
constexpr int PROJ_N = 2840, PROJ_NP = 3072;
constexpr int GU_IL = 128;
constexpr float DN_ALPHA = 1.4142135623730951f;
constexpr float LN_EPS = 1e-5f;
constexpr float QSCALE = 0.125f * 1.4426950408889634f;

constexpr size_t al256(size_t x) { return (x + 255) & ~(size_t)255; }
constexpr size_t O_CTL = 0, CTL_BYTES = 65536;
constexpr size_t O_CNT = O_CTL + 16384;
constexpr size_t O_PADSTART = O_CTL + CTL_BYTES;
constexpr size_t O_TILEE = O_PADSTART + 512;
constexpr size_t O_CMPTE = al256(O_TILEE + (size_t)MOE_TILES * 4);
constexpr size_t O_BIASK = al256(O_CMPTE + 1024);
constexpr size_t O_BIASV = O_BIASK + 1024;
constexpr size_t O_BIASP = O_BIASV + 1024;
constexpr size_t O_WT_K2 = O_BIASP + (size_t)64 * 512 * 4;
constexpr size_t O_ROPE = O_WT_K2 + (size_t)2 * 256 * 256 * 2;
constexpr size_t O_ABAR = O_ROPE + (size_t)S * 16 * 4;
constexpr size_t O_BBAR = al256(O_ABAR + (size_t)NG * 64 * 2 * 4);
constexpr size_t O_S5BT = al256(O_BBAR + (size_t)NG * 64 * 16 * 2 * 4);
constexpr size_t O_S5AP = al256(O_S5BT + (size_t)NG * 128 * 16 * 2);
constexpr size_t O_S5CT = al256(O_S5AP + (size_t)NG * 64 * 8 * 4);
constexpr size_t O_WT_IN0 = al256(O_S5CT + (size_t)NG * 32 * 128 * 2);
constexpr size_t O_WT_K1 = al256(O_WT_IN0 + (size_t)PROJ_NP * DM * 2);
constexpr size_t O_WT_V1 = O_WT_K1 + (size_t)256 * 2048 * 2;
constexpr size_t O_WT_OUT0 = O_WT_V1 + (size_t)256 * 2048 * 2;
constexpr size_t O_WT_R = al256(O_WT_OUT0 + (size_t)DM * 1024 * 2);
constexpr size_t O_WT_SGU = al256(O_WT_R + (size_t)2 * 256 * DM * 2);
constexpr size_t O_WT_SD = al256(O_WT_SGU + (size_t)2 * 512 * DM * 2);
constexpr size_t O_WT_GU = al256(O_WT_SD + (size_t)2 * DM * 256 * 2);
constexpr size_t O_WT_D = al256(O_WT_GU + (size_t)64 * 512 * DM * 2);
constexpr size_t O_WT_IN1 = al256(O_WT_D + (size_t)64 * DM * 256 * 2);
constexpr size_t O_WT_GLU = O_WT_IN1 + (size_t)DM * DM * 2;
constexpr size_t O_WT_OUT1 = O_WT_GLU + (size_t)DM * DM * 2;
constexpr size_t O_H = al256(O_WT_OUT1 + (size_t)DM * DM * 2);
constexpr size_t O_H2 = al256(O_H + (size_t)T * DM * 2);
constexpr size_t O_SCR = al256(O_H2 + (size_t)T * DM * 2);
constexpr size_t HB = (size_t)NB * 8 * S * 64 * 2, GB = (size_t)NB * 2 * S * 64 * 2;
constexpr size_t A_QA = O_SCR, A_KA = A_QA + HB, A_VA = A_KA + HB, A_QB = A_VA + HB;
constexpr size_t A_KC = A_QB + HB, A_VC = A_KC + GB, A_KS = A_VC + GB, A_VS = A_KS + GB, A_KW = A_VS + GB, A_VW = A_KW + GB;
constexpr size_t A_GRAW = A_VW + GB;
constexpr size_t A_HCK = al256(A_GRAW + (size_t)T * 24 * 4);
constexpr size_t A_HCV = A_HCK + (size_t)NB * 2 * NCP * 256 * 2;
constexpr size_t A_KCMP = A_HCV + (size_t)NB * 2 * NCP * 256 * 2;
constexpr size_t A_VCMP = A_KCMP + (size_t)NB * 2 * NCP * 64 * 4;
constexpr size_t A_ATT = al256(A_VCMP + (size_t)NB * 2 * NCP * 64 * 4);
constexpr size_t A_END = A_ATT + (size_t)T * 1024 * 2;
constexpr size_t B_EIDX = O_SCR;
constexpr size_t B_GATE = al256(B_EIDX + (size_t)T * 6 * 4);
constexpr size_t B_POS = al256(B_GATE + (size_t)T * 6 * 4);
constexpr size_t B_ROWTOK = al256(B_POS + (size_t)T * 6 * 4);
constexpr size_t B_ROWGATE = al256(B_ROWTOK + (size_t)MOE_ROWS * 4);
constexpr size_t B_AEX = al256(B_ROWGATE + (size_t)MOE_ROWS * 4);
constexpr size_t B_H8 = al256(B_AEX + (size_t)MOE_ROWS * 256);
static_assert(B_H8 + (size_t)T * DM <= B_AEX + (size_t)MOE_ROWS * 256 * 2, "h8 fits behind the fp8 AEX");
constexpr size_t B_ASH = B_AEX;
constexpr size_t B_Y = al256(B_AEX + (size_t)MOE_ROWS * 256 * 2);
constexpr size_t B_LOGIT = B_Y;
constexpr size_t B_END = B_Y + (size_t)MOE_ROWS * DM;
static_assert((size_t)T * 256 * 2 <= (size_t)MOE_ROWS * 256 * 2 && (size_t)T * 64 * 4 <= (size_t)MOE_ROWS * DM, "MoE overlays");
constexpr size_t B_H28 = B_AEX;
constexpr size_t C_U = O_SCR + ((size_t)128 << 20), C_YS = C_U + (size_t)T * DM * 2, C_Y2 = C_YS + (size_t)T * DM * 2, C_END = C_Y2 + (size_t)T * DM * 2;
static_assert(B_H28 + (size_t)T * DM <= B_H8 && B_H28 + (size_t)T * DM <= O_SCR + ((size_t)128 << 20), "h2 fp8 copy: inside the AEX half, below stage C");
constexpr size_t WS_NEED = (A_END > B_END ? (A_END > C_END ? A_END : C_END) : (B_END > C_END ? B_END : C_END)) + 4096;

__host__ __device__ __forceinline__ float bf2f(bf16 v) { unsigned u = ((unsigned)v) << 16; float f; memcpy(&f, &u, 4); return f; }
__host__ __device__ __forceinline__ bf16 f2bf(float f) { unsigned u; memcpy(&u, &f, 4); u = (u + 0x7fffu + ((u >> 16) & 1u)) >> 16; return (bf16)u; }
#ifdef HOST_EMU
__host__ __device__ __forceinline__ float sigmoidf_(float x) { return 1.0f / (1.0f + expf(-x)); }
#else
__device__ __forceinline__ float sigmoidf_(float x) { return __builtin_amdgcn_rcpf(1.0f + __builtin_amdgcn_exp2f(-1.4426950408889634f * x)); }
#endif
__host__ __device__ __forceinline__ float gelu_tanh(float x) { return 0.5f * x * (1.0f + tanhf(0.7978845608028654f * (x + 0.044715f * x * x * x))); }
__host__ __device__ __forceinline__ float siluf_(float x) { return x * sigmoidf_(x); }


constexpr float Y8_SCALE = 16.0f, Y8_INV = 1.0f / 16.0f;
__host__ __device__ __forceinline__ float fp82f(unsigned c) { const unsigned e = (c >> 3) & 15u, m = c & 7u; const float v = e ? (1.0f + (float)m * 0.125f) * exp2f((float)e - 7.0f) : (float)m * 0.001953125f; return (c & 0x80u) ? -v : v; }
#ifdef HOST_EMU
static inline unsigned f2fp8(float f) { const unsigned sg = f < 0.f ? 0x80u : 0u; float a = fabsf(f); if (!(a == a)) return 0x7fu; if (a >= 448.f) return sg | 0x7eu;
    if (a < 0.015625f) { const int q = (int)nearbyintf(a * 512.0f); return sg | (unsigned)q; }
    int e; float m = frexpf(a, &e); m *= 2.f; e -= 1; int q = (int)nearbyintf((m - 1.0f) * 8.0f); if (q == 8) { q = 0; e += 1; } unsigned c = ((unsigned)(e + 7) << 3) | (unsigned)q; if (c > 0x7eu) c = 0x7eu; return sg | c; }
#endif
struct f4 { float v[4]; };
__host__ __device__ __forceinline__ f4 ld_f4(const float* p) {
    f4 r;
#ifdef HOST_EMU
    for (int i = 0; i < 4; ++i) r.v[i] = p[i];
#else
    const float4 w = *(const float4*)p; r.v[0] = w.x; r.v[1] = w.y; r.v[2] = w.z; r.v[3] = w.w;
#endif
    return r;
}
__host__ __device__ __forceinline__ void st_bf4(bf16* p, float a, float b, float c, float d) {
#ifdef HOST_EMU
    p[0] = f2bf(a); p[1] = f2bf(b); p[2] = f2bf(c); p[3] = f2bf(d);
#else
    uint2 w; w.x = (unsigned)f2bf(a) | ((unsigned)f2bf(b) << 16); w.y = (unsigned)f2bf(c) | ((unsigned)f2bf(d) << 16); *(uint2*)p = w;
#endif
}
__host__ __device__ __forceinline__ void cp16(bf16* d, const bf16* s_) {
#ifdef HOST_EMU
    for (int i = 0; i < 8; ++i) d[i] = s_[i];
#else
    *(uint4*)d = *(const uint4*)s_;
#endif
}
struct f8 { float v[8]; };
__host__ __device__ __forceinline__ void st_bf8(bf16* p, const f8& x) {
#ifdef HOST_EMU
    for (int i = 0; i < 8; ++i) p[i] = f2bf(x.v[i]);
#else
    uint4 w; w.x = (unsigned)f2bf(x.v[0]) | ((unsigned)f2bf(x.v[1]) << 16); w.y = (unsigned)f2bf(x.v[2]) | ((unsigned)f2bf(x.v[3]) << 16);
    w.z = (unsigned)f2bf(x.v[4]) | ((unsigned)f2bf(x.v[5]) << 16); w.w = (unsigned)f2bf(x.v[6]) | ((unsigned)f2bf(x.v[7]) << 16); *(uint4*)p = w;
#endif
}
__host__ __device__ __forceinline__ f8 ld_bf8(const bf16* p) {
    f8 r;
#ifdef HOST_EMU
    for (int i = 0; i < 8; ++i) r.v[i] = bf2f(p[i]);
#else
    const uint4 w = *(const uint4*)p; r.v[0] = bf2f((bf16)(w.x & 0xffffu)); r.v[1] = bf2f((bf16)(w.x >> 16)); r.v[2] = bf2f((bf16)(w.y & 0xffffu)); r.v[3] = bf2f((bf16)(w.y >> 16));
    r.v[4] = bf2f((bf16)(w.z & 0xffffu)); r.v[5] = bf2f((bf16)(w.z >> 16)); r.v[6] = bf2f((bf16)(w.w & 0xffffu)); r.v[7] = bf2f((bf16)(w.w >> 16));
#endif
    return r;
}
__host__ __device__ __forceinline__ f8 ld_f8(const float* p) { f8 r; const f4 a = ld_f4(p), b = ld_f4(p + 4); for (int i = 0; i < 4; ++i) { r.v[i] = a.v[i]; r.v[4 + i] = b.v[i]; } return r; }
__host__ __device__ __forceinline__ void st_f8(float* p, const f8& x) {
#ifdef HOST_EMU
    for (int i = 0; i < 8; ++i) p[i] = x.v[i];
#else
    *(float4*)p = make_float4(x.v[0], x.v[1], x.v[2], x.v[3]); *(float4*)(p + 4) = make_float4(x.v[4], x.v[5], x.v[6], x.v[7]);
#endif
}


struct P {
    const float* in[44];
    float* out;
    unsigned char* ws;
    int grid, pad0, pad1, pad2;
};
#define WSP(T_, off) ((T_*)(p.ws + (off)))

enum { I_X = 0, I_L0_WIN, I_POSK, I_POSV, I_KW1, I_KW2, I_VW1, I_VW2, I_L0_WOUT, I_L0_LN1G, I_L0_LN1B,
       I_L0_ROUTER, I_L0_RBIAS, I_L0_WG, I_L0_WU, I_L0_WD, I_L0_SG, I_L0_SU, I_L0_SD, I_L0_LN2G, I_L0_LN2B,
       I_L1_WIN, I_LRE, I_LIM, I_BRE, I_BIM, I_CRE, I_CIM, I_DSK, I_LOGDT, I_WGLU, I_L1_WOUT, I_L1_LN1G, I_L1_LN1B,
       I_L1_ROUTER, I_L1_RBIAS, I_L1_WG, I_L1_WU, I_L1_WD, I_L1_SG, I_L1_SU, I_L1_SD, I_L1_LN2G, I_L1_LN2B };
constexpr int MOE_IN0[2] = { I_L0_ROUTER, I_L1_ROUTER };

struct XposeJob { const float* src; bf16* dst; int K, N, Ncover, il, il2, add, batch, grid; long sstride, dstride; int first; };
__device__ __forceinline__ void ph_xpose(const XposeJob j, unsigned char* lds) {
    bf16* tile = (bf16*)lds;
    const int tk = j.K / 64, tn = (j.Ncover + 255) / 256, per = tk * tn;
    for (int item = (BIDX - j.first + GDIM_OF(j)) % GDIM_OF(j); item < per * j.batch; item += GDIM_OF(j)) {
        const int bt = item / per, it = item % per, k0 = (it / tn) * 64, n0 = (it % tn) * 256;
        const float* src = j.src + (long)bt * j.sstride; bf16* dst = j.dst + (long)bt * j.dstride;
        PAR_BEGIN
            for (int e = tid; e < 16 * 64; e += NTHR) { const int k4 = (e >> 6) * 4, n4 = (e & 63) * 4, n = n0 + n4;
                float v[4][4];
                for (int r = 0; r < 4; ++r) { const float* row = src + (long)(k0 + k4 + r) * j.N;
                    if (n + 3 < j.N && (j.N & 3) == 0) { const f4 q = ld_f4(row + n); v[r][0] = q.v[0]; v[r][1] = q.v[1]; v[r][2] = q.v[2]; v[r][3] = q.v[3]; }
                    else for (int c = 0; c < 4; ++c) v[r][c] = (n + c < j.N) ? row[n + c] : 0.f; }
                for (int c = 0; c < 4; ++c) st_bf4(tile + (n4 + c) * 72 + k4, v[0][c], v[1][c], v[2][c], v[3][c]); }
        PAR_END
        PAR_BEGIN
            for (int e = tid; e < 256 * 8; e += NTHR) { const int nn = e >> 3, c8 = (e & 7) * 8, n = n0 + nn;
                if (n < j.Ncover) { const long row = (long)(n / j.il) * j.il2 + (n % j.il) + j.add; cp16(dst + row * j.K + k0 + c8, tile + nn * 72 + c8); } }
        PAR_END
    }
}

__device__ __forceinline__ void ph_cvt(const P& p, const float* src, bf16* dst, long n) {
    PAR_BEGIN
        for (long i = ((long)BIDX * NTHR + tid) * 8; i < n; i += (long)GDIM_OF(p) * NTHR * 8) st_bf8(dst + i, ld_f8(src + i));
    PAR_END
}

__device__ __forceinline__ void ph_tables(const P& p) {
    PAR_BEGIN
        const long gt = (long)BIDX * NTHR + tid, gs = (long)GDIM_OF(p) * NTHR;
        for (long i = gt; i < 2 * (NB * 2 * NCP / 256); i += gs) WSP(int, O_CMPTE)[i] = (i >= NB * 2 * NCP / 256) ? 1 : 0;
        for (long i = gt; i < 64 * 512; i += gs) {
            const int sl = (int)(i >> 9), which = (int)((i >> 8) & 1), c = (int)(i & 255);
            const float* pos = p.in[which ? I_POSV : I_POSK]; const float* w1 = p.in[which ? I_VW1 : I_KW1];
            float s = 0.f; for (int jx = 32 * sl; jx < 32 * sl + 32; ++jx) s += pos[jx] * w1[(long)jx * 256 + c];
            WSP(float, O_BIASP)[i] = s;
        }
        for (long i = gt; i < (long)S * 8; i += gs) { const int jx = (int)(i & 7), sp = (int)(i >> 3); const float inv = powf(500000.0f, -(float)jx / 8.0f), ang = (float)sp * inv;
            WSP(float, O_ROPE)[i * 2] = cosf(ang); WSP(float, O_ROPE)[i * 2 + 1] = sinf(ang); }
        for (long i = gt; i < (long)NG * 64; i += gs) {
            const int g = (int)(i >> 6);
            const float lre = p.in[I_LRE][i], lim = p.in[I_LIM][i], step = expf(p.in[I_LOGDT][g]);
            const float mag = expf(lre * step), are = mag * cosf(lim * step), aim = mag * sinf(lim * step);
            const float den = lre * lre + lim * lim;
            const float zre = ((are - 1.0f) * lre + aim * lim) / den, zim = (aim * lre - (are - 1.0f) * lim) / den;
            WSP(float, O_ABAR)[i * 2] = are; WSP(float, O_ABAR)[i * 2 + 1] = aim;
            const int ps = (int)(i & 63);
            for (int h = 0; h < 16; ++h) { const float br = p.in[I_BRE][i * 16 + h], bi = p.in[I_BIM][i * 16 + h]; const float bbr = zre * br - zim * bi, bbi = zre * bi + zim * br;
                WSP(float, O_BBAR)[(i * 16 + h) * 2] = bbr; WSP(float, O_BBAR)[(i * 16 + h) * 2 + 1] = bbi;
                WSP(bf16, O_S5BT)[((long)g * 128 + ps) * 16 + h] = f2bf(bbr); WSP(bf16, O_S5BT)[((long)g * 128 + 64 + ps) * 16 + h] = f2bf(bbi);
                WSP(bf16, O_S5CT)[((long)g * 32 + h) * 128 + ps] = f2bf(p.in[I_CRE][((long)g * 16 + h) * 64 + ps]); WSP(bf16, O_S5CT)[((long)g * 32 + h) * 128 + 64 + ps] = f2bf(-p.in[I_CIM][((long)g * 16 + h) * 64 + ps]);
                WSP(bf16, O_S5CT)[((long)g * 32 + 16 + h) * 128 + ps] = 0; WSP(bf16, O_S5CT)[((long)g * 32 + 16 + h) * 128 + 64 + ps] = 0; }
            { float* ap = WSP(float, O_S5AP) + i * 8; const float a2r = are * are - aim * aim, a2i = 2.f * are * aim, a3r = a2r * are - a2i * aim, a3i = a2r * aim + a2i * are, a4r = a2r * a2r - a2i * a2i, a4i = 2.f * a2r * a2i;
              ap[0] = are; ap[1] = aim; ap[2] = a2r; ap[3] = a2i; ap[4] = a3r; ap[5] = a3i; ap[6] = a4r; ap[7] = a4i; }
        }
    PAR_END
}

__device__ __forceinline__ void ph_bias_finish(const P& p) {
    PAR_BEGIN
        for (long i = (long)BIDX * NTHR + tid; i < 512; i += (long)GDIM_OF(p) * NTHR) { float s = 0.f; for (int sl = 0; sl < 64; ++sl) s += WSP(float, O_BIASP)[sl * 512 + i]; WSP(float, O_BIASK)[i] = s; }
    PAR_END
}
__device__ __forceinline__ void ph_rope(const P& p) {
    PAR_BEGIN
        const long rows_q = (long)NB * 8 * S, rows_k = (long)NB * 2 * S, total = rows_q + 3 * rows_k;
        for (long i = (long)BIDX * NTHR + tid; i < total; i += (long)GDIM_OF(p) * NTHR) {
            long row = i; bf16* base;
            if (row < rows_q) base = WSP(bf16, A_QB);
            else { row -= rows_q; const int w = (int)(row / rows_k); row -= (long)w * rows_k; base = WSP(bf16, w == 0 ? A_KC : (w == 1 ? A_KS : A_KW)); }
            const int sp = (int)(row % S); const float* cs = WSP(float, O_ROPE) + (long)sp * 16;
            bf16* r = base + row * 64; const f8 x1 = ld_bf8(r), x2 = ld_bf8(r + 8), t0 = ld_f8(cs), t1 = ld_f8(cs + 8);
            f8 o1, o2;
            for (int jx = 0; jx < 8; ++jx) { const float c = jx < 4 ? t0.v[2 * jx] : t1.v[2 * jx - 8], sn = jx < 4 ? t0.v[2 * jx + 1] : t1.v[2 * jx - 7];
                o1.v[jx] = x1.v[jx] * c - x2.v[jx] * sn; o2.v[jx] = x2.v[jx] * c + x1.v[jx] * sn; }
            st_bf8(r, o1); st_bf8(r + 8, o2);
        }
    PAR_END
}

__device__ __forceinline__ void ph_cmpw2(const P& p) {
    PAR_BEGIN
        const long rows = (long)NB * 2 * NCP, total = rows * 64 * 2;
        for (long i = (long)BIDX * NTHR + tid; i < total; i += (long)GDIM_OF(p) * NTHR) {
            const int which = (int)(i / (rows * 64)); const long r = (i / 64) % rows; const int d = (int)(i & 63);
            const bf16* hc = WSP(bf16, which ? A_HCV : A_HCK) + r * 256; const float* w2 = p.in[which ? I_VW2 : I_KW2];
            float s = 0.f; for (int c = 0; c < 256; ++c) s += bf2f(hc[c]) * w2[c * 64 + d];
            WSP(bf16, which ? A_VCMP : A_KCMP)[r * 64 + d] = f2bf(s);
        }
    PAR_END
}

__device__ __forceinline__ void ph_sb(const P& p) {
    PAR_BEGIN
        const bf16* QA = WSP(bf16, A_QA); const bf16* KA = WSP(bf16, A_KA); const bf16* VA = WSP(bf16, A_VA); bf16* ATT = WSP(bf16, A_ATT);
        for (long gq = (long)BIDX * NTHR + tid; gq < (long)NB * 8 * S; gq += (long)GDIM_OF(p) * NTHR) {
            const int t = (int)(gq % S); const long bh = gq / S; const int h = (int)(bh & 7); const long b = bh >> 3;
            float q[64], acc[64];
#pragma unroll
            for (int d = 0; d < 64; ++d) { q[d] = bf2f(QA[gq * 64 + d]) * (0.125f / QSCALE); acc[d] = 0.f; }
            float run = 0.f;
            for (int s = t - 1; s >= 0; --s) {
                const bf16* kr = KA + (bh * S + s) * 64; const bf16* vr = VA + (bh * S + s) * 64;
                float z = 0.f;
#pragma unroll
                for (int d = 0; d < 64; ++d) z += q[d] * bf2f(kr[d]);
                const float l1p = log1pf(expf(-fabsf(z)));
                const float sp_pos = fmaxf(z, 0.f) + l1p, sp_neg = fmaxf(-z, 0.f) + l1p;
                const float w = expf(run - sp_neg);
#pragma unroll
                for (int d = 0; d < 64; ++d) acc[d] += w * bf2f(vr[d]);
                run -= sp_pos;
                if (run < -120.f) break;
            }
            bf16* o = ATT + (b * S + t) * 1024 + h * 64;
#pragma unroll
            for (int d = 0; d < 64; ++d) o[d] = f2bf(acc[d]);
        }
    PAR_END
}

constexpr int NSA_LDS_PER = (4 * 64 + 4 * 512 + 4 * 64 + 64 + 64 + 32 + 16 + 16 + 16) * 4;
__device__ __forceinline__ void ph_nsa(const P& p, unsigned char* lds) {
    const int per = NTHR / 256; const long items = (long)NB * 2 * S;
    const bf16* QB = WSP(bf16, A_QB); bf16* ATT = WSP(bf16, A_ATT);
    const bf16* KCMP = WSP(bf16, A_KCMP); const bf16* VCMP = WSP(bf16, A_VCMP);
    for (long it0 = (long)BIDX * per; it0 < items; it0 += (long)GDIM_OF(p) * per) {
#define NSA_SETUP const int sub = tid >> 8, lt = tid & 255; const long item = it0 + sub; const bool act = item < items; \
        const int t = act ? (int)(item % S) : 0; const long bg = act ? item / S : 0; const int g = (int)(bg & 1); const long b = bg >> 1; \
        float* L = (float*)(lds + (size_t)sub * NSA_LDS_PER); float* qs = L; float* sc = qs + 256; float* osum = sc + 2048; float* pm = osum + 256; float* pl = pm + 64; \
        float* imp = pl + 64; int* sel = (int*)(imp + 32); float* st = (float*)(sel + 16); float* gts = st + 16; (void)lt; (void)g; (void)b; (void)t; (void)qs; (void)sc; (void)osum; (void)pm; (void)pl; (void)imp; (void)sel; (void)st; (void)gts;
#define NSA_SOFTMAX(NEXPR) \
        PAR_BEGIN NSA_SETUP if (act && lt < 64) { const int r = lt >> 4, part = lt & 15, n = (NEXPR); float m = -3e38f; \
            for (int jx = part; jx < n; jx += 16) m = fmaxf(m, sc[r * 512 + jx]); float l = 0.f; \
            for (int jx = part; jx < n; jx += 16) { const float v = sc[r * 512 + jx]; if (v > -1e29f) l += expf(v - m); } pm[lt] = m; pl[lt] = l; } PAR_END \
        PAR_BEGIN NSA_SETUP if (act && lt < 4) { float m = -3e38f; for (int q2 = 0; q2 < 16; ++q2) m = fmaxf(m, pm[lt * 16 + q2]); float l = 0.f; \
            for (int q2 = 0; q2 < 16; ++q2) { const float pmv = pm[lt * 16 + q2]; if (pmv > -1e29f) l += pl[lt * 16 + q2] * expf(pmv - m); } st[lt] = m; st[4 + lt] = l; } PAR_END \
        PAR_BEGIN NSA_SETUP if (act) { const int n = (NEXPR); for (int idx = lt; idx < 4 * n; idx += 256) { const int r = idx / n, jx = idx % n; const float v = sc[r * 512 + jx]; \
            const float l = st[4 + r]; sc[r * 512 + jx] = (v > -1e29f && l > 0.f) ? expf(v - st[r]) / l : 0.f; } } PAR_END
        PAR_BEGIN NSA_SETUP
            if (act) { const int r = lt >> 6, d = lt & 63; qs[lt] = bf2f(QB[((b * 8 + g * 4 + r) * S + t) * 64 + d]) * (0.125f / QSCALE); osum[lt] = 0.f;
                if (lt < 12) gts[lt] = sigmoidf_(WSP(float, A_GRAW)[(b * S + t) * 24 + g * 12 + lt]); }
        PAR_END
        PAR_BEGIN NSA_SETUP
            if (act) for (int idx = lt; idx < 4 * NCP; idx += 256) { const int r = idx / NCP, n = idx % NCP; float v = -1e30f;
                if (n < NCMP && 16 * n + 31 <= t) { const bf16* kr = KCMP + (bg * NCP + n) * 64; v = 0.f; for (int d = 0; d < 64; ++d) v += qs[r * 64 + d] * bf2f(kr[d]); }
                sc[r * 512 + n] = v; }
        PAR_END
        NSA_SOFTMAX(NCP)
        PAR_BEGIN NSA_SETUP
            if (act) { const int r = lt >> 6, d = lt & 63; float o = 0.f; for (int n = 0; n < NCMP; ++n) o += sc[r * 512 + n] * bf2f(VCMP[(bg * NCP + n) * 64 + d]); osum[lt] += gts[r * 3 + 0] * o; }
        PAR_END
        PAR_BEGIN NSA_SETUP
            if (act && lt < 32) { float s = 0.f; if (lt < NSLC) { const int n0 = 4 * lt - 1 < 0 ? 0 : 4 * lt - 1, n1 = 4 * lt + 3 > NCMP - 1 ? NCMP - 1 : 4 * lt + 3;
                for (int r = 0; r < 4; ++r) for (int n = n0; n <= n1; ++n) s += sc[r * 512 + n]; } imp[lt] = s; }
        PAR_END
        PAR_BEGIN NSA_SETUP
            if (act && lt == 0) { const int cur = t >> 6;
                for (int m = 0; m < NSLC; ++m) { const bool valid = m <= cur, forced = (m == 0) || (valid && m > cur - 2); imp[m] = forced ? imp[m] + 1e4f : (valid ? imp[m] : -1e30f); }
                int ns = 0;
                for (int i = 0; i < 8; ++i) { int best = 0; float bv = -3.4e38f; for (int m = 0; m < NSLC; ++m) if (imp[m] > bv) { bv = imp[m]; best = m; } imp[best] = -3.4e38f; if (best <= cur) sel[ns++] = best; }
                sel[8] = ns; }
        PAR_END
        PAR_BEGIN NSA_SETUP
            if (act) { const int n = sel[8] * 64; const bf16* KS = WSP(bf16, A_KS);
                for (int idx = lt; idx < 4 * n; idx += 256) { const int r = idx / n, jx = idx % n, pos = sel[jx >> 6] * 64 + (jx & 63); float v = -1e30f;
                    if (pos <= t) { const bf16* kr = KS + (bg * S + pos) * 64; v = 0.f; for (int d = 0; d < 64; ++d) v += qs[r * 64 + d] * bf2f(kr[d]); }
                    sc[r * 512 + jx] = v; } }
        PAR_END
        NSA_SOFTMAX(sel[8] * 64)
        PAR_BEGIN NSA_SETUP
            if (act) { const int r = lt >> 6, d = lt & 63, n = sel[8] * 64; const bf16* VS = WSP(bf16, A_VS); float o = 0.f;
                for (int jx = 0; jx < n; ++jx) { const int pos = sel[jx >> 6] * 64 + (jx & 63); o += sc[r * 512 + jx] * bf2f(VS[(bg * S + pos) * 64 + d]); }
                osum[lt] += gts[r * 3 + 1] * o; }
        PAR_END
        PAR_BEGIN NSA_SETUP
            if (act) { const bf16* KW = WSP(bf16, A_KW);
                for (int idx = lt; idx < 4 * 512; idx += 256) { const int r = idx >> 9, jx = idx & 511, pos = t - 511 + jx; float v = -1e30f;
                    if (pos >= 0) { const bf16* kr = KW + (bg * S + pos) * 64; v = 0.f; for (int d = 0; d < 64; ++d) v += qs[r * 64 + d] * bf2f(kr[d]); }
                    sc[r * 512 + jx] = v; } }
        PAR_END
        NSA_SOFTMAX(512)
        PAR_BEGIN NSA_SETUP
            if (act) { const int r = lt >> 6, d = lt & 63; const bf16* VW = WSP(bf16, A_VW); float o = 0.f;
                for (int jx = 0; jx < 512; ++jx) { const int pos = t - 511 + jx; if (pos >= 0) o += sc[r * 512 + jx] * bf2f(VW[(bg * S + pos) * 64 + d]); }
                osum[lt] += gts[r * 3 + 2] * o;
                ATT[(b * S + t) * 1024 + 512 + (g * 4 + r) * 64 + d] = f2bf(osum[lt]); }
        PAR_END
    }
}

constexpr int S5_LDS_PER = (8 * 128 + 8 * 16 + 128) * 4;
__device__ __forceinline__ void ph_s5(const P& p, unsigned char* lds) {
    const int per = NTHR / 64; const long items = (long)NB * NG;
    const bf16* U = WSP(bf16, C_U); bf16* YS = WSP(bf16, C_YS);
    const float* ABAR = WSP(float, O_ABAR); const float* BBAR = WSP(float, O_BBAR);
    for (long it0 = (long)BIDX * per; it0 < items; it0 += (long)GDIM_OF(p) * per) {
#define S5_SETUP const int sub = tid >> 6, lt = tid & 63; const long item = it0 + sub; const bool act = item < items; const int g = act ? (int)(item % NG) : 0; const long b = act ? item / NG : 0; \
        float* L = (float*)(lds + (size_t)sub * S5_LDS_PER); float* hbuf = L; float* ubuf = hbuf + 1024; float* hst = ubuf + 128; (void)lt; (void)g; (void)b; (void)hbuf; (void)ubuf; (void)hst;
        PAR_BEGIN S5_SETUP if (act) { hst[lt] = 0.f; hst[64 + lt] = 0.f; } PAR_END
        for (int t0 = 0; t0 < S; t0 += 8) {
            PAR_BEGIN S5_SETUP
                if (act) for (int e = lt; e < 128; e += 64) ubuf[e] = bf2f(U[(b * S + t0 + (e >> 4)) * DM + g * 16 + (e & 15)]);
            PAR_END
            PAR_BEGIN S5_SETUP
                if (act) { const long gp = (long)g * 64 + lt; const float are = ABAR[gp * 2], aim = ABAR[gp * 2 + 1]; float bre[16], bim[16];
#pragma unroll
                    for (int h = 0; h < 16; ++h) { bre[h] = BBAR[(gp * 16 + h) * 2]; bim[h] = BBAR[(gp * 16 + h) * 2 + 1]; }
                    float hr = hst[lt], hi = hst[64 + lt];
                    for (int i = 0; i < 8; ++i) { float ur = 0.f, ui = 0.f;
#pragma unroll
                        for (int h = 0; h < 16; ++h) { const float u = ubuf[i * 16 + h]; ur += u * bre[h]; ui += u * bim[h]; }
                        const float nr = are * hr - aim * hi + ur, ni = are * hi + aim * hr + ui; hr = nr; hi = ni;
                        hbuf[i * 128 + lt] = hr; hbuf[i * 128 + 64 + lt] = hi; }
                    hst[lt] = hr; hst[64 + lt] = hi; }
            PAR_END
            PAR_BEGIN S5_SETUP
                if (act) { const int hh = lt & 15, iq = lt >> 4; const float* cre = p.in[I_CRE] + ((long)g * 16 + hh) * 64; const float* cim = p.in[I_CIM] + ((long)g * 16 + hh) * 64;
                    const float dsk = p.in[I_DSK][g * 16 + hh];
                    for (int i = iq * 2; i < iq * 2 + 2; ++i) { float y = 0.f;
                        for (int pp = 0; pp < 64; ++pp) y += cre[pp] * hbuf[i * 128 + pp] - cim[pp] * hbuf[i * 128 + 64 + pp];
                        y += dsk * ubuf[i * 16 + hh];
                        YS[(b * S + t0 + i) * DM + g * 16 + hh] = f2bf(gelu_tanh(y)); } }
            PAR_END
        }
    }
}

__device__ __forceinline__ void ph_route(const P& p, const int layer, const int chunk, unsigned char* lds) {
    const int NT_ = 256; float* rb = (float*)lds;
    int* hist = (int*)(rb + (size_t)NT_ * 72); int* base = hist + 64; int* lr = base + 64;
    const float* LOGIT = WSP(float, B_LOGIT); const float* rbias = p.in[layer == 0 ? I_L0_RBIAS : I_L1_RBIAS];
    int* gcnt = WSP(int, O_CNT) + (layer * NCH + chunk) * 64;
    const long tbeg = (long)chunk * TC;
    for (long t0 = (long)BIDX * NT_; t0 < TC; t0 += (long)GDIM_OF(p) * NT_) {
        PAR_BEGIN if (tid < 64) hist[tid] = 0; PAR_END
        PAR_BEGIN
            const long tl = t0 + tid;
            if (tid < NT_ && tl < TC) { const long tok = tbeg + tl; float* sb = rb + (size_t)tid * 72; float* gs = sb + 64;
                for (int e = 0; e < 64; ++e) sb[e] = sigmoidf_(LOGIT[tok * 64 + e]) + rbias[e];
                for (int gq = 0; gq < 8; ++gq) { float m1 = -3e38f, m2 = -3e38f; for (int jx = 0; jx < 8; ++jx) { const float v = sb[gq * 8 + jx]; if (v > m1) { m2 = m1; m1 = v; } else if (v > m2) m2 = v; } gs[gq] = m1 + m2; }
                unsigned keep = 0u;
                for (int i = 0; i < 4; ++i) { int best = 0; float bv = -3.4e38f; for (int gq = 0; gq < 8; ++gq) if (!((keep >> gq) & 1u) && gs[gq] > bv) { bv = gs[gq]; best = gq; } keep |= 1u << best; }
                unsigned long long taken = 0ull; int ei[6]; float gv[6]; float gsum = 0.f;
#pragma unroll
                for (int i = 0; i < 6; ++i) { int best = 0; float bv = -3.4e38f;
                    for (int e = 0; e < 64; ++e) if (((keep >> (e >> 3)) & 1u) && !((taken >> e) & 1ull) && sb[e] > bv) { bv = sb[e]; best = e; }
                    taken |= 1ull << best; ei[i] = best; gv[i] = sb[best] - rbias[best]; gsum += gv[i]; }
#pragma unroll
                for (int i = 0; i < 6; ++i) { WSP(int, B_EIDX)[tok * 6 + i] = ei[i]; WSP(float, B_GATE)[tok * 6 + i] = gv[i] / gsum * 2.5f; lr[tid * 6 + i] = ATOMIC_ADD(&hist[ei[i]], 1); }
            }
        PAR_END
        PAR_BEGIN if (tid < 64) base[tid] = ATOMIC_ADD(&gcnt[tid], hist[tid]); PAR_END
        PAR_BEGIN
            const long tl = t0 + tid;
            if (tid < NT_ && tl < TC) { const long tok = tbeg + tl; for (int i = 0; i < 6; ++i) WSP(int, B_POS)[tok * 6 + i] = base[WSP(int, B_EIDX)[tok * 6 + i]] + lr[tid * 6 + i]; }
        PAR_END
    }
}

__device__ __forceinline__ void ph_offsets(const P& p, const int layer, const int chunk) {
    if (BIDX == 0) {
    const int* gcnt = WSP(int, O_CNT) + (layer * NCH + chunk) * 64; int* ps = WSP(int, O_PADSTART); int* te = WSP(int, O_TILEE);
    PAR_BEGIN if (tid == 0) { int acc = 0; for (int e = 0; e < 64; ++e) { ps[e] = acc; acc += (gcnt[e] + 255) / 256 * 256; } ps[64] = acc; } PAR_END
    PAR_BEGIN for (int i = tid; i < MOE_TILES; i += NTHR) { const int r = i * 256; int e = -1; if (r < ps[64]) { e = 0; while (ps[e + 1] <= r) ++e; } te[i] = e; } PAR_END
    }
}
__device__ __forceinline__ void ph_clear_rows(const P& p) {
    PAR_BEGIN for (long i = (long)BIDX * NTHR + tid; i < MOE_ROWS; i += (long)GDIM_OF(p) * NTHR) { WSP(int, B_ROWTOK)[i] = 0; WSP(float, B_ROWGATE)[i] = 0.f; } PAR_END
}
__device__ __forceinline__ void ph_scatter(const P& p, const int chunk) {
    PAR_BEGIN
        const int* ps = WSP(int, O_PADSTART);
        for (long i = (long)BIDX * NTHR + tid; i < (long)TC * 6; i += (long)GDIM_OF(p) * NTHR) { const long gi = (long)chunk * TC * 6 + i;
            const int e = WSP(int, B_EIDX)[gi], dest = ps[e] + WSP(int, B_POS)[gi];
            WSP(int, B_ROWTOK)[dest] = (int)(gi / 6); WSP(float, B_ROWGATE)[dest] = WSP(float, B_GATE)[gi]; WSP(int, B_POS)[gi] = dest; }
    PAR_END
}


__device__ __forceinline__ void ph_place(const P& p, const int layer, const int chunk, unsigned char* lds) {
    const int* gcnt = WSP(int, O_CNT) + (layer * NCH + chunk) * 64; int* psl = (int*)lds;
    PAR_BEGIN if (tid == 0) { int acc = 0; for (int e = 0; e < 64; ++e) { const int c = gcnt[e]; psl[e] = acc; psl[65 + e] = c; acc += (c + 255) / 256 * 256; } psl[64] = acc; } PAR_END
    PAR_BEGIN
        for (long i = (long)BIDX * NTHR + tid; i < (long)TC * 6; i += (long)GDIM_OF(p) * NTHR) { const long gi = (long)chunk * TC * 6 + i;
            const int e = WSP(int, B_EIDX)[gi], dest = psl[e] + WSP(int, B_POS)[gi];
            WSP(int, B_ROWTOK)[dest] = (int)(gi / 6); WSP(float, B_ROWGATE)[dest] = WSP(float, B_GATE)[gi]; WSP(int, B_POS)[gi] = dest; }
        for (long i = (long)BIDX * NTHR + tid; i < 64 * 256; i += (long)GDIM_OF(p) * NTHR) { const int e = (int)(i >> 8), k = (int)(i & 255), row = psl[e] + psl[65 + e] + k;
            if (row < psl[e + 1]) { WSP(int, B_ROWTOK)[row] = 0; WSP(float, B_ROWGATE)[row] = 0.f; } }
        if (BIDX == 0) { int* ps = WSP(int, O_PADSTART); int* te = WSP(int, O_TILEE);
            for (int i = tid; i < 65; i += NTHR) ps[i] = psl[i];
            for (int i = tid; i < MOE_TILES; i += NTHR) { const int r = i * 256; int e = -1; if (r < psl[64]) { e = 0; while (psl[e + 1] <= r) ++e; } te[i] = e; } }
    PAR_END
}
struct LnJob { const float* pre; const bf16* preb; const unsigned char* y; const int* pos; const float* gate; const float* g; const float* b; bf16* obf; float* of32; unsigned char* of8; long t_beg, t_cnt; int grid, pad; };
constexpr int LN_LDS_PER = (DM + 64) * 4;
__device__ __forceinline__ void ph_ln(const LnJob j, unsigned char* lds) {
    const int per = NTHR / 256;
    for (long r0 = (long)BIDX * per; r0 < j.t_cnt; r0 += (long)GDIM_OF(j) * per) {
#define LN_SETUP const int sub = tid >> 8, lt = tid & 255; const long rl = r0 + sub; const bool act = rl < j.t_cnt; const long tok = j.t_beg + (act ? rl : 0); \
        float* vals = (float*)(lds + (size_t)sub * LN_LDS_PER); float* red = vals + DM; (void)lt; (void)tok; (void)red;
        PAR_BEGIN LN_SETUP
            if (act) for (int c = lt; c < DM; c += 256) { float v = j.preb ? bf2f(j.preb[tok * DM + c]) : j.pre[tok * DM + c]; if (j.y) { float ys = 0.f; for (int k = 0; k < 6; ++k) ys += fp82f(j.y[(long)j.pos[tok * 6 + k] * DM + c]); v += ys * Y8_INV; } vals[c] = v; }
        PAR_END
        PAR_BEGIN LN_SETUP if (act && lt < 16) { float s = 0.f; for (int c = lt * (DM / 16); c < (lt + 1) * (DM / 16); ++c) s += vals[c]; red[lt] = s; } PAR_END
        PAR_BEGIN LN_SETUP if (act && lt == 0) { float s = 0.f; for (int i = 0; i < 16; ++i) s += red[i]; red[32] = s / (float)DM; } PAR_END
        PAR_BEGIN LN_SETUP if (act && lt < 16) { const float mu = red[32]; float s = 0.f; for (int c = lt * (DM / 16); c < (lt + 1) * (DM / 16); ++c) { const float d = vals[c] - mu; s += d * d; } red[lt] = s; } PAR_END
        PAR_BEGIN LN_SETUP if (act && lt == 0) { float s = 0.f; for (int i = 0; i < 16; ++i) s += red[i]; red[33] = 1.0f / sqrtf(s / (float)DM + LN_EPS); } PAR_END
        PAR_BEGIN LN_SETUP
            if (act) { const float mu = red[32], rs = red[33];
                for (int c = lt; c < DM; c += 256) { const float o = (vals[c] - mu) * rs * j.g[c] + j.b[c]; if (j.obf) j.obf[tok * DM + c] = f2bf(o); else j.of32[tok * DM + c] = o; } }
        PAR_END
    }
}


#ifndef HOST_EMU
constexpr float W8_SCALE = 64.0f, A8_SCALE = 8.0f, F8_ACC_INV = 1.0f / (W8_SCALE * A8_SCALE);
__device__ __forceinline__ float clamp8(float x) { return __builtin_amdgcn_fmed3f(x, -448.0f, 448.0f); }
__device__ __forceinline__ unsigned pk4_fp8(float a, float b, float c, float d) { int w = __builtin_amdgcn_cvt_pk_fp8_f32(clamp8(a), clamp8(b), 0, false); w = __builtin_amdgcn_cvt_pk_fp8_f32(clamp8(c), clamp8(d), w, true); return (unsigned)w; }
__device__ __forceinline__ float wave_sum(float v) {
    v += __builtin_bit_cast(float, __builtin_amdgcn_mov_dpp(__builtin_bit_cast(int, v), 0xB1, 0xf, 0xf, true));
    v += __builtin_bit_cast(float, __builtin_amdgcn_mov_dpp(__builtin_bit_cast(int, v), 0x4E, 0xf, 0xf, true));
    v += __builtin_bit_cast(float, __builtin_amdgcn_ds_swizzle(__builtin_bit_cast(int, v), 0x101F));
    v += __builtin_bit_cast(float, __builtin_amdgcn_ds_swizzle(__builtin_bit_cast(int, v), 0x201F));
    v += __builtin_bit_cast(float, __builtin_amdgcn_ds_swizzle(__builtin_bit_cast(int, v), 0x401F));
    auto rr = __builtin_amdgcn_permlane32_swap(__float_as_uint(v), __float_as_uint(v), false, false);
    return __uint_as_float(rr[0]) + __uint_as_float(rr[1]); }
__device__ __forceinline__ void ph_ln2(const LnJob j) {
    static_assert(DM == 1024, "ln2: a lane owns 16 consecutive columns; a wave takes two adjacent rows per pass (their loads overlap)");
    int tid = threadIdx.x; asm volatile("" : "+v"(tid));
    const int lane = tid & 63, wid = __builtin_amdgcn_readfirstlane(tid >> 6);
    for (long r = ((long)blockIdx.x * 8 + wid) * 2; r < j.t_cnt; r += (long)j.grid * 16) {
        int c0 = lane * 16; asm volatile("" : "+v"(c0));
        const long tok0 = j.t_beg + r; float v[2][16]; int yrow[2][6];
#pragma unroll
        for (int u = 0; u < 2; ++u) { const long o = (tok0 + u) * DM + c0;
            if (j.y) {
#pragma unroll
                for (int k = 0; k < 6; ++k) yrow[u][k] = j.pos[(tok0 + u) * 6 + k]; }
            if (j.preb) { const f8 a = ld_bf8(j.preb + o), b = ld_bf8(j.preb + o + 8);
#pragma unroll
                for (int q = 0; q < 8; ++q) { v[u][q] = a.v[q]; v[u][8 + q] = b.v[q]; } }
            else { const f8 a = ld_f8(j.pre + o), b = ld_f8(j.pre + o + 8);
#pragma unroll
                for (int q = 0; q < 8; ++q) { v[u][q] = a.v[q]; v[u][8 + q] = b.v[q]; } } }
        if (j.y) {
#pragma unroll
            for (int kb = 0; kb < 6; kb += 3) {
                uint4 w[2][3]; float gk[2][3];
#pragma unroll
                for (int u = 0; u < 2; ++u)
#pragma unroll
                    for (int k = 0; k < 3; ++k) { w[u][k] = *(const uint4*)(j.y + (long)yrow[u][kb + k] * DM + c0); gk[u][k] = j.gate ? j.gate[(tok0 + u) * 6 + kb + k] * Y8_INV : Y8_INV; }
#pragma unroll
                for (int u = 0; u < 2; ++u)
#pragma unroll
                    for (int k = 0; k < 3; ++k) { const unsigned ww[4] = {w[u][k].x, w[u][k].y, w[u][k].z, w[u][k].w};
#pragma unroll
                        for (int q = 0; q < 4; ++q) { const auto lo = __builtin_amdgcn_cvt_pk_f32_fp8((int)ww[q], false), hi2 = __builtin_amdgcn_cvt_pk_f32_fp8((int)ww[q], true);
                            v[u][4 * q] += lo[0] * gk[u][k]; v[u][4 * q + 1] += lo[1] * gk[u][k]; v[u][4 * q + 2] += hi2[0] * gk[u][k]; v[u][4 * q + 3] += hi2[1] * gk[u][k]; } }
            }
        }
        int c0b = lane * 16; asm volatile("" : "+v"(c0b));
        const f8 g0 = ld_f8(j.g + c0b), g1 = ld_f8(j.g + c0b + 8), b0 = ld_f8(j.b + c0b), b1 = ld_f8(j.b + c0b + 8);
#pragma unroll
        for (int u = 0; u < 2; ++u) {
            float s = 0.f;
#pragma unroll
            for (int i = 0; i < 16; ++i) s += v[u][i];
            const float mu = wave_sum(s) * (1.0f / (float)DM);
            float q2 = 0.f;
#pragma unroll
            for (int i = 0; i < 16; ++i) { const float d = v[u][i] - mu; q2 += d * d; }
            const float rs = 1.0f / sqrtf(wave_sum(q2) * (1.0f / (float)DM) + LN_EPS);
            f8 o0, o1;
#pragma unroll
            for (int q = 0; q < 8; ++q) { o0.v[q] = (v[u][q] - mu) * rs * g0.v[q] + b0.v[q]; o1.v[q] = (v[u][8 + q] - mu) * rs * g1.v[q] + b1.v[q]; }
            const long o = (tok0 + u) * DM + c0;
            if (j.obf) { st_bf8(j.obf + o, o0); st_bf8(j.obf + o + 8, o1); } else { st_f8(j.of32 + o, o0); st_f8(j.of32 + o + 8, o1); }
            if (j.of8) { uint4 w8; w8.x = pk4_fp8(o0.v[0] * A8_SCALE, o0.v[1] * A8_SCALE, o0.v[2] * A8_SCALE, o0.v[3] * A8_SCALE); w8.y = pk4_fp8(o0.v[4] * A8_SCALE, o0.v[5] * A8_SCALE, o0.v[6] * A8_SCALE, o0.v[7] * A8_SCALE);
                w8.z = pk4_fp8(o1.v[0] * A8_SCALE, o1.v[1] * A8_SCALE, o1.v[2] * A8_SCALE, o1.v[3] * A8_SCALE); w8.w = pk4_fp8(o1.v[4] * A8_SCALE, o1.v[5] * A8_SCALE, o1.v[6] * A8_SCALE, o1.v[7] * A8_SCALE); *(uint4*)(j.of8 + o) = w8; }
        }
    }
}
#define ph_ln(j, lds) ph_ln2(j)
#endif

struct GemmArgs { const bf16* A; const bf16* Bt; const int* rowidx; const int* tile_e; const int* m_rt; long lda; long b_estride; int M, N, K, grid; };
constexpr int GEMM_LDS = 131072, GEMM_TE_LDS = 8192;
static_assert(MOE_TILES <= 2048, "tile table");
struct EpiProj0 { static constexpr bool HAS_LD = false; unsigned char* ws;
    __device__ __forceinline__ void oct(int row, int col, const f8& v, const f8&) const {
        if (col >= PROJ_N) return; const long b = row / S, s = row % S;
        if (col < 2048) { const int seg = col >> 9, h = (col >> 6) & 7, d = col & 63; bf16* base = (bf16*)(ws + A_QA + (size_t)seg * HB); const float sc = (seg == 3 || seg == 0) ? QSCALE : 1.0f;
            f8 o; for (int i = 0; i < 8; ++i) o.v[i] = v.v[i] * sc; st_bf8(base + ((b * 8 + h) * S + s) * 64 + d, o); }
        else if (col < 2816) { const int c2 = col - 2048, seg = c2 >> 7, g = (c2 >> 6) & 1, d = c2 & 63; bf16* base = (bf16*)(ws + A_KC + (size_t)seg * GB); st_bf8(base + ((b * 2 + g) * S + s) * 64 + d, v); }
        else st_f8((float*)(ws + A_GRAW) + (long)row * 24 + (col - 2816), v); } };
#ifndef HOST_EMU
struct EpiProj0R { static constexpr bool HAS_LD = false; unsigned char* ws; float asc;
    __device__ __forceinline__ void oct(int row, int col, const f8& v0, const f8&) const {
        if (col >= PROJ_N) return; const long b = row / S, s = row % S;
        f8 v; for (int i = 0; i < 8; ++i) v.v[i] = v0.v[i] * asc;
        f8 x = v;
        const bool rs = (col >= 1536 && col < 2048) || (col >= 2048 && col < 2816 && ((((col - 2048) >> 7) & 1) == 0));
        if (rs && (col & 32) == 0) {
            f8 pv; for (int i = 0; i < 8; ++i) pv.v[i] = __builtin_bit_cast(float, __builtin_amdgcn_ds_swizzle(__builtin_bit_cast(int, v.v[i]), 0x401F));
            if ((col & 16) == 0) { const float* cs = (const float*)(ws + O_ROPE) + s * 16; const f8 t0 = ld_f8(cs), t1 = ld_f8(cs + 8); const float sg = (col & 8) ? 1.0f : -1.0f;
                for (int jx = 0; jx < 8; ++jx) { const float c = jx < 4 ? t0.v[2 * jx] : t1.v[2 * jx - 8], sn = jx < 4 ? t0.v[2 * jx + 1] : t1.v[2 * jx - 7]; x.v[jx] = v.v[jx] * c + sg * pv.v[jx] * sn; } } }
        if (col < 2048) { const int seg = col >> 9, h = (col >> 6) & 7, d = col & 63; bf16* base = (bf16*)(ws + A_QA + (size_t)seg * HB); const float sc = (seg == 3 || seg == 0) ? QSCALE : 1.0f;
            f8 o; for (int i = 0; i < 8; ++i) o.v[i] = x.v[i] * sc; st_bf8(base + ((b * 8 + h) * S + s) * 64 + d, o); }
        else if (col < 2816) { const int c2 = col - 2048, seg = c2 >> 7, g = (c2 >> 6) & 1, d = c2 & 63; bf16* base = (bf16*)(ws + A_KC + (size_t)seg * GB); st_bf8(base + ((b * 2 + g) * S + s) * 64 + d, x); }
        else st_f8((float*)(ws + A_GRAW) + (long)row * 24 + (col - 2816), x); } };
#endif
struct EpiCmp1 { static constexpr bool HAS_LD = true; bf16* out; const float* bias;
    __device__ __forceinline__ f8 ld(int row, int col) const { return ld_f8(bias + (row >= NB * 2 * NCP ? 256 : 0) + col); }
    __device__ __forceinline__ void fin(int row, int col, const f8& v, const f8&, const f8& bv) const { f8 o; for (int i = 0; i < 8; ++i) o.v[i] = gelu_tanh(v.v[i] + bv.v[i]); st_bf8(out + (long)row * 256 + col, o); }
    __device__ __forceinline__ void oct(int row, int col, const f8& v, const f8& v2) const { fin(row, col, v, v2, ld(row, col)); } };
struct EpiCmp2 { static constexpr bool HAS_LD = false; bf16* outk; bf16* outv;
    __device__ __forceinline__ void oct(int row, int col, const f8& v, const f8&) const { if (col < 64) { bf16* o = row >= NB * 2 * NCP ? outv + (long)(row - NB * 2 * NCP) * 64 : outk + (long)row * 64; st_bf8(o + col, v); } } };
struct EpiResF32 { static constexpr bool HAS_LD = true; bf16* out; const float* res; int ld_; float sc = 1.0f;
    __device__ __forceinline__ f8 ld(int row, int col) const { return ld_f8(res + (long)row * ld_ + col); }
    __device__ __forceinline__ void fin(int row, int col, const f8& v, const f8&, const f8& r) const { f8 o; for (int i = 0; i < 8; ++i) o.v[i] = DN_ALPHA * r.v[i] + v.v[i] * sc; st_bf8(out + (long)row * ld_ + col, o); }
    __device__ __forceinline__ void oct(int row, int col, const f8& v, const f8& v2) const { fin(row, col, v, v2, ld(row, col)); } };
template <bool OUT_BF> struct EpiResBfT { static constexpr bool HAS_LD = true; float* out; bf16* outb; const bf16* res; int ld_; float sc = 1.0f;
    __device__ __forceinline__ f8 ld(int row, int col) const { return ld_bf8(res + (long)row * ld_ + col); }
    __device__ __forceinline__ void fin(int row, int col, const f8& v, const f8&, const f8& r) const { f8 o; for (int i = 0; i < 8; ++i) o.v[i] = DN_ALPHA * r.v[i] + v.v[i] * sc;
        if (OUT_BF) st_bf8(outb + (long)row * ld_ + col, o); else st_f8(out + (long)row * ld_ + col, o); }
    __device__ __forceinline__ void oct(int row, int col, const f8& v, const f8& v2) const { fin(row, col, v, v2, ld(row, col)); } };
struct EpiLogit { static constexpr bool HAS_LD = false; float* out;
    __device__ __forceinline__ void oct(int row, int col, const f8& v, const f8&) const { if (col < 64) st_f8(out + (long)row * 64 + col, v); } };
struct EpiSwiglu { static constexpr bool HAS_LD = false; bf16* out;
    __device__ __forceinline__ void oct(int row, int col, const f8& v, const f8& v2) const { if ((col & GU_IL) == 0) { f8 o; for (int i = 0; i < 8; ++i) o.v[i] = siluf_(v.v[i]) * v2.v[i];
        st_bf8(out + (long)row * 256 + (col >> 8) * GU_IL + (col & (GU_IL - 1)), o); } } };
#ifndef HOST_EMU
struct EpiSwiglu8 { static constexpr bool HAS_LD = false; unsigned char* out;
    __device__ __forceinline__ void oct(int row, int col, const f8& v, const f8& v2) const { if ((col & GU_IL) == 0) { float o[8]; for (int i = 0; i < 8; ++i) o[i] = siluf_(v.v[i] * F8_ACC_INV) * (v2.v[i] * (F8_ACC_INV * A8_SCALE));
        uint2 w; w.x = pk4_fp8(o[0], o[1], o[2], o[3]); w.y = pk4_fp8(o[4], o[5], o[6], o[7]); *(uint2*)(out + (long)row * 256 + (col >> 8) * GU_IL + (col & (GU_IL - 1))) = w; } } };
#endif
#ifndef HOST_EMU
struct EpiY8 { static constexpr bool HAS_LD = false; unsigned char* out; int ld_; float sc;
    __device__ __forceinline__ void oct(int row, int col, const f8& v, const f8&) const { const float f = Y8_SCALE * sc;
        uint2 w; w.x = pk4_fp8(v.v[0] * f, v.v[1] * f, v.v[2] * f, v.v[3] * f); w.y = pk4_fp8(v.v[4] * f, v.v[5] * f, v.v[6] * f, v.v[7] * f); *(uint2*)(out + (long)row * ld_ + col) = w; } };
#endif
struct EpiY { static constexpr bool HAS_LD = true; unsigned char* out; const float* rowgate; int ld_; float sc = 1.0f;
    __device__ __forceinline__ f8 ld(int row, int) const { f8 r; r.v[0] = rowgate[row]; for (int i = 1; i < 8; ++i) r.v[i] = 0.f; return r; }
    __device__ __forceinline__ void fin(int row, int col, const f8& v, const f8&, const f8& rg) const { const float gt = rg.v[0] * (Y8_SCALE * sc); unsigned char* o = out + (long)row * ld_ + col;
#ifdef HOST_EMU
        for (int i = 0; i < 8; ++i) o[i] = (unsigned char)f2fp8(v.v[i] * gt);
#else
        int w0 = __builtin_amdgcn_cvt_pk_fp8_f32(v.v[0] * gt, v.v[1] * gt, 0, false); w0 = __builtin_amdgcn_cvt_pk_fp8_f32(v.v[2] * gt, v.v[3] * gt, w0, true);
        int w1 = __builtin_amdgcn_cvt_pk_fp8_f32(v.v[4] * gt, v.v[5] * gt, 0, false); w1 = __builtin_amdgcn_cvt_pk_fp8_f32(v.v[6] * gt, v.v[7] * gt, w1, true);
        uint2 w; w.x = (unsigned)w0; w.y = (unsigned)w1; *(uint2*)o = w;
#endif
    }
    __device__ __forceinline__ void oct(int row, int col, const f8& v, const f8& v2) const { fin(row, col, v, v2, ld(row, col)); } };
struct EpiBf { static constexpr bool HAS_LD = false; bf16* out; int ld; float sc = 1.0f;
    __device__ __forceinline__ void oct(int row, int col, const f8& v, const f8&) const { f8 o; for (int i = 0; i < 8; ++i) o.v[i] = v.v[i] * sc; st_bf8(out + (long)row * ld + col, o); } };
#ifndef HOST_EMU
struct EpiGlu8 { static constexpr bool HAS_LD = true; unsigned char* out; const unsigned char* ys; int ld_; int pad = 0;
    __device__ __forceinline__ f8 ld(int row, int col) const { const uint2 w = *(const uint2*)(ys + (long)row * ld_ + col); f8 r;
        const auto a0 = __builtin_amdgcn_cvt_pk_f32_fp8((int)w.x, false), a1 = __builtin_amdgcn_cvt_pk_f32_fp8((int)w.x, true), a2 = __builtin_amdgcn_cvt_pk_f32_fp8((int)w.y, false), a3 = __builtin_amdgcn_cvt_pk_f32_fp8((int)w.y, true);
        r.v[0] = a0[0]; r.v[1] = a0[1]; r.v[2] = a1[0]; r.v[3] = a1[1]; r.v[4] = a2[0]; r.v[5] = a2[1]; r.v[6] = a3[0]; r.v[7] = a3[1]; return r; }
    __device__ __forceinline__ void fin(int row, int col, const f8& v, const f8&, const f8& y) const { float o[8]; for (int i = 0; i < 8; ++i) o[i] = y.v[i] * sigmoidf_(v.v[i] * F8_ACC_INV);
        uint2 w; w.x = pk4_fp8(o[0], o[1], o[2], o[3]); w.y = pk4_fp8(o[4], o[5], o[6], o[7]); *(uint2*)(out + (long)row * ld_ + col) = w; }
    __device__ __forceinline__ void oct(int row, int col, const f8& v, const f8& v2) const { fin(row, col, v, v2, ld(row, col)); } };
#endif
struct EpiGlu { static constexpr bool HAS_LD = true; bf16* out; const bf16* ys; int ld_; int pad = 0;
    __device__ __forceinline__ f8 ld(int row, int col) const { return ld_bf8(ys + (long)row * ld_ + col); }
    __device__ __forceinline__ void fin(int row, int col, const f8& v, const f8&, const f8& y) const { f8 o; for (int i = 0; i < 8; ++i) o.v[i] = y.v[i] * sigmoidf_(v.v[i]); st_bf8(out + (long)row * ld_ + col, o); }
    __device__ __forceinline__ void oct(int row, int col, const f8& v, const f8& v2) const { fin(row, col, v, v2, ld(row, col)); } };

struct Unit { int pm, pn; };
struct StaticOrder {
    int nM, nN, nwg, G, c;
    __host__ __device__ void init(int M, int N, int G_, int c_) { nM = M / 256; nN = N / 256; nwg = nM * nN; G = G_; c = c_; }
    __host__ __device__ bool next(int i, Unit& u) const {
        const long L = (long)i * G + c; if (L >= nwg) return false;
        int wgid = (int)L; { const int q = nwg / 8, r = nwg % 8, xcd = wgid % 8, off = wgid / 8; wgid = (xcd < r ? xcd * (q + 1) : r * (q + 1) + (xcd - r) * q) + off; }
        const int nig = 8 * nN, gid = wgid / nig, fm = gid * 8, gsz = (nM - fm) < 8 ? (nM - fm) : 8;
        u.pm = fm + ((wgid % nig) % gsz); u.pn = (wgid % nig) / gsz; return true;
    }
};

#ifndef HOST_EMU
typedef short bf16x8_t __attribute__((ext_vector_type(8)));
typedef float f32x4_t __attribute__((ext_vector_type(4)));
#define LAS __attribute__((address_space(3)))
constexpr int HTB = 128 * 64 * 2;
__device__ __forceinline__ int lds_byte(int r, int c) { const int st = (r >> 4) * 2 + (c >> 5), rr = r & 15, cc = c & 31, ob = rr * 64 + cc * 2; return st * 1024 + (ob ^ (((ob >> 9) & 1) << 5)); }
__device__ __forceinline__ void stage_rc(int b, int& R, int& C) { const int st = b / 1024, sb = b % 1024, swz = sb ^ (((sb >> 9) & 1) << 5); R = (st >> 1) * 16 + swz / 64; C = (st & 1) * 32 + (swz % 64) / 2; }

typedef int i32x4_t __attribute__((ext_vector_type(4)));
typedef int i32x8_t __attribute__((ext_vector_type(8)));
template <class Epi, bool F8 = false, bool TE_LDS = false>
__device__ __forceinline__ void ph_gemm(const GemmArgs g, const Epi E, unsigned char* lds_) {
    LAS unsigned char* lds = (LAS unsigned char*)lds_;
    int tid = threadIdx.x; asm volatile("" : "+v"(tid));
    const int wid = __builtin_amdgcn_readfirstlane(tid >> 6), lane = tid & 63, wr = wid >> 2, wc = wid & 3, fr = lane & 15, fq = lane >> 4;
    const int K = g.K, nt = K / 64;
    const int Mrt = g.m_rt ? __builtin_amdgcn_readfirstlane(*g.m_rt) : g.M;
    StaticOrder S; S.init(Mrt, g.N, g.grid, (int)blockIdx.x);
    int RA[2]; unsigned CA2[2], voffB[2];
#pragma unroll
    for (int i = 0; i < 2; ++i) { int R, C; stage_rc(tid * 16 + i * 8192, R, C); RA[i] = R; CA2[i] = (unsigned)C * 2u;
        const int rho = R & 31, Rb = (R & ~31) + 8 * ((rho & 15) >> 2) + 4 * (rho >> 4) + (rho & 3);
        voffB[i] = (unsigned)(Rb * K + C) * 2u; }
    const size_t kstep = 128;
    const size_t hstepB = (size_t)128 * K * 2, tstepB = 2 * hstepB;
    const unsigned lda2 = (unsigned)g.lda * 2u;
    const unsigned ldsw = (unsigned)wid * 1024u;
    const int aoff = lds_byte(wr * 64 + fr, fq * 8), boff = lds_byte(wc * 32 + fr, fq * 8);
    const char* gA = (const char*)g.A;
#define PG8_SA(b, h) (((b) * 2 + (h)) * HTB)
#define PG8_SB(b, h) ((4 + (b) * 2 + (h)) * HTB)
#define PG8_STAGE_B(bufoff, gbase) do { _Pragma("unroll") for (int _i = 0; _i < 2; ++_i) \
        __builtin_amdgcn_global_load_lds((const unsigned*)((const char*)(gbase) + voffB[_i]), (LAS unsigned*)(lds + (bufoff) + ldsw + _i * 8192), 16, 0, 0); } while (0)
#define PG8_STAGE_A(bufoff, kbase, o0, o1) do { \
        __builtin_amdgcn_global_load_lds((const unsigned*)((kbase) + (o0)), (LAS unsigned*)(lds + (bufoff) + ldsw), 16, 0, 0); \
        __builtin_amdgcn_global_load_lds((const unsigned*)((kbase) + (o1)), (LAS unsigned*)(lds + (bufoff) + ldsw + 8192), 16, 0, 0); } while (0)
#define PG8_LDA(dst, b, h) do { _Pragma("unroll") for (int m = 0; m < 4; ++m) { dst[m].lo = *(const LAS i32x4_t*)(lds + PG8_SA(b, h) + aoff + m * 2048); dst[m].hi = *(const LAS i32x4_t*)(lds + PG8_SA(b, h) + aoff + m * 2048 + 1024); } } while (0)
#define PG8_LDB(dst, b, h) do { _Pragma("unroll") for (int n = 0; n < 2; ++n) { dst[n].lo = *(const LAS i32x4_t*)(lds + PG8_SB(b, h) + boff + n * 2048); dst[n].hi = *(const LAS i32x4_t*)(lds + PG8_SB(b, h) + boff + n * 2048 + 1024); } } while (0)
#define F8_SC 0
#define PG8_MMA(ai, bj, At, Bt) do { __builtin_amdgcn_s_setprio(1); \
        if constexpr (F8) { _Pragma("unroll") for (int m = 0; m < 4; ++m) _Pragma("unroll") for (int n = 0; n < 2; ++n) \
            asm volatile("v_mfma_f32_16x16x128_f8f6f4 %0, %1, %2, %0" : "+v"(acc[ai][bj][m][n]) : "v"(Bt[n]), "v"(At[m])); } \
        else { _Pragma("unroll") for (int m = 0; m < 4; ++m) _Pragma("unroll") for (int n = 0; n < 2; ++n) _Pragma("unroll") for (int k = 0; k < 2; ++k) \
            acc[ai][bj][m][n] = __builtin_amdgcn_mfma_f32_16x16x32_bf16(__builtin_bit_cast(bf16x8_t, k ? Bt[n].hi : Bt[n].lo), __builtin_bit_cast(bf16x8_t, k ? At[m].hi : At[m].lo), acc[ai][bj][m][n], 0, 0, 0); } \
        __builtin_amdgcn_s_setprio(0); } while (0)
#define PG8_WAIT_V(n) asm volatile("s_waitcnt vmcnt(" #n ")" ::: "memory")
#define PG8_WAIT_L(n) asm volatile("s_waitcnt lgkmcnt(" #n ")" ::: "memory")
#define PG8_BAR __builtin_amdgcn_s_barrier()
#define PG8_SCHED __builtin_amdgcn_sched_barrier(0)
#define PG8_OFFS(u, o) do { _Pragma("unroll") for (int _h = 0; _h < 2; ++_h) _Pragma("unroll") for (int _i = 0; _i < 2; ++_i) { const int _row = (u).pm * 256 + _h * 128 + RA[_i]; \
        const unsigned _ri = g.rowidx ? (unsigned)g.rowidx[_row] : (unsigned)_row; o[_h][_i] = _ri * lda2 + CA2[_i]; } } while (0)
#define PG8_BBASE(u) ((const char*)g.Bt + (g.tile_e ? (size_t)__builtin_amdgcn_readfirstlane(TE_LDS ? *(const LAS int*)(lds + GEMM_LDS + 4 * (u).pm) : g.tile_e[(u).pm]) * (size_t)g.b_estride * 2 : (size_t)0) + (size_t)(u).pn * tstepB)
    Unit cur, nxt; int ui = 0;
    if (!S.next(0, cur)) return;
    f32x4_t acc[2][2][4][2];
#pragma unroll
    for (int a = 0; a < 2; ++a)
#pragma unroll
        for (int b = 0; b < 2; ++b)
#pragma unroll
            for (int m = 0; m < 4; ++m)
#pragma unroll
                for (int n = 0; n < 2; ++n) acc[a][b][m][n] = (f32x4_t){0.f, 0.f, 0.f, 0.f};
    i32x8_t At[4], B0[2], B1[2];
    unsigned oc[2][2], on[2][2];
    PG8_OFFS(cur, oc);
    const char* cB = PG8_BBASE(cur);
    PG8_STAGE_B(PG8_SB(0, 0), cB); PG8_STAGE_B(PG8_SB(0, 1), cB + hstepB); PG8_STAGE_A(PG8_SA(0, 0), gA, oc[0][0], oc[0][1]); PG8_STAGE_A(PG8_SA(0, 1), gA, oc[1][0], oc[1][1]);
    if (wr == 1) PG8_BAR;
    PG8_WAIT_V(2); PG8_BAR;
    PG8_STAGE_B(PG8_SB(1, 0), cB + kstep); PG8_STAGE_A(PG8_SA(1, 0), gA + kstep, oc[0][0], oc[0][1]); PG8_STAGE_B(PG8_SB(1, 1), cB + hstepB + kstep);
    PG8_WAIT_V(6); PG8_BAR;
    for (;;) {
        const bool has_next = S.next(ui + 1, nxt);
        const char* nB = cB;
        if (has_next) { PG8_OFFS(nxt, on); nB = PG8_BBASE(nxt); }
        else {
#pragma unroll
            for (int h = 0; h < 2; ++h)
#pragma unroll
                for (int i = 0; i < 2; ++i) on[h][i] = oc[h][i];
        }
        for (int t = 0; t < nt; t += 2) {
            const bool last = (t == nt - 2);
            const char* a1 = gA + (size_t)(t + 1) * kstep;
            const char* a2 = last ? gA : gA + (size_t)(t + 2) * kstep; const char* b2 = last ? nB : cB + (size_t)(t + 2) * kstep;
            const char* a3 = a2 + kstep; const char* b3 = b2 + kstep;
            const unsigned o00 = last ? on[0][0] : oc[0][0], o01 = last ? on[0][1] : oc[0][1], o10 = last ? on[1][0] : oc[1][0], o11 = last ? on[1][1] : oc[1][1];
            PG8_LDB(B0, 0, 0); PG8_LDB(B1, 0, 1); PG8_SCHED; PG8_LDA(At, 0, 0); PG8_STAGE_A(PG8_SA(1, 1), a1, oc[1][0], oc[1][1]);
            PG8_WAIT_V(8); PG8_WAIT_L(0); PG8_BAR; PG8_MMA(0, 0, At, B0); PG8_MMA(0, 1, At, B1); PG8_BAR; PG8_SCHED;
            PG8_LDA(At, 0, 1); PG8_STAGE_B(PG8_SB(0, 0), b2); PG8_STAGE_B(PG8_SB(0, 1), b2 + hstepB); PG8_STAGE_A(PG8_SA(0, 0), a2, o00, o01);
            PG8_WAIT_V(8); PG8_WAIT_L(0); PG8_BAR; PG8_MMA(1, 0, At, B0); PG8_MMA(1, 1, At, B1); PG8_BAR; PG8_SCHED;
            PG8_LDB(B0, 1, 0); PG8_LDB(B1, 1, 1); PG8_SCHED; PG8_LDA(At, 1, 0); PG8_STAGE_A(PG8_SA(0, 1), a2, o10, o11);
            PG8_WAIT_V(8); PG8_WAIT_L(0); PG8_BAR; PG8_MMA(0, 0, At, B0); PG8_MMA(0, 1, At, B1); PG8_BAR; PG8_SCHED;
            PG8_LDA(At, 1, 1); PG8_STAGE_B(PG8_SB(1, 0), b3); PG8_STAGE_B(PG8_SB(1, 1), b3 + hstepB); PG8_STAGE_A(PG8_SA(1, 0), a3, o00, o01);
            PG8_WAIT_V(8); PG8_WAIT_L(0); PG8_BAR; PG8_MMA(1, 0, At, B0); PG8_MMA(1, 1, At, B1); PG8_BAR; PG8_SCHED;
        }
        if (wr == 0) PG8_BAR;
        if constexpr (F8) asm volatile("s_nop 15\n\ts_nop 15" ::: "memory");
        {
            f8 raw[4], rawn[4];
#define PG8_EPI_LD(dst, ai_, mp_) do { _Pragma("unroll") for (int mm = 0; mm < 2; ++mm) _Pragma("unroll") for (int bj = 0; bj < 2; ++bj) \
                dst[mm * 2 + bj] = E.ld(cur.pm * 256 + (ai_) * 128 + wr * 64 + ((mp_) * 2 + mm) * 16 + fr, cur.pn * 256 + bj * 128 + wc * 32 + fq * 8); } while (0)
            if constexpr (Epi::HAS_LD) PG8_EPI_LD(rawn, 0, 0);
#pragma unroll
            for (int b4 = 0; b4 < 4; ++b4) { const int ai = b4 >> 1, mp = b4 & 1;
                if constexpr (Epi::HAS_LD) {
#pragma unroll
                    for (int i = 0; i < 4; ++i) raw[i] = rawn[i];
                    if (b4 < 3) PG8_EPI_LD(rawn, (b4 + 1) >> 1, (b4 + 1) & 1);
                }
#pragma unroll
                for (int mm = 0; mm < 2; ++mm) { const int m = mp * 2 + mm, row = cur.pm * 256 + ai * 128 + wr * 64 + m * 16 + fr;
#pragma unroll
                    for (int bj = 0; bj < 2; ++bj) { f8 v, v2;
#pragma unroll
                        for (int n = 0; n < 2; ++n)
#pragma unroll
                            for (int q = 0; q < 4; ++q) { v.v[4 * n + q] = acc[ai][bj][m][n][q]; v2.v[4 * n + q] = acc[ai][bj ^ 1][m][n][q]; }
                        const int col = cur.pn * 256 + bj * 128 + wc * 32 + fq * 8;
                        if constexpr (Epi::HAS_LD) E.fin(row, col, v, v2, raw[mm * 2 + bj]); else E.oct(row, col, v, v2); } }
            }
#undef PG8_EPI_LD
        }
        if (!has_next) break;
#pragma unroll
        for (int a = 0; a < 2; ++a)
#pragma unroll
            for (int b = 0; b < 2; ++b)
#pragma unroll
                for (int m = 0; m < 4; ++m)
#pragma unroll
                    for (int n = 0; n < 2; ++n) acc[a][b][m][n] = (f32x4_t){0.f, 0.f, 0.f, 0.f};
        cur = nxt; cB = nB; ++ui;
#pragma unroll
        for (int h = 0; h < 2; ++h)
#pragma unroll
            for (int i = 0; i < 2; ++i) oc[h][i] = on[h][i];
        if (wr == 1) PG8_BAR;
    }
    PG8_WAIT_V(0);
    PG8_BAR;
#undef PG8_SA
#undef PG8_SB
#undef PG8_STAGE_A
#undef PG8_STAGE_B
#undef PG8_LDA
#undef PG8_LDB
#undef PG8_MMA
#undef PG8_WAIT_V
#undef PG8_WAIT_L
#undef PG8_BAR
#undef PG8_SCHED
#undef PG8_OFFS
#undef PG8_BBASE
}
#else
template <class Epi> static void ph_gemm(const GemmArgs g, const Epi E, unsigned char*) {
    static float Ct[256][256];
    const int Mrt = g.m_rt ? *g.m_rt : g.M;
    StaticOrder S; S.init(Mrt, g.N, GDIM_OF(g), BIDX); Unit u;
    for (int i = 0; S.next(i, u); ++i) {
        const int brow = u.pm * 256, bcol = u.pn * 256; const bf16* Bg = g.Bt + (g.tile_e ? (long)g.tile_e[u.pm] * g.b_estride : 0);
        for (int r = 0; r < 256; ++r) { const long ridx = g.rowidx ? g.rowidx[brow + r] : brow + r; const bf16* a = g.A + ridx * g.lda;
            for (int c = 0; c < 256; ++c) { const bf16* bt = Bg + (long)(bcol + c) * g.K; float s = 0.f; for (int k = 0; k < g.K; ++k) s += bf2f(a[k]) * bf2f(bt[k]); Ct[r][c] = s; } }
        for (int r = 0; r < 256; ++r) for (int c = 0; c < 256; c += 8) { f8 v, v2; for (int q = 0; q < 8; ++q) { v.v[q] = Ct[r][c + q]; v2.v[q] = Ct[r][(c ^ 128) + q]; } E.oct(brow + r, bcol + c, v, v2); }
    }
}
#endif
__host__ __device__ __forceinline__ GemmArgs mk_gemm_(int grid, const bf16* A, long lda, const bf16* Bt, int M, int N, int K) {
    GemmArgs g; g.grid = grid; g.A = A; g.Bt = Bt; g.rowidx = nullptr; g.tile_e = nullptr; g.m_rt = nullptr; g.lda = lda; g.b_estride = 0; g.M = M; g.N = N; g.K = K; return g; }
#define mk_gemm(...) mk_gemm_(p.grid, __VA_ARGS__)
__host__ __device__ __forceinline__ XposeJob mk_xpose_(int grid, const float* src, bf16* dst, int K, int N, int Ncover, int il, int il2, int add, int batch, long ss, long ds) {
    XposeJob j; j.grid = grid; j.src = src; j.dst = dst; j.K = K; j.N = N; j.Ncover = Ncover; j.il = il; j.il2 = il2; j.add = add; j.batch = batch; j.sstride = ss; j.dstride = ds; j.first = 0; return j; }
#define mk_xpose(...) mk_xpose_(p.grid, __VA_ARGS__)

#ifndef HOST_EMU
#define XB_TMO      128
#define XB_XCNT(j)  (256  + 64 * (j))
#define XB_XSUB(j)  (1280 + 64 * (j))
#define XB_XGEN(j)  (2304 + 64 * (j))
#define XB_TOP      3328
#define XB_TOPGEN   3392
#define XCD_BAR_WORDS 3456
#define XB_SPIN_CAP (1u << 18)
__device__ __forceinline__ unsigned xb_ld(unsigned* p)              { return __hip_atomic_load(p, __ATOMIC_RELAXED, __HIP_MEMORY_SCOPE_AGENT); }
__device__ __forceinline__ unsigned xb_add(unsigned* p, unsigned v) { return __hip_atomic_fetch_add(p, v, __ATOMIC_RELAXED, __HIP_MEMORY_SCOPE_AGENT); }
__device__ __forceinline__ unsigned xb_xcc_id() { return (unsigned)__builtin_amdgcn_s_getreg((3 << 11) | 20) & 0xFu; }
#define XB_SPIN(cond, bar) do { unsigned _sp = 0; while (cond) { __builtin_amdgcn_s_sleep(1); \
    if ((++_sp & 255u) == 0u) { if (xb_ld(&(bar)[XB_TMO])) break; if (_sp > XB_SPIN_CAP) { atomicAdd(&(bar)[XB_TMO], 1u); break; } } } } while (0)
struct XcdBarrier { unsigned* bar; unsigned x; volatile LAS unsigned* st; unsigned G; };
__device__ __forceinline__ XcdBarrier xcd_barrier_post(unsigned* bar, volatile LAS unsigned* st, unsigned G) {
    XcdBarrier b; b.bar = bar; b.x = xb_xcc_id(); b.st = st; b.G = G;
    if (threadIdx.x == 0) (void)xb_add(&bar[XB_XCNT(b.x)], 1u);
    return b;
}
__device__ __forceinline__ void xcd_barrier_complete(unsigned* bar, unsigned x, unsigned G, unsigned& nloc, unsigned& nx) {
    unsigned sum, cnt, mine, sp = 0u;
    for (;;) {
        sum = 0u; cnt = 0u; mine = 0u;
#pragma unroll
        for (unsigned j = 0; j < 16; ++j) { const unsigned c = xb_ld(&bar[XB_XCNT(j)]); sum += c; cnt += (c > 0u) ? 1u : 0u; mine = (j == x) ? c : mine; }
        if (sum == G) break;
        __builtin_amdgcn_s_sleep(1);
        if ((++sp & 255u) == 0u) { if (xb_ld(&bar[XB_TMO])) break; if (sp > XB_SPIN_CAP) { atomicAdd(&bar[XB_TMO], 1u); break; } }
    }
    nloc = mine > 0u ? mine : 1u; nx = cnt > 0u ? cnt : 1u;
}
__device__ __forceinline__ void xcd_barrier(const XcdBarrier& b) {
    asm volatile("s_waitcnt vmcnt(0)" ::: "memory");
    __syncthreads();
    if (threadIdx.x == 0) {
        unsigned* bar = b.bar;
        __builtin_amdgcn_s_waitcnt(0);
        unsigned nloc = b.st[0], nx = b.st[1];
        if (nloc == 0u) { xcd_barrier_complete(bar, b.x, b.G, nloc, nx); b.st[0] = nloc; b.st[1] = nx; }
        const unsigned old = xb_add(&bar[XB_XSUB(b.x)], 1u);
        const unsigned gen = old / nloc;
        if (old + 1u == (gen + 1u) * nloc) {
            __builtin_amdgcn_fence(__ATOMIC_RELEASE, "agent");
            asm volatile("s_waitcnt vmcnt(0)" ::: "memory");
            const unsigned og = xb_add(&bar[XB_TOP], 1u);
            const unsigned tg = og / nx;
            if (og + 1u == (tg + 1u) * nx) xb_add(&bar[XB_TOPGEN], 1u);
            else XB_SPIN(xb_ld(&bar[XB_TOPGEN]) == tg, bar);
            __builtin_amdgcn_fence(__ATOMIC_ACQUIRE, "agent");
            xb_add(&bar[XB_XGEN(b.x)], 1u);
            asm volatile("s_waitcnt vmcnt(0)" ::: "memory");
        } else {
            XB_SPIN(xb_ld(&bar[XB_XGEN(b.x)]) == gen, bar);
            __builtin_amdgcn_fence(__ATOMIC_ACQUIRE, "agent");
            asm volatile("s_waitcnt vmcnt(0)" ::: "memory");
        }
    }
    __syncthreads();
}
#define PHASE_BEGIN {
#define PHASE_END } xcd_barrier(gbar);
#define PROGRAM_ARGS const P& p, unsigned char* lds, const XcdBarrier& gbar
#else
constexpr int EMU_GRID = 4;
#define PHASE_BEGIN for (int _b = 0; _b < EMU_GRID; ++_b) { e_blockIdx.x = _b;
#define PHASE_END }
#define PROGRAM_ARGS const P& p, unsigned char* lds, int gbar
#endif


#ifndef HOST_EMU
typedef float f32x16_t __attribute__((ext_vector_type(16)));
typedef short s16x4_t __attribute__((ext_vector_type(4)));
typedef float f32x2_t __attribute__((ext_vector_type(2)));
typedef __bf16 bf16x2_t __attribute__((ext_vector_type(2)));
typedef unsigned u32x4_t __attribute__((ext_vector_type(4)));
typedef unsigned u32x2_t __attribute__((ext_vector_type(2)));
__device__ __forceinline__ int crow(int r, int hi) { return (r & 3) + 8 * (r >> 2) + 4 * hi; }
__device__ __forceinline__ unsigned cvtpk(float lo, float hi) { f32x2_t v = {lo, hi}; bf16x2_t b = __builtin_convertvector(v, bf16x2_t); return __builtin_bit_cast(unsigned, b); }
__device__ __forceinline__ float xhalf_max(float m) { auto rr = __builtin_amdgcn_permlane32_swap(__float_as_uint(m), __float_as_uint(m), false, false); return fmaxf(__uint_as_float(rr[0]), __uint_as_float(rr[1])); }
__device__ __forceinline__ float xhalf_sum(float m) { auto rr = __builtin_amdgcn_permlane32_swap(__float_as_uint(m), __float_as_uint(m), false, false); return __uint_as_float(rr[0]) + __uint_as_float(rr[1]); }
constexpr int N2_SLOT = 16384;
constexpr int N2_IMPA = 2 * N2_SLOT, N2_IMPB = N2_IMPA + 32768, N2_IMPT = N2_IMPB + 32768, N2_SEL = N2_IMPT + 8192, N2_END = N2_SEL + 512;
static_assert(N2_END <= GEMM_LDS, "nsa lds");
__device__ __forceinline__ void n2_qk(f32x16_t& p0, f32x16_t& p1, const LAS unsigned char* Ks, const bf16x8_t (&qr)[4], int r32, int hi) {
#pragma unroll
    for (int r = 0; r < 16; ++r) { p0[r] = 0.f; p1[r] = 0.f; }
    asm volatile("" : "+v"(p0), "+v"(p1));
#pragma unroll
    for (int ks = 0; ks < 4; ++ks) { const int c = ((2 * ks + hi) ^ (r32 & 7)) * 16;
        const bf16x8_t k0 = *(const LAS bf16x8_t*)(Ks + r32 * 128 + c), k1 = *(const LAS bf16x8_t*)(Ks + (32 + r32) * 128 + c);
        p0 = __builtin_amdgcn_mfma_f32_32x32x16_bf16(k0, qr[ks], p0, 0, 0, 0); p1 = __builtin_amdgcn_mfma_f32_32x32x16_bf16(k1, qr[ks], p1, 0, 0, 0); }
}
__device__ __forceinline__ void n2_pv(f32x16_t& o0, f32x16_t& o1, const LAS unsigned char* Vs, const f32x16_t& p0, const f32x16_t& p1, int lane) {
    const int hi = lane >> 5; const LAS unsigned char* vb = Vs + (4 * hi + ((lane & 15) >> 2)) * 128 + (((lane >> 4) & 1) * 16 + (lane & 3) * 4) * 2;
#pragma unroll
    for (int s = 0; s < 4; ++s) {
        bf16x8_t pb;
        { const f32x16_t& pp = (s < 2) ? p0 : p1; const int r0 = 8 * (s & 1);
          union { unsigned u[4]; bf16x8_t v; } pk; pk.u[0] = cvtpk(pp[r0], pp[r0 + 1]); pk.u[1] = cvtpk(pp[r0 + 2], pp[r0 + 3]); pk.u[2] = cvtpk(pp[r0 + 4], pp[r0 + 5]); pk.u[3] = cvtpk(pp[r0 + 6], pp[r0 + 7]); pb = pk.v; }
#pragma unroll
        for (int d0 = 0; d0 < 2; ++d0) {
            const s16x4_t lo = __builtin_bit_cast(s16x4_t, __builtin_amdgcn_ds_read_tr16_b64_v4i16((LAS s16x4_t*)(vb + s * 2048 + d0 * 64)));
            const s16x4_t hh = __builtin_bit_cast(s16x4_t, __builtin_amdgcn_ds_read_tr16_b64_v4i16((LAS s16x4_t*)(vb + s * 2048 + 1024 + d0 * 64)));
            const bf16x8_t vf = (bf16x8_t){lo[0], lo[1], lo[2], lo[3], hh[0], hh[1], hh[2], hh[3]};
            if (d0 == 0) o0 = __builtin_amdgcn_mfma_f32_32x32x16_bf16(vf, pb, o0, 0, 0, 0); else o1 = __builtin_amdgcn_mfma_f32_32x32x16_bf16(vf, pb, o1, 0, 0, 0);
        }
    }
}
__device__ __forceinline__ void ph_nsa2(const P& p, unsigned char* lds_) {
    LAS unsigned char* lds = (LAS unsigned char*)lds_;
    int tid = threadIdx.x; asm volatile("" : "+v"(tid));
    const int lane = tid & 63, wid = __builtin_amdgcn_readfirstlane(tid >> 6), r32 = lane & 31, hi = lane >> 5;
    const int hr = wid >> 1, tsub = (wid & 1) * 32 + r32;
    const int skey = tid >> 3, sch = tid & 7;
    const unsigned soff = (unsigned)(skey * 128 + sch * 16);
    const bf16* QB = WSP(bf16, A_QB); bf16* ATT = WSP(bf16, A_ATT);
    const bf16* KCMP = WSP(bf16, A_KCMP); const bf16* VCMP = WSP(bf16, A_VCMP);
    const bf16* KS = WSP(bf16, A_KS); const bf16* VS = WSP(bf16, A_VS); const bf16* KW = WSP(bf16, A_KW); const bf16* VW = WSP(bf16, A_VW);
    LAS float* IMPA = (LAS float*)(lds + N2_IMPA); LAS float* IMPB = (LAS float*)(lds + N2_IMPB); LAS float* IMPT = (LAS float*)(lds + N2_IMPT); LAS unsigned* SEL = (LAS unsigned*)(lds + N2_SEL);
    constexpr int NQT = S / 64, NBG = NB * 2, NUNITS = NBG * NQT;
#define N2_LOAD(Kp, Vp, row0, kreg, vreg) do { const long rb_ = (long)(row0) * 128;     \
        kreg = *(const u32x4_t*)((const char*)(Kp) + rb_ + soff); vreg = *(const u32x4_t*)((const char*)(Vp) + rb_ + soff); } while (0)
#define N2_STORE(slot, kreg, vreg) do { *(LAS u32x4_t*)(lds + (slot) * N2_SLOT + skey * 128 + ((sch ^ (skey & 7)) * 16)) = kreg; *(LAS u32x4_t*)(lds + (slot) * N2_SLOT + 8192 + skey * 128 + sch * 16) = vreg; } while (0)
    for (int unit0 = blockIdx.x; unit0 < NUNITS; unit0 += p.grid) {
        int unit = unit0;
        if (p.grid % NBG == 0) { const int per = p.grid / NBG, k = unit0 / p.grid, c0 = (unit0 % p.grid) / NBG; if ((k & 1) && (k + 1) * p.grid <= NUNITS) unit = k * p.grid + (per - 1 - c0) * NBG + unit0 % NBG; }
        const int bg = unit % NBG, qt = unit / NBG, g = bg & 1, b = bg >> 1, t0 = qt * 64, t = t0 + tsub, cur = qt;
        const long kvrow = (long)bg * S;
        bf16x8_t qr[4];
        { const bf16* qrow = QB + ((long)(b * 8 + g * 4 + hr) * S + t) * 64;
#pragma unroll
          for (int ks = 0; ks < 4; ++ks) qr[ks] = *(const bf16x8_t*)(qrow + ks * 16 + hi * 8); }
        float gate[3];
        { const float* gr = WSP(float, A_GRAW) + ((long)b * S + t) * 24 + (g * 4 + hr) * 3;
#pragma unroll
          for (int i = 0; i < 3; ++i) gate[i] = sigmoidf_(gr[i]); }
        f32x16_t oa0, oa1;
#pragma unroll
        for (int r = 0; r < 16; ++r) { oa0[r] = 0.f; oa1[r] = 0.f; }
        asm volatile("" : "+v"(oa0), "+v"(oa1));
        u32x4_t kreg, vreg;
        N2_LOAD(KCMP, VCMP, (long)bg * NCP, kreg, vreg); N2_STORE(0, kreg, vreg);
        N2_LOAD(KCMP, VCMP, (long)bg * NCP + 64, kreg, vreg); N2_STORE(1, kreg, vreg);
        if (tid < 64) SEL[64 + 0] = 0u;
        __syncthreads();
        {
            f32x16_t c0, c1, c2, c3;
            n2_qk(c0, c1, lds, qr, r32, hi); n2_qk(c2, c3, lds + N2_SLOT, qr, r32, hi);
            float m = -1e30f;
            int nlim = (t >= 31) ? ((t - 31) >> 4) : -1; nlim = (nlim > NCMP - 1 ? NCMP - 1 : nlim) - 4 * hi;
            asm volatile("" : "+v"(nlim));
#pragma unroll
            for (int r = 0; r < 16; ++r) { const int nc = (r & 3) + 8 * (r >> 2);
                if (nc > nlim) c0[r] = -INFINITY;
                if (nc + 32 > nlim) c1[r] = -INFINITY;
                if (nc + 64 > nlim) c2[r] = -INFINITY;
                if (nc + 96 > nlim) c3[r] = -INFINITY;
                m = fmaxf(fmaxf(m, c0[r]), fmaxf(c1[r], fmaxf(c2[r], c3[r]))); }
            m = xhalf_max(m);
            float l = 0.f;
#pragma unroll
            for (int r = 0; r < 16; ++r) { c0[r] = __builtin_amdgcn_exp2f(c0[r] - m); c1[r] = __builtin_amdgcn_exp2f(c1[r] - m); c2[r] = __builtin_amdgcn_exp2f(c2[r] - m); c3[r] = __builtin_amdgcn_exp2f(c3[r] - m); l += (c0[r] + c1[r]) + (c2[r] + c3[r]); }
            l = xhalf_sum(l);
            const float inv = l > 0.f ? 1.0f / l : 0.f;
#pragma unroll
            for (int r = 0; r < 16; ++r) { c0[r] *= inv; c1[r] *= inv; c2[r] *= inv; c3[r] *= inv; }
            asm volatile("" : "+v"(c0), "+v"(c1), "+v"(c2), "+v"(c3));
            { LAS float* ia = IMPA + ((wid * 2 + hi) * 32 + r32) * 16; LAS float* ib = IMPB + ((wid * 2 + hi) * 32 + r32) * 16;
#pragma unroll
              for (int gi = 0; gi < 4; ++gi) {
                  ia[0 + gi] = (c0[4 * gi] + c0[4 * gi + 1]) + (c0[4 * gi + 2] + c0[4 * gi + 3]); ib[0 + gi] = c0[4 * gi + 3];
                  ia[4 + gi] = (c1[4 * gi] + c1[4 * gi + 1]) + (c1[4 * gi + 2] + c1[4 * gi + 3]); ib[4 + gi] = c1[4 * gi + 3];
                  ia[8 + gi] = (c2[4 * gi] + c2[4 * gi + 1]) + (c2[4 * gi + 2] + c2[4 * gi + 3]); ib[8 + gi] = c2[4 * gi + 3];
                  ia[12 + gi] = (c3[4 * gi] + c3[4 * gi + 1]) + (c3[4 * gi + 2] + c3[4 * gi + 3]); ib[12 + gi] = c3[4 * gi + 3]; } }
#pragma unroll
            for (int r = 0; r < 16; ++r) { c0[r] *= gate[0]; c1[r] *= gate[0]; c2[r] *= gate[0]; c3[r] *= gate[0]; }
            n2_pv(oa0, oa1, lds + 8192, c0, c1, lane); n2_pv(oa0, oa1, lds + N2_SLOT + 8192, c2, c3, lane);
        }
        __syncthreads();
        if (tid < 64) {
            const int tt = tid, th = tt >> 5, tr = tt & 31; LAS float* im = IMPT + tt * 32;
            for (int m = 0; m < 32; ++m) { float sacc = 0.f;
                if (m < NSLC) {
#pragma unroll
                    for (int r = 0; r < 4; ++r) { const int w = 2 * r + th; sacc += IMPA[((w * 2 + (m & 1)) * 32 + tr) * 16 + (m >> 1)]; if (m >= 1) sacc += IMPB[((w * 2 + ((m - 1) & 1)) * 32 + tr) * 16 + ((m - 1) >> 1)]; } }
                const bool valid = m <= cur, forced = (m == 0) || (valid && m > cur - 2);
                im[m] = (m < NSLC) ? (forced ? sacc + 1e4f : (valid ? sacc : -1e30f)) : -3.4e38f; }
            unsigned sm = 0u;
            for (int i = 0; i < 8; ++i) { int best = 0; float bv = -3.4e38f; for (int m = 0; m < NSLC; ++m) { const float v = im[m]; if (v > bv) { bv = v; best = m; } } im[best] = -3.4e38f; if (best <= cur) sm |= 1u << best; }
            SEL[tt] = sm; atomicOr((unsigned*)&SEL[64], sm);
        }
        __syncthreads();
        const unsigned mysel = SEL[tsub];
#pragma unroll
        for (int br = 0; br < 2; ++br) {
            const bf16* Kp = br == 0 ? KS : KW; const bf16* Vp = br == 0 ? VS : VW;
            unsigned bm;
            if (br == 0) bm = (unsigned)__builtin_amdgcn_readfirstlane((int)SEL[64]);
            else { const int lo = cur - 8 < 0 ? 0 : cur - 8; bm = (cur >= 31 ? 0xffffffffu : ((1u << (cur + 1)) - 1u)) & ~((1u << lo) - 1u); }
            int ja = __builtin_ctz(bm); bm &= bm - 1u; int jb = bm ? __builtin_ctz(bm) : -1; bm &= bm - 1u;
            N2_LOAD(Kp, Vp, kvrow + 64 * ja, kreg, vreg); N2_STORE(0, kreg, vreg);
            if (jb >= 0) { N2_LOAD(Kp, Vp, kvrow + 64 * jb, kreg, vreg); N2_STORE(1, kreg, vreg); }
            __syncthreads();
            int ps = 0; float m = -1e30f, l = 0.f; f32x16_t o0, o1;
#pragma unroll
            for (int r = 0; r < 16; ++r) { o0[r] = 0.f; o1[r] = 0.f; }
            asm volatile("" : "+v"(o0), "+v"(o1));
#define N2_STEP(jj, sub) do { \
                f32x16_t p0, p1; \
                n2_qk(p0, p1, lds + (sub) * N2_SLOT, qr, r32, hi); \
                const bool dead = (br == 0) && !((mysel >> (jj)) & 1u); \
                const bool diag = ((jj) == cur), tail = (br == 1) && ((jj) == cur - 8); \
                float rm = -1e30f; \
                int khi = dead ? -1000 : (diag ? tsub - 4 * hi : 1000), klo = tail ? tsub - 4 * hi : -1000;     \
                asm volatile("" : "+v"(khi), "+v"(klo)); \
                _Pragma("unroll") for (int r = 0; r < 16; ++r) { const int kc = (r & 3) + 8 * (r >> 2); \
                    if (kc > khi || kc <= klo) p0[r] = -INFINITY; \
                    if (kc + 32 > khi || kc + 32 <= klo) p1[r] = -INFINITY; \
                    rm = fmaxf(rm, fmaxf(p0[r], p1[r])); } \
                rm = xhalf_max(rm); \
                const float mn = fmaxf(m, rm), sc = __builtin_amdgcn_exp2f(m - mn); m = mn; \
                float rs = 0.f; \
                _Pragma("unroll") for (int r = 0; r < 16; ++r) { p0[r] = __builtin_amdgcn_exp2f(p0[r] - mn); p1[r] = __builtin_amdgcn_exp2f(p1[r] - mn); rs += p0[r] + p1[r]; } \
                l = l * sc + rs; \
                _Pragma("unroll") for (int r = 0; r < 16; ++r) { o0[r] *= sc; o1[r] *= sc; } \
                n2_pv(o0, o1, lds + (sub) * N2_SLOT + 8192, p0, p1, lane); } while (0)
            for (;;) {
                const int na = bm ? __builtin_ctz(bm) : -1; bm &= bm - 1u; const int nb = bm ? __builtin_ctz(bm) : -1; bm &= bm - 1u;
                if (na >= 0) N2_LOAD(Kp, Vp, kvrow + 64 * na, kreg, vreg);
                N2_STEP(ja, 2 * ps);
                if (na >= 0) N2_STORE(2 * (ps ^ 1), kreg, vreg);
                if (jb >= 0) {
                    if (nb >= 0) N2_LOAD(Kp, Vp, kvrow + 64 * nb, kreg, vreg);
                    N2_STEP(jb, 2 * ps + 1);
                    if (nb >= 0) N2_STORE(2 * (ps ^ 1) + 1, kreg, vreg); }
                __syncthreads();
                if (na < 0) break;
                ja = na; jb = nb; ps ^= 1;
            }
#undef N2_STEP
            l = xhalf_sum(l);
            const float f = (l > 0.f ? 1.0f / l : 0.f) * gate[1 + br];
#pragma unroll
            for (int r = 0; r < 16; ++r) { oa0[r] += f * o0[r]; oa1[r] += f * o1[r]; }
        }
        { unsigned char* orow = (unsigned char*)ATT + ((long)b * S + t) * 1024 + 512 + (g * 4 + hr) * 64;
#pragma unroll
          for (int gi = 0; gi < 4; ++gi) {
              *(unsigned*)(orow + 8 * gi + 4 * hi) = pk4_fp8(oa0[4 * gi] * A8_SCALE, oa0[4 * gi + 1] * A8_SCALE, oa0[4 * gi + 2] * A8_SCALE, oa0[4 * gi + 3] * A8_SCALE);
              *(unsigned*)(orow + 32 + 8 * gi + 4 * hi) = pk4_fp8(oa1[4 * gi] * A8_SCALE, oa1[4 * gi + 1] * A8_SCALE, oa1[4 * gi + 2] * A8_SCALE, oa1[4 * gi + 3] * A8_SCALE); } }
    }
#undef N2_LOAD
#undef N2_STORE
}

__device__ __forceinline__ void ph_sb2(const P& p, unsigned char* lds_) {
    LAS unsigned char* lds = (LAS unsigned char*)lds_;
    int tid = threadIdx.x; asm volatile("" : "+v"(tid));
    const int lane = tid & 63, wid = __builtin_amdgcn_readfirstlane(tid >> 6), r32 = lane & 31, hi = lane >> 5;
    const int skey = tid >> 3, sch = tid & 7;
    const unsigned soff = (unsigned)(skey * 128 + sch * 16);
    const bf16* QA = WSP(bf16, A_QA); const bf16* KA = WSP(bf16, A_KA); const bf16* VA = WSP(bf16, A_VA); bf16* ATT = WSP(bf16, A_ATT);
    LAS unsigned* FLG = (LAS unsigned*)(lds + 2 * N2_SLOT);
    constexpr int NQB = S / 256, NBH = NB * 8, NUNITS = NBH * NQB;
#define N2_LOAD(Kp, Vp, row0, kreg, vreg) do { const long rb_ = (long)(row0) * 128;     \
        kreg = *(const u32x4_t*)((const char*)(Kp) + rb_ + soff); vreg = *(const u32x4_t*)((const char*)(Vp) + rb_ + soff); } while (0)
#define N2_STORE(slot, kreg, vreg) do { *(LAS u32x4_t*)(lds + (slot) * N2_SLOT + skey * 128 + ((sch ^ (skey & 7)) * 16)) = kreg; *(LAS u32x4_t*)(lds + (slot) * N2_SLOT + 8192 + skey * 128 + sch * 16) = vreg; } while (0)
    for (int unit = blockIdx.x; unit < NUNITS; unit += p.grid) {
        const int bh = unit % NBH, qb = unit / NBH, t0 = qb * 256, tw = t0 + 32 * wid, t = tw + r32;
        const long kvrow = (long)bh * S;
        bf16x8_t qr[4];
        { const bf16* qrow = QA + (kvrow + t) * 64;
#pragma unroll
          for (int ks = 0; ks < 4; ++ks) qr[ks] = *(const bf16x8_t*)(qrow + ks * 16 + hi * 8); }
        f32x16_t o0, o1;
#pragma unroll
        for (int r = 0; r < 16; ++r) { o0[r] = 0.f; o1[r] = 0.f; }
        asm volatile("" : "+v"(o0), "+v"(o1));
        float R = 0.f;
        u32x4_t kreg, vreg;
        int j = 4 * qb + 3, slot = 0, iter = 0;
        N2_LOAD(KA, VA, kvrow + 64 * j, kreg, vreg); N2_STORE(0, kreg, vreg);
        __syncthreads();
        for (;;) {
            const int jn = j - 1;
            if (jn >= 0) N2_LOAD(KA, VA, kvrow + 64 * jn, kreg, vreg);
            if (64 * j < tw + 31 && !__all(R > 175.f)) {
                f32x16_t p0, p1, s0, s1;
                n2_qk(p0, p1, lds + slot * N2_SLOT, qr, r32, hi);
                int lim = t - 64 * j - 4 * hi;
                asm volatile("" : "+v"(lim));
#pragma unroll
                for (int r = 0; r < 16; ++r) { const int kc = (r & 3) + 8 * (r >> 2);
                    { const float z = p0[r], c = __builtin_amdgcn_logf(1.0f + __builtin_amdgcn_exp2f(-fabsf(z))); const bool ok = kc < lim; s0[r] = ok ? fmaxf(z, 0.f) + c : 0.f; p0[r] = ok ? -(fmaxf(-z, 0.f) + c) : -INFINITY; }
                    { const float z = p1[r], c = __builtin_amdgcn_logf(1.0f + __builtin_amdgcn_exp2f(-fabsf(z))); const bool ok = kc + 32 < lim; s1[r] = ok ? fmaxf(z, 0.f) + c : 0.f; p1[r] = ok ? -(fmaxf(-z, 0.f) + c) : -INFINITY; } }
                float own[8], part[8], T[8];
#pragma unroll
                for (int i = 0; i < 4; ++i) { own[i] = (s0[4 * i] + s0[4 * i + 1]) + (s0[4 * i + 2] + s0[4 * i + 3]); own[4 + i] = (s1[4 * i] + s1[4 * i + 1]) + (s1[4 * i + 2] + s1[4 * i + 3]); }
#pragma unroll
                for (int i = 0; i < 8; ++i) { auto rr = __builtin_amdgcn_permlane32_swap(__float_as_uint(own[i]), __float_as_uint(own[i]), false, false); part[i] = __uint_as_float(hi ? rr[0] : rr[1]); }
                float sp = R;
#pragma unroll
                for (int i = 7; i >= 0; --i) { T[i] = sp + (hi ? 0.f : part[i]); sp += own[i] + part[i]; }
                R = sp;
#pragma unroll
                for (int i = 0; i < 4; ++i) {
                    { const float e3 = T[i], e2 = e3 + s0[4 * i + 3], e1 = e2 + s0[4 * i + 2], e0 = e1 + s0[4 * i + 1];
                      p0[4 * i] = __builtin_amdgcn_exp2f(p0[4 * i] - e0); p0[4 * i + 1] = __builtin_amdgcn_exp2f(p0[4 * i + 1] - e1); p0[4 * i + 2] = __builtin_amdgcn_exp2f(p0[4 * i + 2] - e2); p0[4 * i + 3] = __builtin_amdgcn_exp2f(p0[4 * i + 3] - e3); }
                    { const float e3 = T[4 + i], e2 = e3 + s1[4 * i + 3], e1 = e2 + s1[4 * i + 2], e0 = e1 + s1[4 * i + 1];
                      p1[4 * i] = __builtin_amdgcn_exp2f(p1[4 * i] - e0); p1[4 * i + 1] = __builtin_amdgcn_exp2f(p1[4 * i + 1] - e1); p1[4 * i + 2] = __builtin_amdgcn_exp2f(p1[4 * i + 2] - e2); p1[4 * i + 3] = __builtin_amdgcn_exp2f(p1[4 * i + 3] - e3); } }
                n2_pv(o0, o1, lds + slot * N2_SLOT + 8192, p0, p1, lane);
            }
            if (jn >= 0) N2_STORE(slot ^ 1, kreg, vreg);
            const bool wdone = __all(R > 175.f);
            if (lane == 0) FLG[(iter & 1) * 8 + wid] = wdone ? 1u : 0u;
            __syncthreads();
            if (jn < 0) break;
            unsigned nd = 0u;
#pragma unroll
            for (int w = 0; w < 8; ++w) nd += FLG[(iter & 1) * 8 + w];
            if (__builtin_amdgcn_readfirstlane((int)nd) == 8) break;
            j = jn; slot ^= 1; ++iter;
        }
        { unsigned char* orow = (unsigned char*)ATT + ((long)(bh >> 3) * S + t) * 1024 + (bh & 7) * 64;
#pragma unroll
          for (int gi = 0; gi < 4; ++gi) {
              *(unsigned*)(orow + 8 * gi + 4 * hi) = pk4_fp8(o0[4 * gi] * A8_SCALE, o0[4 * gi + 1] * A8_SCALE, o0[4 * gi + 2] * A8_SCALE, o0[4 * gi + 3] * A8_SCALE);
              *(unsigned*)(orow + 32 + 8 * gi + 4 * hi) = pk4_fp8(o1[4 * gi] * A8_SCALE, o1[4 * gi + 1] * A8_SCALE, o1[4 * gi + 2] * A8_SCALE, o1[4 * gi + 3] * A8_SCALE); } }
    }
#undef N2_LOAD
#undef N2_STORE
}

__device__ __forceinline__ float gelu_fast(float v) { const float u = 0.7978845608028654f * (v + 0.044715f * v * v * v); return v * __builtin_amdgcn_rcpf(1.0f + __builtin_amdgcn_exp2f(-2.8853900817779268f * u)); }
__device__ __forceinline__ float xhalf_other(float v) { float a = v, b = v; asm volatile("s_nop 4\n\tv_permlane32_swap_b32 %0, %1\n\ts_nop 4" : "+v"(a), "+v"(b)); return (threadIdx.x & 32) ? a : b; }
__device__ __forceinline__ void xhalf_other8(const float (&v)[8], float (&o)[8]) {
    float a0 = v[0], a1 = v[1], a2 = v[2], a3 = v[3], a4 = v[4], a5 = v[5], a6 = v[6], a7 = v[7], b0 = a0, b1 = a1, b2 = a2, b3 = a3, b4 = a4, b5 = a5, b6 = a6, b7 = a7;
    asm volatile("s_nop 4\n\tv_permlane32_swap_b32 %0, %8\n\tv_permlane32_swap_b32 %1, %9\n\tv_permlane32_swap_b32 %2, %10\n\tv_permlane32_swap_b32 %3, %11\n\tv_permlane32_swap_b32 %4, %12\n\tv_permlane32_swap_b32 %5, %13\n\tv_permlane32_swap_b32 %6, %14\n\tv_permlane32_swap_b32 %7, %15\n\ts_nop 4"
                 : "+v"(a0), "+v"(a1), "+v"(a2), "+v"(a3), "+v"(a4), "+v"(a5), "+v"(a6), "+v"(a7), "+v"(b0), "+v"(b1), "+v"(b2), "+v"(b3), "+v"(b4), "+v"(b5), "+v"(b6), "+v"(b7));
    const bool up = (threadIdx.x & 32) != 0;
    o[0] = up ? a0 : b0; o[1] = up ? a1 : b1; o[2] = up ? a2 : b2; o[3] = up ? a3 : b3; o[4] = up ? a4 : b4; o[5] = up ? a5 : b5; o[6] = up ? a6 : b6; o[7] = up ? a7 : b7;
}
constexpr int S5B_ROW = 72, S5B_IMG = 128 * S5B_ROW, S5B_LDS_PER = S5B_IMG + 8192 + 4096 + 2048;
constexpr int S5B_SIDE = 4 * S5B_LDS_PER;
__device__ __forceinline__ float opq(float v) { asm("" : "+v"(v)); return v; }
__device__ __forceinline__ void ph_s5b(const P& p, unsigned char* lds_, bf16* YS) {
    int tid = threadIdx.x; asm volatile("" : "+v"(tid));
    const int lane = tid & 63, wid = __builtin_amdgcn_readfirstlane(tid >> 6), r32 = lane & 31, hi = lane >> 5;
    LAS unsigned char* HB = (LAS unsigned char*)lds_ + wid * S5B_LDS_PER;
    const bf16* U = WSP(bf16, C_U);
    const bf16* BT = WSP(bf16, O_S5BT); const bf16* CTB = WSP(bf16, O_S5CT); const float* APW = WSP(float, O_S5AP);
    const LAS unsigned char* hrd = HB + (8 * hi + ((lane & 15) >> 2)) * S5B_ROW + (((lane >> 4) & 1) * 16 + (lane & 3) * 4) * 2;
    for (int item = blockIdx.x * 4 + wid; wid < 4 && item < NB * NG; item += p.grid * 4) {
        const int g = item % NG; const long b = item / NG;
        const bf16* btp = BT + ((long)g * 128 + r32) * 16 + 8 * hi;
        const bf16* cfp = CTB + ((long)g * 32 + r32) * 128 + 8 * hi;
        LAS unsigned char* CF = HB + S5B_IMG + lane * 16;
#pragma unroll
        for (int ks = 0; ks < 8; ++ks) *(LAS bf16x8_t*)(CF + ks * 1024) = *(const bf16x8_t*)(cfp + 16 * ks);
#pragma unroll
        for (int ct = 0; ct < 4; ++ct) *(LAS bf16x8_t*)(CF + 8192 + ct * 1024) = *(const bf16x8_t*)(btp + ct * 512);
        *(LAS f32x4_t*)(CF + 8192 + 4096) = *(const f32x4_t*)(p.in[I_DSK] + g * 16 + 4 * hi); *(LAS f32x4_t*)(CF + 8192 + 4096 + 1024) = *(const f32x4_t*)(p.in[I_DSK] + g * 16 + 8 + 4 * hi);
        asm volatile("s_waitcnt vmcnt(0) lgkmcnt(0)" ::: "memory");
        float ap[2][8];
#pragma unroll
        for (int s = 0; s < 2; ++s)
#pragma unroll
            for (int k = 0; k < 8; ++k) ap[s][k] = APW[((long)g * 64 + 32 * s + r32) * 8 + k];
        float hs[2][2] = {{0.f, 0.f}, {0.f, 0.f}};
        const bf16* urow = U + ((long)b * S + r32) * DM + g * 16;
        bf16x8_t uf = *(const bf16x8_t*)(urow + 8 * hi);
        bf16x8_t btf[4];
#pragma unroll
        for (int ct = 0; ct < 4; ++ct) btf[ct] = *(const LAS bf16x8_t*)(CF + 8192 + ct * 1024);
        f32x16_t z16;
#pragma unroll
        for (int r = 0; r < 16; ++r) z16[r] = 0.f;
        asm volatile("" : "+v"(z16));
        unsigned pend0 = 0u, pend1 = 0u; unsigned char* pend_row = (unsigned char*)YS;
#pragma nounroll
        for (int c = 0; c < S / 32; ++c) {
            const bf16* ucur = urow + (long)c * 32 * DM;
            const int cn = (c + 1 < S / 32) ? c + 1 : c;
            const u32x2_t uq0 = *(const u32x2_t*)(ucur + 4 * hi), uq1 = *(const u32x2_t*)(ucur + 8 + 4 * hi);
            const bf16x8_t ufn = *(const bf16x8_t*)(urow + (long)cn * 32 * DM + 8 * hi);
            if (c > 0) { *(unsigned*)(pend_row + 4 * hi) = pend0; *(unsigned*)(pend_row + 8 + 4 * hi) = pend1; }
            f32x16_t x[4];
#pragma unroll
            for (int ct = 0; ct < 4; ++ct) x[ct] = __builtin_amdgcn_mfma_f32_32x32x16_bf16(uf, btf[ct], z16, 0, 0, 0);
#pragma unroll
            for (int s = 0; s < 2; ++s) {
                f32x16_t& xr = x[s]; f32x16_t& xi = x[2 + s];
                const float ar = ap[s][0], ai = ap[s][1], a4r = ap[s][6], a4i = ap[s][7];
                float er[4], ei[4], pr[4], pi[4], cgr[4], cgi[4];
#pragma unroll
                for (int gi = 0; gi < 4; ++gi) {
#pragma unroll
                    for (int k = 1; k < 4; ++k) { const float nr = opq(__builtin_fmaf(-ai, xi[4 * gi + k - 1], opq(__builtin_fmaf(ar, xr[4 * gi + k - 1], xr[4 * gi + k])))), ni = opq(__builtin_fmaf(ai, xr[4 * gi + k - 1], opq(__builtin_fmaf(ar, xi[4 * gi + k - 1], xi[4 * gi + k])))); xr[4 * gi + k] = nr; xi[4 * gi + k] = ni; }
                    er[gi] = xr[4 * gi + 3]; ei[gi] = xi[4 * gi + 3]; }
#pragma unroll
                for (int gi = 0; gi < 4; ++gi) { pr[gi] = 0.f; pi[gi] = 0.f; }
                { const float vin[8] = {er[0], er[1], er[2], er[3], ei[0], ei[1], ei[2], ei[3]}; float vout[8]; xhalf_other8(vin, vout);
#pragma unroll
                  for (int gi = 0; gi < 4; ++gi) { pr[gi] = vout[gi]; pi[gi] = vout[4 + gi]; } }
                float cr = hs[s][0], ci = hs[s][1];
#pragma unroll
                for (int gi = 0; gi < 4; ++gi) {
                    const float evr = hi ? pr[gi] : er[gi], evi = hi ? pi[gi] : ei[gi], odr = hi ? er[gi] : pr[gi], odi = hi ? ei[gi] : pi[gi];
                    const float c0r = cr, c0i = ci;
                    float nr = opq(__builtin_fmaf(-a4i, ci, opq(__builtin_fmaf(a4r, cr, evr)))), ni = opq(__builtin_fmaf(a4i, cr, opq(__builtin_fmaf(a4r, ci, evi)))); cr = nr; ci = ni;
                    cgr[gi] = hi ? cr : c0r; cgi[gi] = hi ? ci : c0i;
                    nr = opq(__builtin_fmaf(-a4i, ci, opq(__builtin_fmaf(a4r, cr, odr)))); ni = opq(__builtin_fmaf(a4i, cr, opq(__builtin_fmaf(a4r, ci, odi)))); cr = nr; ci = ni; }
                hs[s][0] = cr; hs[s][1] = ci;
#pragma unroll
                for (int gi = 0; gi < 4; ++gi)
#pragma unroll
                    for (int k = 0; k < 4; ++k) { const float pwr = ap[s][2 * k], pwi = ap[s][2 * k + 1]; xr[4 * gi + k] = opq(__builtin_fmaf(-pwi, cgi[gi], opq(__builtin_fmaf(pwr, cgr[gi], xr[4 * gi + k])))); xi[4 * gi + k] = opq(__builtin_fmaf(pwi, cgr[gi], opq(__builtin_fmaf(pwr, cgi[gi], xi[4 * gi + k])))); }
            }
#pragma unroll
            for (int ct = 0; ct < 4; ++ct)
#pragma unroll
                for (int gi = 0; gi < 4; ++gi) { u32x2_t w; w.x = cvtpk(x[ct][4 * gi], x[ct][4 * gi + 1]); w.y = cvtpk(x[ct][4 * gi + 2], x[ct][4 * gi + 3]); *(LAS u32x2_t*)(HB + (32 * ct + r32) * S5B_ROW + (8 * gi + 4 * hi) * 2) = w; }
            const f32x4_t dka = *(const LAS f32x4_t*)(CF + 8192 + 4096), dkb = *(const LAS f32x4_t*)(CF + 8192 + 4096 + 1024);
            asm volatile("s_waitcnt lgkmcnt(0)" ::: "memory");
            f32x16_t y;
#pragma unroll
            for (int ks = 0; ks < 8; ++ks) {
                const s16x4_t lo = __builtin_bit_cast(s16x4_t, __builtin_amdgcn_ds_read_tr16_b64_v4i16((LAS s16x4_t*)(hrd + (16 * ks) * S5B_ROW)));
                const s16x4_t hh = __builtin_bit_cast(s16x4_t, __builtin_amdgcn_ds_read_tr16_b64_v4i16((LAS s16x4_t*)(hrd + (16 * ks + 4) * S5B_ROW)));
                const bf16x8_t hf = (bf16x8_t){lo[0], lo[1], lo[2], lo[3], hh[0], hh[1], hh[2], hh[3]};
                const bf16x8_t cfk = *(const LAS bf16x8_t*)(CF + ks * 1024);
                y = __builtin_amdgcn_mfma_f32_32x32x16_bf16(cfk, hf, ks == 0 ? z16 : y, 0, 0, 0); }
#pragma unroll
            for (int ct = 0; ct < 4; ++ct) btf[ct] = *(const LAS bf16x8_t*)(CF + 8192 + ct * 1024);
            asm volatile("s_waitcnt lgkmcnt(0)" ::: "memory");
            { unsigned char* yrow = (unsigned char*)YS + ((long)b * S + c * 32 + r32) * DM + g * 16; float dk[8];
              { dk[0] = dka[0]; dk[1] = dka[1]; dk[2] = dka[2]; dk[3] = dka[3]; dk[4] = dkb[0]; dk[5] = dkb[1]; dk[6] = dkb[2]; dk[7] = dkb[3]; }
              const float u0 = bf2f((bf16)(uq0.x & 0xffffu)), u1 = bf2f((bf16)(uq0.x >> 16)), u2 = bf2f((bf16)(uq0.y & 0xffffu)), u3 = bf2f((bf16)(uq0.y >> 16));
              const float u4 = bf2f((bf16)(uq1.x & 0xffffu)), u5 = bf2f((bf16)(uq1.x >> 16)), u6 = bf2f((bf16)(uq1.y & 0xffffu)), u7 = bf2f((bf16)(uq1.y >> 16));
              pend0 = pk4_fp8(gelu_fast(y[0] + dk[0] * u0) * A8_SCALE, gelu_fast(y[1] + dk[1] * u1) * A8_SCALE, gelu_fast(y[2] + dk[2] * u2) * A8_SCALE, gelu_fast(y[3] + dk[3] * u3) * A8_SCALE);
              pend1 = pk4_fp8(gelu_fast(y[4] + dk[4] * u4) * A8_SCALE, gelu_fast(y[5] + dk[5] * u5) * A8_SCALE, gelu_fast(y[6] + dk[6] * u6) * A8_SCALE, gelu_fast(y[7] + dk[7] * u7) * A8_SCALE); pend_row = yrow; }
            uf = ufn;
        }
        *(unsigned*)(pend_row + 4 * hi) = pend0; *(unsigned*)(pend_row + 8 + 4 * hi) = pend1;
    }
}
#endif


#ifndef HOST_EMU
__device__ __forceinline__ void ph_xpose8(const XposeJob j, unsigned char* lds_, int rank = -1, int nranks = 0) {
    LAS unsigned char* tile = (LAS unsigned char*)lds_;
    int tid = threadIdx.x; asm volatile("" : "+v"(tid));
    const int tk = j.K / 64, tn = j.Ncover / 256, per = tk * tn;
    if (rank < 0) { rank = ((int)blockIdx.x - j.first + j.grid) % j.grid; nranks = j.grid; }
    for (int item = rank; item < per * j.batch; item += nranks) {
        const int bt = item / per, it = item % per, k0 = (it / tn) * 64, n0 = (it % tn) * 256;
        const float* src = j.src + (long)bt * j.sstride + (long)k0 * j.N + n0; unsigned char* dst = (unsigned char*)j.dst + (long)bt * j.dstride + k0;
#pragma unroll
        for (int i = 0; i < 2; ++i) { const int e = tid + 512 * i, k4 = (e >> 6) * 4, n4 = (e & 63) * 4;
            float4 q0 = make_float4(0.f, 0.f, 0.f, 0.f), q1 = q0, q2 = q0, q3 = q0;
            if (n0 + n4 < j.N) { q0 = *(const float4*)(src + (long)(k4 + 0) * j.N + n4); q1 = *(const float4*)(src + (long)(k4 + 1) * j.N + n4); q2 = *(const float4*)(src + (long)(k4 + 2) * j.N + n4); q3 = *(const float4*)(src + (long)(k4 + 3) * j.N + n4); }
            *(LAS unsigned*)(tile + (n4 + 0) * 80 + k4) = pk4_fp8(q0.x * W8_SCALE, q1.x * W8_SCALE, q2.x * W8_SCALE, q3.x * W8_SCALE);
            *(LAS unsigned*)(tile + (n4 + 1) * 80 + k4) = pk4_fp8(q0.y * W8_SCALE, q1.y * W8_SCALE, q2.y * W8_SCALE, q3.y * W8_SCALE);
            *(LAS unsigned*)(tile + (n4 + 2) * 80 + k4) = pk4_fp8(q0.z * W8_SCALE, q1.z * W8_SCALE, q2.z * W8_SCALE, q3.z * W8_SCALE);
            *(LAS unsigned*)(tile + (n4 + 3) * 80 + k4) = pk4_fp8(q0.w * W8_SCALE, q1.w * W8_SCALE, q2.w * W8_SCALE, q3.w * W8_SCALE); }
        __syncthreads();
#pragma unroll
        for (int i = 0; i < 2; ++i) { const int e = tid + 512 * i, nn = e >> 2, c16 = (e & 3) * 16, n = n0 + nn; const long row = (long)(n / j.il) * j.il2 + (n % j.il) + j.add;
            *(u32x4_t*)(dst + row * j.K + c16) = *(const LAS u32x4_t*)(tile + nn * 80 + c16); }
        __syncthreads();
    }
}
__device__ __forceinline__ void xpose_wave8(const XposeJob j, LAS unsigned char* tl, int wave_rank, int n_waves, int lane) {
    const int tk = j.K / 64, tn = j.Ncover / 64, per = tk * tn;
    for (int item = wave_rank; item < per * j.batch; item += n_waves) {
        const int bt = item / per, it = item % per, k0 = (it / tn) * 64, n0 = (it % tn) * 64;
        const float* src = j.src + (long)bt * j.sstride + (long)k0 * j.N + n0; unsigned char* dst = (unsigned char*)j.dst + (long)bt * j.dstride + k0;
#pragma unroll
        for (int i = 0; i < 4; ++i) { const int e = lane + 64 * i, k4 = (e >> 4) * 4, n4 = (e & 15) * 4;
            const float4 q0 = *(const float4*)(src + (long)(k4 + 0) * j.N + n4), q1 = *(const float4*)(src + (long)(k4 + 1) * j.N + n4), q2 = *(const float4*)(src + (long)(k4 + 2) * j.N + n4), q3 = *(const float4*)(src + (long)(k4 + 3) * j.N + n4);
            *(LAS unsigned*)(tl + (n4 + 0) * 80 + k4) = pk4_fp8(q0.x * W8_SCALE, q1.x * W8_SCALE, q2.x * W8_SCALE, q3.x * W8_SCALE);
            *(LAS unsigned*)(tl + (n4 + 1) * 80 + k4) = pk4_fp8(q0.y * W8_SCALE, q1.y * W8_SCALE, q2.y * W8_SCALE, q3.y * W8_SCALE);
            *(LAS unsigned*)(tl + (n4 + 2) * 80 + k4) = pk4_fp8(q0.z * W8_SCALE, q1.z * W8_SCALE, q2.z * W8_SCALE, q3.z * W8_SCALE);
            *(LAS unsigned*)(tl + (n4 + 3) * 80 + k4) = pk4_fp8(q0.w * W8_SCALE, q1.w * W8_SCALE, q2.w * W8_SCALE, q3.w * W8_SCALE); }
        asm volatile("s_waitcnt lgkmcnt(0)" ::: "memory");
#pragma unroll
        for (int i = 0; i < 4; ++i) { const int e = lane + 64 * i, nn = e >> 2, c16 = (e & 3) * 16, n = n0 + nn; const long row = (long)(n / j.il) * j.il2 + (n % j.il) + j.add;
            *(u32x4_t*)(dst + row * j.K + c16) = *(const LAS u32x4_t*)(tl + nn * 80 + c16); }
        asm volatile("s_waitcnt lgkmcnt(0)" ::: "memory");
    }
}
__device__ __forceinline__ void xpose_wave(const XposeJob j, LAS unsigned char* tl, int wave_rank, int n_waves, int lane) {
    const int tk = j.K / 64, tn = j.Ncover / 64, per = tk * tn;
    for (int item = wave_rank; item < per * j.batch; item += n_waves) {
        const int bt = item / per, it = item % per, k0 = (it / tn) * 64, n0 = (it % tn) * 64;
        const float* src = j.src + (long)bt * j.sstride + (long)k0 * j.N + n0; bf16* dst = j.dst + (long)bt * j.dstride + k0;
#pragma unroll
        for (int i = 0; i < 4; ++i) { const int e = lane + 64 * i, k4 = (e >> 4) * 4, n4 = (e & 15) * 4;
            const float4 q0 = *(const float4*)(src + (long)(k4 + 0) * j.N + n4), q1 = *(const float4*)(src + (long)(k4 + 1) * j.N + n4), q2 = *(const float4*)(src + (long)(k4 + 2) * j.N + n4), q3 = *(const float4*)(src + (long)(k4 + 3) * j.N + n4);
            u32x2_t w;
            w.x = (unsigned)f2bf(q0.x) | ((unsigned)f2bf(q1.x) << 16); w.y = (unsigned)f2bf(q2.x) | ((unsigned)f2bf(q3.x) << 16); *(LAS u32x2_t*)(tl + ((n4 + 0) * 72 + k4) * 2) = w;
            w.x = (unsigned)f2bf(q0.y) | ((unsigned)f2bf(q1.y) << 16); w.y = (unsigned)f2bf(q2.y) | ((unsigned)f2bf(q3.y) << 16); *(LAS u32x2_t*)(tl + ((n4 + 1) * 72 + k4) * 2) = w;
            w.x = (unsigned)f2bf(q0.z) | ((unsigned)f2bf(q1.z) << 16); w.y = (unsigned)f2bf(q2.z) | ((unsigned)f2bf(q3.z) << 16); *(LAS u32x2_t*)(tl + ((n4 + 2) * 72 + k4) * 2) = w;
            w.x = (unsigned)f2bf(q0.w) | ((unsigned)f2bf(q1.w) << 16); w.y = (unsigned)f2bf(q2.w) | ((unsigned)f2bf(q3.w) << 16); *(LAS u32x2_t*)(tl + ((n4 + 3) * 72 + k4) * 2) = w; }
        asm volatile("s_waitcnt lgkmcnt(0)" ::: "memory");
#pragma unroll 4
        for (int i = 0; i < 8; ++i) { const int e = lane + 64 * i, nn = e >> 3, c8 = (e & 7) * 8, n = n0 + nn; const long row = (long)(n / j.il) * j.il2 + (n % j.il) + j.add;
            *(u32x4_t*)(dst + row * j.K + c8) = *(const LAS u32x4_t*)(tl + (nn * 72 + c8) * 2); }
        asm volatile("s_waitcnt lgkmcnt(0)" ::: "memory");
    }
}
template <int L> __device__ __forceinline__ void ph_xpose_side(const P& p, unsigned char* lds_) {
    int tid = threadIdx.x; asm volatile("" : "+v"(tid));
    const int lane = tid & 63, wid = __builtin_amdgcn_readfirstlane(tid >> 6);
    if (wid < 4) return;
    LAS unsigned char* tl = (LAS unsigned char*)lds_ + S5B_SIDE + (wid - 4) * 9216;
    const int wr_ = (int)blockIdx.x * 4 + (wid - 4), nw = p.grid * 4; constexpr int mi = MOE_IN0[L];
    xpose_wave8(mk_xpose(p.in[mi + 2], WSP(bf16, O_WT_GU), DM, 256, 256, GU_IL, 2 * GU_IL, 0, 64, (long)DM * 256, (long)512 * DM), tl, wr_, nw, lane);
    xpose_wave8(mk_xpose(p.in[mi + 3], WSP(bf16, O_WT_GU), DM, 256, 256, GU_IL, 2 * GU_IL, GU_IL, 64, (long)DM * 256, (long)512 * DM), tl, wr_, nw, lane);
    xpose_wave8(mk_xpose(p.in[mi + 4], WSP(bf16, O_WT_D), 256, DM, DM, DM, 0, 0, 64, (long)256 * DM, (long)DM * 256), tl, wr_, nw, lane);
}
static_assert(S5B_SIDE + 4 * 9216 <= GEMM_LDS, "s5 side lds");
#endif
constexpr int ROUTE_LDS = 256 * 72 * 4 + 128 * 4 + 256 * 6 * 4;
constexpr int MEGA_LDS_PH = GEMM_LDS;
static_assert(MEGA_LDS_PH >= 2 * NSA_LDS_PER && MEGA_LDS_PH >= 8 * S5_LDS_PER && MEGA_LDS_PH >= 2 * LN_LDS_PER && MEGA_LDS_PH >= ROUTE_LDS && MEGA_LDS_PH >= 256 * 72 * 2, "LDS map");
constexpr int MEGA_LDS = MEGA_LDS_PH + 256 + GEMM_TE_LDS;

#ifndef HOST_EMU
__device__ __forceinline__ void ph_te_load(const int* te, unsigned char* lds_) {
    int t2 = threadIdx.x; asm volatile("" : "+v"(t2));
    for (int i = t2; i < MOE_TILES; i += NTHR) *(LAS int*)((LAS unsigned char*)lds_ + GEMM_LDS + 4 * i) = te[i];
    __syncthreads();
}
#endif
template <int L, int CH> __device__ __forceinline__ void moe_chunk(PROGRAM_ARGS) {
    bf16* const PREB = (L == 0) ? (bf16*)p.out : WSP(bf16, O_H2);
    const int mi = MOE_IN0[L]; const bf16* hin = WSP(bf16, O_H);
    PHASE_BEGIN ph_place(p, L, CH, lds); PHASE_END
#ifndef HOST_EMU
    PHASE_BEGIN { GemmArgs g = mk_gemm(WSP(bf16, B_H8), DM / 2, WSP(bf16, O_WT_GU), MOE_ROWS, 512, DM / 2); g.rowidx = WSP(int, B_ROWTOK); g.tile_e = WSP(int, O_TILEE); g.m_rt = WSP(int, O_PADSTART) + 64; g.b_estride = (long)512 * DM / 2; EpiSwiglu8 e{WSP(unsigned char, B_AEX)}; ph_te_load(WSP(int, O_TILEE), lds); ph_gemm<EpiSwiglu8, true, true>(g, e, lds); } PHASE_END
    PHASE_BEGIN { GemmArgs g = mk_gemm(WSP(bf16, B_AEX), 128, WSP(bf16, O_WT_D), MOE_ROWS, DM, 128); g.tile_e = WSP(int, O_TILEE); g.m_rt = WSP(int, O_PADSTART) + 64; g.b_estride = (long)DM * 128; EpiY8 e{WSP(unsigned char, B_Y), DM, F8_ACC_INV}; ph_gemm<EpiY8, true, true>(g, e, lds); } PHASE_END
#else
    PHASE_BEGIN { GemmArgs g = mk_gemm(hin, DM, WSP(bf16, O_WT_GU), MOE_ROWS, 512, DM); g.rowidx = WSP(int, B_ROWTOK); g.tile_e = WSP(int, O_TILEE); g.m_rt = WSP(int, O_PADSTART) + 64; g.b_estride = (long)512 * DM; EpiSwiglu e{WSP(bf16, B_AEX)}; ph_gemm(g, e, lds); } PHASE_END
    PHASE_BEGIN { GemmArgs g = mk_gemm(WSP(bf16, B_AEX), 256, WSP(bf16, O_WT_D), MOE_ROWS, DM, 256); g.tile_e = WSP(int, O_TILEE); g.m_rt = WSP(int, O_PADSTART) + 64; g.b_estride = (long)DM * 256; EpiY e{WSP(unsigned char, B_Y), WSP(float, B_ROWGATE), DM}; ph_gemm(g, e, lds); } PHASE_END
#endif
    PHASE_BEGIN
        { LnJob j; j.grid = p.grid; j.pad = 0; j.pre = p.out; j.preb = PREB; j.y = WSP(unsigned char, B_Y); j.pos = WSP(int, B_POS); j.g = p.in[mi + 8];
#ifndef HOST_EMU
          j.gate = WSP(float, B_GATE);
#else
          j.gate = nullptr;
#endif
          j.b = p.in[mi + 9]; j.t_beg = (long)CH * TC; j.t_cnt = TC;
          j.obf = (L == 0) ? WSP(bf16, O_H2) : nullptr; j.of32 = (L == 0) ? nullptr : p.out; j.of8 = (L == 0) ? WSP(unsigned char, B_H28) : nullptr; ph_ln(j, lds); }
        if (CH + 1 < NCH) ph_route(p, L, CH + 1, lds);
    PHASE_END
}
template <int L> __device__ __forceinline__ void moe_layer(PROGRAM_ARGS) {
    bf16* const PREB = (L == 0) ? (bf16*)p.out : WSP(bf16, O_H2);
    const int mi = MOE_IN0[L]; const bf16* hin = WSP(bf16, O_H);
    PHASE_BEGIN
        { GemmArgs g = mk_gemm(hin, DM, WSP(bf16, O_WT_R) + (size_t)L * 256 * DM, T, 256, DM); EpiLogit e{WSP(float, B_LOGIT)}; ph_gemm(g, e, lds); }
#ifndef HOST_EMU
        { GemmArgs g = mk_gemm(WSP(bf16, B_H8), DM / 2, (const bf16*)(WSP(unsigned char, O_WT_SGU) + (size_t)L * 512 * DM), T, 512, DM / 2); EpiSwiglu8 e{WSP(unsigned char, B_ASH)}; ph_gemm<EpiSwiglu8, true>(g, e, lds); }
#else
        { GemmArgs g = mk_gemm(hin, DM, WSP(bf16, O_WT_SGU) + (size_t)L * 512 * DM, T, 512, DM); EpiSwiglu e{WSP(bf16, B_ASH)}; ph_gemm(g, e, lds); }
#endif
    PHASE_END
    PHASE_BEGIN
#ifndef HOST_EMU
        { GemmArgs g = mk_gemm(WSP(bf16, B_ASH), 128, (const bf16*)(WSP(unsigned char, O_WT_SD) + (size_t)L * DM * 256), T, DM, 128); EpiResBfT<true> e{p.out, PREB, hin, DM}; e.sc = F8_ACC_INV; ph_gemm<EpiResBfT<true>, true>(g, e, lds); }
#else
        { GemmArgs g = mk_gemm(WSP(bf16, B_ASH), 256, WSP(bf16, O_WT_SD) + (size_t)L * DM * 256, T, DM, 256); EpiResBfT<true> e{p.out, PREB, hin, DM}; ph_gemm(g, e, lds); }
#endif
        ph_route(p, L, 0, lds);
    PHASE_END
    (void)mi;
    moe_chunk<L, 0>(p, lds, gbar);
    if constexpr (NCH == 2) moe_chunk<L, 1>(p, lds, gbar);
}
template <int L> __device__ __forceinline__ void xpose_experts(const P& p, unsigned char* lds, int rank = -1, int nranks = 0) {
    constexpr int mi = MOE_IN0[L];
#ifndef HOST_EMU
#define XPOSE_EXP(j_) ph_xpose8(j_, lds, rank, nranks)
#else
#define XPOSE_EXP(j_) ph_xpose(j_, lds)
    (void)rank; (void)nranks;
#endif
    XPOSE_EXP(mk_xpose(p.in[mi + 2], WSP(bf16, O_WT_GU), DM, 256, 256, GU_IL, 2 * GU_IL, 0, 64, (long)DM * 256, (long)512 * DM));
    XPOSE_EXP(mk_xpose(p.in[mi + 3], WSP(bf16, O_WT_GU), DM, 256, 256, GU_IL, 2 * GU_IL, GU_IL, 64, (long)DM * 256, (long)512 * DM));
    XPOSE_EXP(mk_xpose(p.in[mi + 4], WSP(bf16, O_WT_D), 256, DM, DM, DM, 0, 0, 64, (long)256 * DM, (long)DM * 256));
#undef XPOSE_EXP
}
__device__ __forceinline__ void program(PROGRAM_ARGS) {
    bf16* const PREB = (bf16*)p.out;
    PHASE_BEGIN
        int xo = 0;
#define XP(fn_, job_) do { XposeJob j_ = job_; j_.first = xo % p.grid; xo += (j_.K / 64) * ((j_.Ncover + 255) / 256) * j_.batch; fn_(j_, lds); } while (0)
#ifndef HOST_EMU
        XP(ph_xpose8, mk_xpose(p.in[I_L0_WIN], WSP(bf16, O_WT_IN0), DM, PROJ_N, PROJ_NP, PROJ_NP, 0, 0, 1, 0, 0));
        { int t8 = threadIdx.x; asm volatile("" : "+v"(t8));
          for (long i = ((long)blockIdx.x * NTHR + t8) * 8; i < (long)T * DM; i += (long)p.grid * NTHR * 8) { const f8 a = ld_f8(p.in[I_X] + i);
              uint2 w; w.x = pk4_fp8(a.v[0] * A8_SCALE, a.v[1] * A8_SCALE, a.v[2] * A8_SCALE, a.v[3] * A8_SCALE); w.y = pk4_fp8(a.v[4] * A8_SCALE, a.v[5] * A8_SCALE, a.v[6] * A8_SCALE, a.v[7] * A8_SCALE); *(uint2*)(WSP(unsigned char, O_H) + i) = w; } }
#else
        XP(ph_xpose, mk_xpose(p.in[I_L0_WIN], WSP(bf16, O_WT_IN0), DM, PROJ_N, PROJ_NP, PROJ_NP, 0, 0, 1, 0, 0));
        ph_cvt(p, p.in[I_X], WSP(bf16, O_H), (long)T * DM);
#endif
        XP(ph_xpose, mk_xpose(p.in[I_KW1], WSP(bf16, O_WT_K1), 2048, 256, 256, 256, 0, 0, 1, 0, 0));
        XP(ph_xpose, mk_xpose(p.in[I_VW1], WSP(bf16, O_WT_V1), 2048, 256, 256, 256, 0, 0, 1, 0, 0));
#ifndef HOST_EMU
        XP(ph_xpose8, mk_xpose(p.in[I_L0_WOUT], WSP(bf16, O_WT_OUT0), 1024, DM, DM, DM, 0, 0, 1, 0, 0));
#else
        XP(ph_xpose, mk_xpose(p.in[I_L0_WOUT], WSP(bf16, O_WT_OUT0), 1024, DM, DM, DM, 0, 0, 1, 0, 0));
#endif
        XP(ph_xpose, mk_xpose(p.in[I_KW2], WSP(bf16, O_WT_K2), 256, 64, 256, 256, 0, 0, 1, 0, 0));
        XP(ph_xpose, mk_xpose(p.in[I_VW2], WSP(bf16, O_WT_K2) + 256 * 256, 256, 64, 256, 256, 0, 0, 1, 0, 0));
#pragma unroll
        for (int l = 0; l < 2; ++l) { const int mi = (l == 0) ? I_L0_ROUTER : I_L1_ROUTER;
            XP(ph_xpose, mk_xpose(p.in[mi], WSP(bf16, O_WT_R) + (size_t)l * 256 * DM, DM, 64, 256, 256, 0, 0, 1, 0, 0));
#ifndef HOST_EMU
            XP(ph_xpose8, mk_xpose(p.in[mi + 5], (bf16*)(WSP(unsigned char, O_WT_SGU) + (size_t)l * 512 * DM), DM, 256, 256, GU_IL, 2 * GU_IL, 0, 1, 0, 0));
            XP(ph_xpose8, mk_xpose(p.in[mi + 6], (bf16*)(WSP(unsigned char, O_WT_SGU) + (size_t)l * 512 * DM), DM, 256, 256, GU_IL, 2 * GU_IL, GU_IL, 1, 0, 0));
            XP(ph_xpose8, mk_xpose(p.in[mi + 7], (bf16*)(WSP(unsigned char, O_WT_SD) + (size_t)l * DM * 256), 256, DM, DM, DM, 0, 0, 1, 0, 0)); }
#else
            XP(ph_xpose, mk_xpose(p.in[mi + 5], WSP(bf16, O_WT_SGU) + (size_t)l * 512 * DM, DM, 256, 256, GU_IL, 2 * GU_IL, 0, 1, 0, 0));
            XP(ph_xpose, mk_xpose(p.in[mi + 6], WSP(bf16, O_WT_SGU) + (size_t)l * 512 * DM, DM, 256, 256, GU_IL, 2 * GU_IL, GU_IL, 1, 0, 0));
            XP(ph_xpose, mk_xpose(p.in[mi + 7], WSP(bf16, O_WT_SD) + (size_t)l * DM * 256, 256, DM, DM, DM, 0, 0, 1, 0, 0)); }
#endif
#ifndef HOST_EMU
        XP(ph_xpose8, mk_xpose(p.in[I_L1_WIN], WSP(bf16, O_WT_IN1), DM, DM, DM, DM, 0, 0, 1, 0, 0));
#else
        XP(ph_xpose, mk_xpose(p.in[I_L1_WIN], WSP(bf16, O_WT_IN1), DM, DM, DM, DM, 0, 0, 1, 0, 0));
#endif
#ifndef HOST_EMU
        XP(ph_xpose8, mk_xpose(p.in[I_WGLU], WSP(bf16, O_WT_GLU), DM, DM, DM, DM, 0, 0, 1, 0, 0));
#else
        XP(ph_xpose, mk_xpose(p.in[I_WGLU], WSP(bf16, O_WT_GLU), DM, DM, DM, DM, 0, 0, 1, 0, 0));
#endif
#ifndef HOST_EMU
        XP(ph_xpose8, mk_xpose(p.in[I_L1_WOUT], WSP(bf16, O_WT_OUT1), DM, DM, DM, DM, 0, 0, 1, 0, 0));
#else
        XP(ph_xpose, mk_xpose(p.in[I_L1_WOUT], WSP(bf16, O_WT_OUT1), DM, DM, DM, DM, 0, 0, 1, 0, 0));
#endif
#undef XP
        ph_tables(p);
#ifdef HOST_EMU
        xpose_experts<0>(p, lds);
#endif
    PHASE_END
#ifndef HOST_EMU
    PHASE_BEGIN ph_bias_finish(p); { GemmArgs g = mk_gemm(WSP(bf16, O_H), DM / 2, WSP(bf16, O_WT_IN0), T, PROJ_NP, DM / 2); EpiProj0R e{p.ws, F8_ACC_INV}; ph_gemm<EpiProj0R, true>(g, e, lds); } PHASE_END
#else
    PHASE_BEGIN { GemmArgs g = mk_gemm(WSP(bf16, O_H), DM, WSP(bf16, O_WT_IN0), T, PROJ_NP, DM); EpiProj0 e{p.ws}; ph_gemm(g, e, lds); } PHASE_END
    PHASE_BEGIN ph_rope(p); ph_bias_finish(p); PHASE_END
#endif
    PHASE_BEGIN
        static_assert(A_VC == A_KC + (size_t)NB * 2 * NCP * 1024 * 2 && O_WT_V1 == O_WT_K1 + (size_t)256 * 2048 * 2 && O_BIASV == O_BIASK + 1024 && (NB * 2 * NCP) % 256 == 0, "batched cmp GEMM: k then v, contiguous");
        { GemmArgs g = mk_gemm(WSP(bf16, A_KC), 1024, WSP(bf16, O_WT_K1), 2 * NB * 2 * NCP, 256, 2048); g.tile_e = WSP(int, O_CMPTE); g.b_estride = (long)256 * 2048; EpiCmp1 e{WSP(bf16, A_HCK), WSP(float, O_BIASK)}; ph_gemm(g, e, lds); }
        { GemmArgs g = mk_gemm(WSP(bf16, A_HCK), 256, WSP(bf16, O_WT_K2), 2 * NB * 2 * NCP, 256, 256); g.tile_e = WSP(int, O_CMPTE); g.b_estride = (long)256 * 256; EpiCmp2 e{WSP(bf16, A_KCMP), WSP(bf16, A_VCMP)}; ph_gemm(g, e, lds); }
#ifndef HOST_EMU
        { constexpr int NCW = 2 * NB * 2 * NCP / 256; if (p.grid > NCW) { if ((int)blockIdx.x >= NCW) xpose_experts<0>(p, lds, (int)blockIdx.x - NCW, p.grid - NCW); } else xpose_experts<0>(p, lds); }
#endif
    PHASE_END
#ifdef HOST_EMU
    PHASE_BEGIN ph_nsa(p, lds); ph_sb(p); PHASE_END
#else
    PHASE_BEGIN ph_nsa2(p, lds); ph_sb2(p, lds); PHASE_END
#endif
#ifndef HOST_EMU
    PHASE_BEGIN { GemmArgs g = mk_gemm(WSP(bf16, A_ATT), 512, WSP(bf16, O_WT_OUT0), T, DM, 512); EpiResF32 e{PREB, p.in[I_X], DM}; e.sc = F8_ACC_INV; ph_gemm<EpiResF32, true>(g, e, lds); } PHASE_END
#else
    PHASE_BEGIN { GemmArgs g = mk_gemm(WSP(bf16, A_ATT), 1024, WSP(bf16, O_WT_OUT0), T, DM, 1024); EpiResF32 e{PREB, p.in[I_X], DM}; ph_gemm(g, e, lds); } PHASE_END
#endif
    PHASE_BEGIN { LnJob j; j.grid = p.grid; j.pad = 0; j.pre = p.out; j.preb = PREB; j.y = nullptr; j.pos = nullptr; j.gate = nullptr; j.g = p.in[I_L0_LN1G]; j.b = p.in[I_L0_LN1B]; j.obf = WSP(bf16, O_H); j.of32 = nullptr; j.of8 = WSP(unsigned char, B_H8); j.t_beg = 0; j.t_cnt = T; ph_ln(j, lds); } PHASE_END
    moe_layer<0>(p, lds, gbar);
    PHASE_BEGIN
#ifndef HOST_EMU
        { GemmArgs g = mk_gemm(WSP(bf16, B_H28), DM / 2, WSP(bf16, O_WT_IN1), T, DM, DM / 2); EpiBf e{WSP(bf16, C_U), DM}; e.sc = F8_ACC_INV; ph_gemm<EpiBf, true>(g, e, lds); }
#else
        { GemmArgs g = mk_gemm(WSP(bf16, O_H2), DM, WSP(bf16, O_WT_IN1), T, DM, DM); EpiBf e{WSP(bf16, C_U), DM}; ph_gemm(g, e, lds); }
#endif
#ifdef HOST_EMU
        xpose_experts<1>(p, lds);
#endif
    PHASE_END
#ifdef HOST_EMU
    PHASE_BEGIN ph_s5(p, lds); PHASE_END
#else
    PHASE_BEGIN ph_s5b(p, lds, WSP(bf16, C_YS)); ph_xpose_side<1>(p, lds); PHASE_END
#endif
#ifndef HOST_EMU
    PHASE_BEGIN { GemmArgs g = mk_gemm(WSP(bf16, C_YS), DM / 2, WSP(bf16, O_WT_GLU), T, DM, DM / 2); EpiGlu8 e{WSP(unsigned char, C_Y2), WSP(unsigned char, C_YS), DM}; ph_gemm<EpiGlu8, true>(g, e, lds); } PHASE_END
    PHASE_BEGIN { GemmArgs g = mk_gemm(WSP(bf16, C_Y2), DM / 2, WSP(bf16, O_WT_OUT1), T, DM, DM / 2); EpiResBfT<true> e{p.out, PREB, WSP(bf16, O_H2), DM}; e.sc = F8_ACC_INV; ph_gemm<EpiResBfT<true>, true>(g, e, lds); } PHASE_END
#else
    PHASE_BEGIN { GemmArgs g = mk_gemm(WSP(bf16, C_YS), DM, WSP(bf16, O_WT_GLU), T, DM, DM); EpiGlu e{WSP(bf16, C_Y2), WSP(bf16, C_YS), DM}; ph_gemm(g, e, lds); } PHASE_END
    PHASE_BEGIN { GemmArgs g = mk_gemm(WSP(bf16, C_Y2), DM, WSP(bf16, O_WT_OUT1), T, DM, DM); EpiResBfT<true> e{p.out, PREB, WSP(bf16, O_H2), DM}; ph_gemm(g, e, lds); } PHASE_END
#endif
    PHASE_BEGIN { LnJob j; j.grid = p.grid; j.pad = 0; j.pre = p.out; j.preb = PREB; j.y = nullptr; j.pos = nullptr; j.gate = nullptr; j.g = p.in[I_L1_LN1G]; j.b = p.in[I_L1_LN1B]; j.obf = WSP(bf16, O_H); j.of32 = nullptr; j.of8 = WSP(unsigned char, B_H8); j.t_beg = 0; j.t_cnt = T; ph_ln(j, lds); } PHASE_END
    moe_layer<1>(p, lds, gbar);
}

#ifndef HOST_EMU
__global__ void __launch_bounds__(512, 2) mega(const P p) {
    LDS_DECL;
    if (threadIdx.x == 0) *(uint4*)lds = make_uint4(0u, 0u, 0u, 0u);
    __syncthreads();
    const XcdBarrier gbar = xcd_barrier_post((unsigned*)(p.ws + O_CTL), (volatile LAS unsigned*)lds, (unsigned)p.grid);
    program(p, lds + 256, gbar);
}
#else
static int hipMemsetAsync(void* p, int v, size_t n, hipStream_t) { memset(p, v, n); return 0; }
#endif

extern "C" void kernel_launch(void* const* d_in, const int* in_sizes, int n_in, void* d_out, int out_size, void* d_ws, size_t ws_size, hipStream_t stream) {
    (void)in_sizes; (void)out_size;
    if (n_in < 44 || ws_size < WS_NEED) return;
    P p; memset(&p, 0, sizeof(p));
    for (int i = 0; i < 44; ++i) p.in[i] = (const float*)d_in[i];
    p.out = (float*)d_out; p.ws = (unsigned char*)d_ws;
    (void)hipMemsetAsync(p.ws + O_CTL, 0, CTL_BYTES, stream);
#ifndef HOST_EMU
    static int grid = 0;
    if (!grid) {
        int dev = 0, cus = 0, per_cu = 0;
        (void)hipGetDevice(&dev);
        (void)hipDeviceGetAttribute(&cus, hipDeviceAttributeMultiprocessorCount, dev);
        (void)hipFuncSetAttribute((const void*)mega, hipFuncAttributeMaxDynamicSharedMemorySize, MEGA_LDS);
        (void)hipOccupancyMaxActiveBlocksPerMultiprocessor(&per_cu, mega, 512, MEGA_LDS);
        grid = cus * (per_cu < 1 ? per_cu : 1);
    }
    p.grid = grid;
    if (grid > 0) mega<<<grid, 512, MEGA_LDS, stream>>>(p);
#else
    e_gridDim.x = EMU_GRID; e_blockDim.x = 512; p.grid = EMU_GRID;
    program(p, g_emu_lds, 0);
#endif
}
```

```cpp
#ifndef HOST_EMU
#include <hip/hip_runtime.h>
#endif
#include <stdint.h>
#include <stddef.h>
#include <math.h>
#include <string.h>

#ifndef CFG_B
#define CFG_B 32
#define CFG_S 2048
#define CFG_D 1024
#endif

#ifdef HOST_EMU
#include <stdio.h>
#include <stdlib.h>
#define __global__
#define __device__
#define __host__
#define __forceinline__ inline
struct EmuDim { int x; };
static EmuDim e_blockIdx, e_gridDim, e_blockDim;
#define BIDX (e_blockIdx.x)
#define GDIM_OF(a_) (e_gridDim.x)
#define NTHR (e_blockDim.x)
#define PAR_BEGIN for (int tid = 0; tid < NTHR; ++tid) {
#define PAR_END }
template <class T> static inline T emu_atomic_add(T* p, T v) { T o = *p; *p = o + v; return o; }
#define ATOMIC_ADD(p, v) emu_atomic_add((p), (v))
typedef int hipStream_t;
static unsigned char g_emu_lds[163840];
#define LDS_DECL unsigned char* lds = g_emu_lds
#else
#define BIDX ((int)blockIdx.x)
#define GDIM_OF(a_) ((a_).grid)
#define NTHR 512
#define PAR_BEGIN { int tid = (int)threadIdx.x; asm volatile("" : "+v"(tid));
#define PAR_END } __syncthreads();
#define ATOMIC_ADD(p, v) atomicAdd((p), (v))
#define LDS_DECL extern __shared__ __attribute__((aligned(16))) unsigned char lds[]
#endif

typedef unsigned short bf16;

constexpr int NB = CFG_B, S = CFG_S, DM = CFG_D, T = NB * S;
constexpr int NCH = 1, TC = T / NCH;
constexpr int MOE_ROWS = ((TC * 6 + 64 * 255 + 255) / 256) * 256, MOE_TILES = MOE_ROWS / 256;
constexpr int NG = DM / 16;
constexpr int NCP = S / 16, NCMP = NCP - 1, NSLC = S / 64;
constexpr int PROJ_N = 2840, PROJ_NP = 3072;
constexpr int GU_IL = 128;
constexpr float DN_ALPHA = 1.4142135623730951f;
constexpr float LN_EPS = 1e-5f;
constexpr float QSCALE = 0.125f * 1.4426950408889634f;

constexpr size_t al256(size_t x) { return (x + 255) & ~(size_t)255; }
constexpr size_t O_CTL = 0, CTL_BYTES = 65536;
constexpr size_t O_CNT = O_CTL + 16384;
constexpr size_t O_PADSTART = O_CTL + CTL_BYTES;
constexpr size_t O_TILEE = O_PADSTART + 512;
constexpr size_t O_CMPTE = al256(O_TILEE + (size_t)MOE_TILES * 4);
constexpr size_t O_BIASK = al256(O_CMPTE + 1024);
constexpr size_t O_BIASV = O_BIASK + 1024;
constexpr size_t O_BIASP = O_BIASV + 1024;
constexpr size_t O_WT_K2 = O_BIASP + (size_t)64 * 512 * 4;
constexpr size_t O_ROPE = O_WT_K2 + (size_t)2 * 256 * 256 * 2;
constexpr size_t O_ABAR = O_ROPE + (size_t)S * 16 * 4;
constexpr size_t O_BBAR = al256(O_ABAR + (size_t)NG * 64 * 2 * 4);
constexpr size_t O_S5BT = al256(O_BBAR + (size_t)NG * 64 * 16 * 2 * 4);
constexpr size_t O_S5AP = al256(O_S5BT + (size_t)NG * 128 * 16 * 2);
constexpr size_t O_S5CT = al256(O_S5AP + (size_t)NG * 64 * 8 * 4);
constexpr size_t O_WT_IN0 = al256(O_S5CT + (size_t)NG * 32 * 128 * 2);
constexpr size_t O_WT_K1 = al256(O_WT_IN0 + (size_t)PROJ_NP * DM * 2);
constexpr size_t O_WT_V1 = O_WT_K1 + (size_t)256 * 2048 * 2;
constexpr size_t O_WT_OUT0 = O_WT_V1 + (size_t)256 * 2048 * 2;
constexpr size_t O_WT_R = al256(O_WT_OUT0 + (size_t)DM * 1024 * 2);
constexpr size_t O_WT_SGU = al256(O_WT_R + (size_t)2 * 256 * DM * 2);
constexpr size_t O_WT_SD = al256(O_WT_SGU + (size_t)2 * 512 * DM * 2);
constexpr size_t O_WT_GU = al256(O_WT_SD + (size_t)2 * DM * 256 * 2);
constexpr size_t O_WT_D = al256(O_WT_GU + (size_t)64 * 512 * DM * 2);
constexpr size_t O_WT_IN1 = al256(O_WT_D + (size_t)64 * DM * 256 * 2);
constexpr size_t O_WT_GLU = O_WT_IN1 + (size_t)DM * DM * 2;
constexpr size_t O_WT_OUT1 = O_WT_GLU + (size_t)DM * DM * 2;
constexpr size_t O_H = al256(O_WT_OUT1 + (size_t)DM * DM * 2);
constexpr size_t O_H2 = al256(O_H + (size_t)T * DM * 2);
constexpr size_t O_SCR = al256(O_H2 + (size_t)T * DM * 2);
constexpr size_t HB = (size_t)NB * 8 * S * 64 * 2, GB = (size_t)NB * 2 * S * 64 * 2;
constexpr size_t A_QA = O_SCR, A_KA = A_QA + HB, A_VA = A_KA + HB, A_QB = A_VA + HB;
constexpr size_t A_KC = A_QB + HB, A_VC = A_KC + GB, A_KS = A_VC + GB, A_VS = A_KS + GB, A_KW = A_VS + GB, A_VW = A_KW + GB;
constexpr size_t A_GRAW = A_VW + GB;
constexpr size_t A_HCK = al256(A_GRAW + (size_t)T * 24 * 4);
constexpr size_t A_HCV = A_HCK + (size_t)NB * 2 * NCP * 256 * 2;
constexpr size_t A_KCMP = A_HCV + (size_t)NB * 2 * NCP * 256 * 2;
constexpr size_t A_VCMP = A_KCMP + (size_t)NB * 2 * NCP * 64 * 4;
constexpr size_t A_ATT = al256(A_VCMP + (size_t)NB * 2 * NCP * 64 * 4);
constexpr size_t A_END = A_ATT + (size_t)T * 1024 * 2;
constexpr size_t B_EIDX = O_SCR;
constexpr size_t B_GATE = al256(B_EIDX + (size_t)T * 6 * 4);
constexpr size_t B_POS = al256(B_GATE + (size_t)T * 6 * 4);
constexpr size_t B_ROWTOK = al256(B_POS + (size_t)T * 6 * 4);
constexpr size_t B_ROWGATE = al256(B_ROWTOK + (size_t)MOE_ROWS * 4);
constexpr size_t B_AEX = al256(B_ROWGATE + (size_t)MOE_ROWS * 4);
constexpr size_t B_H8 = al256(B_AEX + (size_t)MOE_ROWS * 256);
static_assert(B_H8 + (size_t)T * DM <= B_AEX + (size_t)MOE_ROWS * 256 * 2, "h8 fits behind the fp8 AEX");
constexpr size_t B_ASH = B_AEX;
constexpr size_t B_Y = al256(B_AEX + (size_t)MOE_ROWS * 256 * 2);
constexpr size_t B_LOGIT = B_Y;
constexpr size_t B_END = B_Y + (size_t)MOE_ROWS * DM;
static_assert((size_t)T * 256 * 2 <= (size_t)MOE_ROWS * 256 * 2 && (size_t)T * 64 * 4 <= (size_t)MOE_ROWS * DM, "MoE overlays");
constexpr size_t B_H28 = B_AEX;
constexpr size_t C_U = O_SCR + ((size_t)128 << 20), C_YS = C_U + (size_t)T * DM * 2, C_Y2 = C_YS + (size_t)T * DM * 2, C_END = C_Y2 + (size_t)T * DM * 2;
static_assert(B_H28 + (size_t)T * DM <= B_H8 && B_H28 + (size_t)T * DM <= O_SCR + ((size_t)128 << 20), "h2 fp8 copy: inside the AEX half, below stage C");
constexpr size_t WS_NEED = (A_END > B_END ? (A_END > C_END ? A_END : C_END) : (B_END > C_END ? B_END : C_END)) + 4096;

__host__ __device__ __forceinline__ float bf2f(bf16 v) { unsigned u = ((unsigned)v) << 16; float f; memcpy(&f, &u, 4); return f; }
__host__ __device__ __forceinline__ bf16 f2bf(float f) { unsigned u; memcpy(&u, &f, 4); u = (u + 0x7fffu + ((u >> 16) & 1u)) >> 16; return (bf16)u; }
#ifdef HOST_EMU
__host__ __device__ __forceinline__ float sigmoidf_(float x) { return 1.0f / (1.0f + expf(-x)); }
#else
__device__ __forceinline__ float sigmoidf_(float x) { return __builtin_amdgcn_rcpf(1.0f + __builtin_amdgcn_exp2f(-1.4426950408889634f * x)); }
#endif
__host__ __device__ __forceinline__ float gelu_tanh(float x) { return 0.5f * x * (1.0f + tanhf(0.7978845608028654f * (x + 0.044715f * x * x * x))); }
__host__ __device__ __forceinline__ float siluf_(float x) { return x * sigmoidf_(x); }


constexpr float Y8_SCALE = 16.0f, Y8_INV = 1.0f / 16.0f;
__host__ __device__ __forceinline__ float fp82f(unsigned c) { const unsigned e = (c >> 3) & 15u, m = c & 7u; const float v = e ? (1.0f + (float)m * 0.125f) * exp2f((float)e - 7.0f) : (float)m * 0.001953125f; return (c & 0x80u) ? -v : v; }
#ifdef HOST_EMU
static inline unsigned f2fp8(float f) { const unsigned sg = f < 0.f ? 0x80u : 0u; float a = fabsf(f); if (!(a == a)) return 0x7fu; if (a >= 448.f) return sg | 0x7eu;
    if (a < 0.015625f) { const int q = (int)nearbyintf(a * 512.0f); return sg | (unsigned)q; }
    int e; float m = frexpf(a, &e); m *= 2.f; e -= 1; int q = (int)nearbyintf((m - 1.0f) * 8.0f); if (q == 8) { q = 0; e += 1; } unsigned c = ((unsigned)(e + 7) << 3) | (unsigned)q; if (c > 0x7eu) c = 0x7eu; return sg | c; }
#endif
struct f4 { float v[4]; };
__host__ __device__ __forceinline__ f4 ld_f4(const float* p) {
    f4 r;
#ifdef HOST_EMU
    for (int i = 0; i < 4; ++i) r.v[i] = p[i];
#else
    const float4 w = *(const float4*)p; r.v[0] = w.x; r.v[1] = w.y; r.v[2] = w.z; r.v[3] = w.w;
#endif
    return r;
}
__host__ __device__ __forceinline__ void st_bf4(bf16* p, float a, float b, float c, float d) {
#ifdef HOST_EMU
    p[0] = f2bf(a); p[1] = f2bf(b); p[2] = f2bf(c); p[3] = f2bf(d);
#else
    uint2 w; w.x = (unsigned)f2bf(a) | ((unsigned)f2bf(b) << 16); w.y = (unsigned)f2bf(c) | ((unsigned)f2bf(d) << 16); *(uint2*)p = w;
#endif
}
__host__ __device__ __forceinline__ void cp16(bf16* d, const bf16* s_) {
#ifdef HOST_EMU
    for (int i = 0; i < 8; ++i) d[i] = s_[i];
#else
    *(uint4*)d = *(const uint4*)s_;
#endif
}
struct f8 { float v[8]; };
__host__ __device__ __forceinline__ void st_bf8(bf16* p, const f8& x) {
#ifdef HOST_EMU
    for (int i = 0; i < 8; ++i) p[i] = f2bf(x.v[i]);
#else
    uint4 w; w.x = (unsigned)f2bf(x.v[0]) | ((unsigned)f2bf(x.v[1]) << 16); w.y = (unsigned)f2bf(x.v[2]) | ((unsigned)f2bf(x.v[3]) << 16);
    w.z = (unsigned)f2bf(x.v[4]) | ((unsigned)f2bf(x.v[5]) << 16); w.w = (unsigned)f2bf(x.v[6]) | ((unsigned)f2bf(x.v[7]) << 16); *(uint4*)p = w;
#endif
}
__host__ __device__ __forceinline__ f8 ld_bf8(const bf16* p) {
    f8 r;
#ifdef HOST_EMU
    for (int i = 0; i < 8; ++i) r.v[i] = bf2f(p[i]);
#else
    const uint4 w = *(const uint4*)p; r.v[0] = bf2f((bf16)(w.x & 0xffffu)); r.v[1] = bf2f((bf16)(w.x >> 16)); r.v[2] = bf2f((bf16)(w.y & 0xffffu)); r.v[3] = bf2f((bf16)(w.y >> 16));
    r.v[4] = bf2f((bf16)(w.z & 0xffffu)); r.v[5] = bf2f((bf16)(w.z >> 16)); r.v[6] = bf2f((bf16)(w.w & 0xffffu)); r.v[7] = bf2f((bf16)(w.w >> 16));
#endif
    return r;
}
__host__ __device__ __forceinline__ f8 ld_f8(const float* p) { f8 r; const f4 a = ld_f4(p), b = ld_f4(p + 4); for (int i = 0; i < 4; ++i) { r.v[i] = a.v[i]; r.v[4 + i] = b.v[i]; } return r; }
__host__ __device__ __forceinline__ void st_f8(float* p, const f8& x) {
#ifdef HOST_EMU
    for (int i = 0; i < 8; ++i) p[i] = x.v[i];
#else
    *(float4*)p = make_float4(x.v[0], x.v[1], x.v[2], x.v[3]); *(float4*)(p + 4) = make_float4(x.v[4], x.v[5], x.v[6], x.v[7]);
#endif
}


struct P {
    const float* in[44];
    float* out;
    unsigned char* ws;
    int grid, pad0, pad1, pad2;
};
#define WSP(T_, off) ((T_*)(p.ws + (off)))

enum { I_X = 0, I_L0_WIN, I_POSK, I_POSV, I_KW1, I_KW2, I_VW1, I_VW2, I_L0_WOUT, I_L0_LN1G, I_L0_LN1B,
       I_L0_ROUTER, I_L0_RBIAS, I_L0_WG, I_L0_WU, I_L0_WD, I_L0_SG, I_L0_SU, I_L0_SD, I_L0_LN2G, I_L0_LN2B,
       I_L1_WIN, I_LRE, I_LIM, I_BRE, I_BIM, I_CRE, I_CIM, I_DSK, I_LOGDT, I_WGLU, I_L1_WOUT, I_L1_LN1G, I_L1_LN1B,
       I_L1_ROUTER, I_L1_RBIAS, I_L1_WG, I_L1_WU, I_L1_WD, I_L1_SG, I_L1_SU, I_L1_SD, I_L1_LN2G, I_L1_LN2B };
constexpr int MOE_IN0[2] = { I_L0_ROUTER, I_L1_ROUTER };

struct XposeJob { const float* src; bf16* dst; int K, N, Ncover, il, il2, add, batch, grid; long sstride, dstride; int first; };
__device__ __forceinline__ void ph_xpose(const XposeJob j, unsigned char* lds) {
    bf16* tile = (bf16*)lds;
    const int tk = j.K / 64, tn = (j.Ncover + 255) / 256, per = tk * tn;
    for (int item = (BIDX - j.first + GDIM_OF(j)) % GDIM_OF(j); item < per * j.batch; item += GDIM_OF(j)) {
        const int bt = item / per, it = item % per, k0 = (it / tn) * 64, n0 = (it % tn) * 256;
        const float* src = j.src + (long)bt * j.sstride; bf16* dst = j.dst + (long)bt * j.dstride;
        PAR_BEGIN
            for (int e = tid; e < 16 * 64; e += NTHR) { const int k4 = (e >> 6) * 4, n4 = (e & 63) * 4, n = n0 + n4;
                float v[4][4];
                for (int r = 0; r < 4; ++r) { const float* row = src + (long)(k0 + k4 + r) * j.N;
                    if (n + 3 < j.N && (j.N & 3) == 0) { const f4 q = ld_f4(row + n); v[r][0] = q.v[0]; v[r][1] = q.v[1]; v[r][2] = q.v[2]; v[r][3] = q.v[3]; }
                    else for (int c = 0; c < 4; ++c) v[r][c] = (n + c < j.N) ? row[n + c] : 0.f; }
                for (int c = 0; c < 4; ++c) st_bf4(tile + (n4 + c) * 72 + k4, v[0][c], v[1][c], v[2][c], v[3][c]); }
        PAR_END
        PAR_BEGIN
            for (int e = tid; e < 256 * 8; e += NTHR) { const int nn = e >> 3, c8 = (e & 7) * 8, n = n0 + nn;
                if (n < j.Ncover) { const long row = (long)(n / j.il) * j.il2 + (n % j.il) + j.add; cp16(dst + row * j.K + k0 + c8, tile + nn * 72 + c8); } }
        PAR_END
    }
}

__device__ __forceinline__ void ph_cvt(const P& p, const float* src, bf16* dst, long n) {
    PAR_BEGIN
        for (long i = ((long)BIDX * NTHR + tid) * 8; i < n; i += (long)GDIM_OF(p) * NTHR * 8) st_bf8(dst + i, ld_f8(src + i));
    PAR_END
}

__device__ __forceinline__ void ph_tables(const P& p) {
    PAR_BEGIN
        const long gt = (long)BIDX * NTHR + tid, gs = (long)GDIM_OF(p) * NTHR;
        for (long i = gt; i < 2 * (NB * 2 * NCP / 256); i += gs) WSP(int, O_CMPTE)[i] = (i >= NB * 2 * NCP / 256) ? 1 : 0;
        for (long i = gt; i < 64 * 512; i += gs) {
            const int sl = (int)(i >> 9), which = (int)((i >> 8) & 1), c = (int)(i & 255);
            const float* pos = p.in[which ? I_POSV : I_POSK]; const float* w1 = p.in[which ? I_VW1 : I_KW1];
            float s = 0.f; for (int jx = 32 * sl; jx < 32 * sl + 32; ++jx) s += pos[jx] * w1[(long)jx * 256 + c];
            WSP(float, O_BIASP)[i] = s;
        }
        for (long i = gt; i < (long)S * 8; i += gs) { const int jx = (int)(i & 7), sp = (int)(i >> 3); const float inv = powf(500000.0f, -(float)jx / 8.0f), ang = (float)sp * inv;
            WSP(float, O_ROPE)[i * 2] = cosf(ang); WSP(float, O_ROPE)[i * 2 + 1] = sinf(ang); }
        for (long i = gt; i < (long)NG * 64; i += gs) {
            const int g = (int)(i >> 6);
            const float lre = p.in[I_LRE][i], lim = p.in[I_LIM][i], step = expf(p.in[I_LOGDT][g]);
            const float mag = expf(lre * step), are = mag * cosf(lim * step), aim = mag * sinf(lim * step);
            const float den = lre * lre + lim * lim;
            const float zre = ((are - 1.0f) * lre + aim * lim) / den, zim = (aim * lre - (are - 1.0f) * lim) / den;
            WSP(float, O_ABAR)[i * 2] = are; WSP(float, O_ABAR)[i * 2 + 1] = aim;
            const int ps = (int)(i & 63);
            for (int h = 0; h < 16; ++h) { const float br = p.in[I_BRE][i * 16 + h], bi = p.in[I_BIM][i * 16 + h]; const float bbr = zre * br - zim * bi, bbi = zre * bi + zim * br;
                WSP(float, O_BBAR)[(i * 16 + h) * 2] = bbr; WSP(float, O_BBAR)[(i * 16 + h) * 2 + 1] = bbi;
                WSP(bf16, O_S5BT)[((long)g * 128 + ps) * 16 + h] = f2bf(bbr); WSP(bf16, O_S5BT)[((long)g * 128 + 64 + ps) * 16 + h] = f2bf(bbi);
                WSP(bf16, O_S5CT)[((long)g * 32 + h) * 128 + ps] = f2bf(p.in[I_CRE][((long)g * 16 + h) * 64 + ps]); WSP(bf16, O_S5CT)[((long)g * 32 + h) * 128 + 64 + ps] = f2bf(-p.in[I_CIM][((long)g * 16 + h) * 64 + ps]);
                WSP(bf16, O_S5CT)[((long)g * 32 + 16 + h) * 128 + ps] = 0; WSP(bf16, O_S5CT)[((long)g * 32 + 16 + h) * 128 + 64 + ps] = 0; }
            { float* ap = WSP(float, O_S5AP) + i * 8; const float a2r = are * are - aim * aim, a2i = 2.f * are * aim, a3r = a2r * are - a2i * aim, a3i = a2r * aim + a2i * are, a4r = a2r * a2r - a2i * a2i, a4i = 2.f * a2r * a2i;
              ap[0] = are; ap[1] = aim; ap[2] = a2r; ap[3] = a2i; ap[4] = a3r; ap[5] = a3i; ap[6] = a4r; ap[7] = a4i; }
        }
    PAR_END
}

__device__ __forceinline__ void ph_bias_finish(const P& p) {
    PAR_BEGIN
        for (long i = (long)BIDX * NTHR + tid; i < 512; i += (long)GDIM_OF(p) * NTHR) { float s = 0.f; for (int sl = 0; sl < 64; ++sl) s += WSP(float, O_BIASP)[sl * 512 + i]; WSP(float, O_BIASK)[i] = s; }
    PAR_END
}
__device__ __forceinline__ void ph_rope(const P& p) {
    PAR_BEGIN
        const long rows_q = (long)NB * 8 * S, rows_k = (long)NB * 2 * S, total = rows_q + 3 * rows_k;
        for (long i = (long)BIDX * NTHR + tid; i < total; i += (long)GDIM_OF(p) * NTHR) {
            long row = i; bf16* base;
            if (row < rows_q) base = WSP(bf16, A_QB);
            else { row -= rows_q; const int w = (int)(row / rows_k); row -= (long)w * rows_k; base = WSP(bf16, w == 0 ? A_KC : (w == 1 ? A_KS : A_KW)); }
            const int sp = (int)(row % S); const float* cs = WSP(float, O_ROPE) + (long)sp * 16;
            bf16* r = base + row * 64; const f8 x1 = ld_bf8(r), x2 = ld_bf8(r + 8), t0 = ld_f8(cs), t1 = ld_f8(cs + 8);
            f8 o1, o2;
            for (int jx = 0; jx < 8; ++jx) { const float c = jx < 4 ? t0.v[2 * jx] : t1.v[2 * jx - 8], sn = jx < 4 ? t0.v[2 * jx + 1] : t1.v[2 * jx - 7];
                o1.v[jx] = x1.v[jx] * c - x2.v[jx] * sn; o2.v[jx] = x2.v[jx] * c + x1.v[jx] * sn; }
            st_bf8(r, o1); st_bf8(r + 8, o2);
        }
    PAR_END
}

__device__ __forceinline__ void ph_cmpw2(const P& p) {
    PAR_BEGIN
        const long rows = (long)NB * 2 * NCP, total = rows * 64 * 2;
        for (long i = (long)BIDX * NTHR + tid; i < total; i += (long)GDIM_OF(p) * NTHR) {
            const int which = (int)(i / (rows * 64)); const long r = (i / 64) % rows; const int d = (int)(i & 63);
            const bf16* hc = WSP(bf16, which ? A_HCV : A_HCK) + r * 256; const float* w2 = p.in[which ? I_VW2 : I_KW2];
            float s = 0.f; for (int c = 0; c < 256; ++c) s += bf2f(hc[c]) * w2[c * 64 + d];
            WSP(bf16, which ? A_VCMP : A_KCMP)[r * 64 + d] = f2bf(s);
        }
    PAR_END
}

__device__ __forceinline__ void ph_sb(const P& p) {
    PAR_BEGIN
        const bf16* QA = WSP(bf16, A_QA); const bf16* KA = WSP(bf16, A_KA); const bf16* VA = WSP(bf16, A_VA); bf16* ATT = WSP(bf16, A_ATT);
        for (long gq = (long)BIDX * NTHR + tid; gq < (long)NB * 8 * S; gq += (long)GDIM_OF(p) * NTHR) {
            const int t = (int)(gq % S); const long bh = gq / S; const int h = (int)(bh & 7); const long b = bh >> 3;
            float q[64], acc[64];
#pragma unroll
            for (int d = 0; d < 64; ++d) { q[d] = bf2f(QA[gq * 64 + d]) * (0.125f / QSCALE); acc[d] = 0.f; }
            float run = 0.f;
            for (int s = t - 1; s >= 0; --s) {
                const bf16* kr = KA + (bh * S + s) * 64; const bf16* vr = VA + (bh * S + s) * 64;
                float z = 0.f;
#pragma unroll
                for (int d = 0; d < 64; ++d) z += q[d] * bf2f(kr[d]);
                const float l1p = log1pf(expf(-fabsf(z)));
                const float sp_pos = fmaxf(z, 0.f) + l1p, sp_neg = fmaxf(-z, 0.f) + l1p;
                const float w = expf(run - sp_neg);
#pragma unroll
                for (int d = 0; d < 64; ++d) acc[d] += w * bf2f(vr[d]);
                run -= sp_pos;
                if (run < -120.f) break;
            }
            bf16* o = ATT + (b * S + t) * 1024 + h * 64;
#pragma unroll
            for (int d = 0; d < 64; ++d) o[d] = f2bf(acc[d]);
        }
    PAR_END
}

constexpr int NSA_LDS_PER = (4 * 64 + 4 * 512 + 4 * 64 + 64 + 64 + 32 + 16 + 16 + 16) * 4;
__device__ __forceinline__ void ph_nsa(const P& p, unsigned char* lds) {
    const int per = NTHR / 256; const long items = (long)NB * 2 * S;
    const bf16* QB = WSP(bf16, A_QB); bf16* ATT = WSP(bf16, A_ATT);
    const bf16* KCMP = WSP(bf16, A_KCMP); const bf16* VCMP = WSP(bf16, A_VCMP);
    for (long it0 = (long)BIDX * per; it0 < items; it0 += (long)GDIM_OF(p) * per) {
#define NSA_SETUP const int sub = tid >> 8, lt = tid & 255; const long item = it0 + sub; const bool act = item < items; \
        const int t = act ? (int)(item % S) : 0; const long bg = act ? item / S : 0; const int g = (int)(bg & 1); const long b = bg >> 1; \
        float* L = (float*)(lds + (size_t)sub * NSA_LDS_PER); float* qs = L; float* sc = qs + 256; float* osum = sc + 2048; float* pm = osum + 256; float* pl = pm + 64; \
        float* imp = pl + 64; int* sel = (int*)(imp + 32); float* st = (float*)(sel + 16); float* gts = st + 16; (void)lt; (void)g; (void)b; (void)t; (void)qs; (void)sc; (void)osum; (void)pm; (void)pl; (void)imp; (void)sel; (void)st; (void)gts;
#define NSA_SOFTMAX(NEXPR) \
        PAR_BEGIN NSA_SETUP if (act && lt < 64) { const int r = lt >> 4, part = lt & 15, n = (NEXPR); float m = -3e38f; \
            for (int jx = part; jx < n; jx += 16) m = fmaxf(m, sc[r * 512 + jx]); float l = 0.f; \
            for (int jx = part; jx < n; jx += 16) { const float v = sc[r * 512 + jx]; if (v > -1e29f) l += expf(v - m); } pm[lt] = m; pl[lt] = l; } PAR_END \
        PAR_BEGIN NSA_SETUP if (act && lt < 4) { float m = -3e38f; for (int q2 = 0; q2 < 16; ++q2) m = fmaxf(m, pm[lt * 16 + q2]); float l = 0.f; \
            for (int q2 = 0; q2 < 16; ++q2) { const float pmv = pm[lt * 16 + q2]; if (pmv > -1e29f) l += pl[lt * 16 + q2] * expf(pmv - m); } st[lt] = m; st[4 + lt] = l; } PAR_END \
        PAR_BEGIN NSA_SETUP if (act) { const int n = (NEXPR); for (int idx = lt; idx < 4 * n; idx += 256) { const int r = idx / n, jx = idx % n; const float v = sc[r * 512 + jx]; \
            const float l = st[4 + r]; sc[r * 512 + jx] = (v > -1e29f && l > 0.f) ? expf(v - st[r]) / l : 0.f; } } PAR_END
        PAR_BEGIN NSA_SETUP
            if (act) { const int r = lt >> 6, d = lt & 63; qs[lt] = bf2f(QB[((b * 8 + g * 4 + r) * S + t) * 64 + d]) * (0.125f / QSCALE); osum[lt] = 0.f;
                if (lt < 12) gts[lt] = sigmoidf_(WSP(float, A_GRAW)[(b * S + t) * 24 + g * 12 + lt]); }
        PAR_END
        PAR_BEGIN NSA_SETUP
            if (act) for (int idx = lt; idx < 4 * NCP; idx += 256) { const int r = idx / NCP, n = idx % NCP; float v = -1e30f;
                if (n < NCMP && 16 * n + 31 <= t) { const bf16* kr = KCMP + (bg * NCP + n) * 64; v = 0.f; for (int d = 0; d < 64; ++d) v += qs[r * 64 + d] * bf2f(kr[d]); }
                sc[r * 512 + n] = v; }
        PAR_END
        NSA_SOFTMAX(NCP)
        PAR_BEGIN NSA_SETUP
            if (act) { const int r = lt >> 6, d = lt & 63; float o = 0.f; for (int n = 0; n < NCMP; ++n) o += sc[r * 512 + n] * bf2f(VCMP[(bg * NCP + n) * 64 + d]); osum[lt] += gts[r * 3 + 0] * o; }
        PAR_END
        PAR_BEGIN NSA_SETUP
            if (act && lt < 32) { float s = 0.f; if (lt < NSLC) { const int n0 = 4 * lt - 1 < 0 ? 0 : 4 * lt - 1, n1 = 4 * lt + 3 > NCMP - 1 ? NCMP - 1 : 4 * lt + 3;
                for (int r = 0; r < 4; ++r) for (int n = n0; n <= n1; ++n) s += sc[r * 512 + n]; } imp[lt] = s; }
        PAR_END
        PAR_BEGIN NSA_SETUP
            if (act && lt == 0) { const int cur = t >> 6;
                for (int m = 0; m < NSLC; ++m) { const bool valid = m <= cur, forced = (m == 0) || (valid && m > cur - 2); imp[m] = forced ? imp[m] + 1e4f : (valid ? imp[m] : -1e30f); }
                int ns = 0;
                for (int i = 0; i < 8; ++i) { int best = 0; float bv = -3.4e38f; for (int m = 0; m < NSLC; ++m) if (imp[m] > bv) { bv = imp[m]; best = m; } imp[best] = -3.4e38f; if (best <= cur) sel[ns++] = best; }
                sel[8] = ns; }
        PAR_END
        PAR_BEGIN NSA_SETUP
            if (act) { const int n = sel[8] * 64; const bf16* KS = WSP(bf16, A_KS);
                for (int idx = lt; idx < 4 * n; idx += 256) { const int r = idx / n, jx = idx % n, pos = sel[jx >> 6] * 64 + (jx & 63); float v = -1e30f;
                    if (pos <= t) { const bf16* kr = KS + (bg * S + pos) * 64; v = 0.f; for (int d = 0; d < 64; ++d) v += qs[r * 64 + d] * bf2f(kr[d]); }
                    sc[r * 512 + jx] = v; } }
        PAR_END
        NSA_SOFTMAX(sel[8] * 64)
        PAR_BEGIN NSA_SETUP
            if (act) { const int r = lt >> 6, d = lt & 63, n = sel[8] * 64; const bf16* VS = WSP(bf16, A_VS); float o = 0.f;
                for (int jx = 0; jx < n; ++jx) { const int pos = sel[jx >> 6] * 64 + (jx & 63); o += sc[r * 512 + jx] * bf2f(VS[(bg * S + pos) * 64 + d]); }
                osum[lt] += gts[r * 3 + 1] * o; }
        PAR_END
        PAR_BEGIN NSA_SETUP
            if (act) { const bf16* KW = WSP(bf16, A_KW);
                for (int idx = lt; idx < 4 * 512; idx += 256) { const int r = idx >> 9, jx = idx & 511, pos = t - 511 + jx; float v = -1e30f;
                    if (pos >= 0) { const bf16* kr = KW + (bg * S + pos) * 64; v = 0.f; for (int d = 0; d < 64; ++d) v += qs[r * 64 + d] * bf2f(kr[d]); }
                    sc[r * 512 + jx] = v; } }
        PAR_END
        NSA_SOFTMAX(512)
        PAR_BEGIN NSA_SETUP
            if (act) { const int r = lt >> 6, d = lt & 63; const bf16* VW = WSP(bf16, A_VW); float o = 0.f;
                for (int jx = 0; jx < 512; ++jx) { const int pos = t - 511 + jx; if (pos >= 0) o += sc[r * 512 + jx] * bf2f(VW[(bg * S + pos) * 64 + d]); }
                osum[lt] += gts[r * 3 + 2] * o;
                ATT[(b * S + t) * 1024 + 512 + (g * 4 + r) * 64 + d] = f2bf(osum[lt]); }
        PAR_END
    }
}

constexpr int S5_LDS_PER = (8 * 128 + 8 * 16 + 128) * 4;
__device__ __forceinline__ void ph_s5(const P& p, unsigned char* lds) {
    const int per = NTHR / 64; const long items = (long)NB * NG;
    const bf16* U = WSP(bf16, C_U); bf16* YS = WSP(bf16, C_YS);
    const float* ABAR = WSP(float, O_ABAR); const float* BBAR = WSP(float, O_BBAR);
    for (long it0 = (long)BIDX * per; it0 < items; it0 += (long)GDIM_OF(p) * per) {
#define S5_SETUP const int sub = tid >> 6, lt = tid & 63; const long item = it0 + sub; const bool act = item < items; const int g = act ? (int)(item % NG) : 0; const long b = act ? item / NG : 0; \
        float* L = (float*)(lds + (size_t)sub * S5_LDS_PER); float* hbuf = L; float* ubuf = hbuf + 1024; float* hst = ubuf + 128; (void)lt; (void)g; (void)b; (void)hbuf; (void)ubuf; (void)hst;
        PAR_BEGIN S5_SETUP if (act) { hst[lt] = 0.f; hst[64 + lt] = 0.f; } PAR_END
        for (int t0 = 0; t0 < S; t0 += 8) {
            PAR_BEGIN S5_SETUP
                if (act) for (int e = lt; e < 128; e += 64) ubuf[e] = bf2f(U[(b * S + t0 + (e >> 4)) * DM + g * 16 + (e & 15)]);
            PAR_END
            PAR_BEGIN S5_SETUP
                if (act) { const long gp = (long)g * 64 + lt; const float are = ABAR[gp * 2], aim = ABAR[gp * 2 + 1]; float bre[16], bim[16];
#pragma unroll
                    for (int h = 0; h < 16; ++h) { bre[h] = BBAR[(gp * 16 + h) * 2]; bim[h] = BBAR[(gp * 16 + h) * 2 + 1]; }
                    float hr = hst[lt], hi = hst[64 + lt];
                    for (int i = 0; i < 8; ++i) { float ur = 0.f, ui = 0.f;
#pragma unroll
                        for (int h = 0; h < 16; ++h) { const float u = ubuf[i * 16 + h]; ur += u * bre[h]; ui += u * bim[h]; }
                        const float nr = are * hr - aim * hi + ur, ni = are * hi + aim * hr + ui; hr = nr; hi = ni;
                        hbuf[i * 128 + lt] = hr; hbuf[i * 128 + 64 + lt] = hi; }
                    hst[lt] = hr; hst[64 + lt] = hi; }
            PAR_END
            PAR_BEGIN S5_SETUP
                if (act) { const int hh = lt & 15, iq = lt >> 4; const float* cre = p.in[I_CRE] + ((long)g * 16 + hh) * 64; const float* cim = p.in[I_CIM] + ((long)g * 16 + hh) * 64;
                    const float dsk = p.in[I_DSK][g * 16 + hh];
                    for (int i = iq * 2; i < iq * 2 + 2; ++i) { float y = 0.f;
                        for (int pp = 0; pp < 64; ++pp) y += cre[pp] * hbuf[i * 128 + pp] - cim[pp] * hbuf[i * 128 + 64 + pp];
                        y += dsk * ubuf[i * 16 + hh];
                        YS[(b * S + t0 + i) * DM + g * 16 + hh] = f2bf(gelu_tanh(y)); } }
            PAR_END
        }
    }
}

__device__ __forceinline__ void ph_route(const P& p, const int layer, const int chunk, unsigned char* lds) {
    const int NT_ = 256; float* rb = (float*)lds;
    int* hist = (int*)(rb + (size_t)NT_ * 72); int* base = hist + 64; int* lr = base + 64;
    const float* LOGIT = WSP(float, B_LOGIT); const float* rbias = p.in[layer == 0 ? I_L0_RBIAS : I_L1_RBIAS];
    int* gcnt = WSP(int, O_CNT) + (layer * NCH + chunk) * 64;
    const long tbeg = (long)chunk * TC;
    for (long t0 = (long)BIDX * NT_; t0 < TC; t0 += (long)GDIM_OF(p) * NT_) {
        PAR_BEGIN if (tid < 64) hist[tid] = 0; PAR_END
        PAR_BEGIN
            const long tl = t0 + tid;
            if (tid < NT_ && tl < TC) { const long tok = tbeg + tl; float* sb = rb + (size_t)tid * 72; float* gs = sb + 64;
                for (int e = 0; e < 64; ++e) sb[e] = sigmoidf_(LOGIT[tok * 64 + e]) + rbias[e];
                for (int gq = 0; gq < 8; ++gq) { float m1 = -3e38f, m2 = -3e38f; for (int jx = 0; jx < 8; ++jx) { const float v = sb[gq * 8 + jx]; if (v > m1) { m2 = m1; m1 = v; } else if (v > m2) m2 = v; } gs[gq] = m1 + m2; }
                unsigned keep = 0u;
                for (int i = 0; i < 4; ++i) { int best = 0; float bv = -3.4e38f; for (int gq = 0; gq < 8; ++gq) if (!((keep >> gq) & 1u) && gs[gq] > bv) { bv = gs[gq]; best = gq; } keep |= 1u << best; }
                unsigned long long taken = 0ull; int ei[6]; float gv[6]; float gsum = 0.f;
#pragma unroll
                for (int i = 0; i < 6; ++i) { int best = 0; float bv = -3.4e38f;
                    for (int e = 0; e < 64; ++e) if (((keep >> (e >> 3)) & 1u) && !((taken >> e) & 1ull) && sb[e] > bv) { bv = sb[e]; best = e; }
                    taken |= 1ull << best; ei[i] = best; gv[i] = sb[best] - rbias[best]; gsum += gv[i]; }
#pragma unroll
                for (int i = 0; i < 6; ++i) { WSP(int, B_EIDX)[tok * 6 + i] = ei[i]; WSP(float, B_GATE)[tok * 6 + i] = gv[i] / gsum * 2.5f; lr[tid * 6 + i] = ATOMIC_ADD(&hist[ei[i]], 1); }
            }
        PAR_END
        PAR_BEGIN if (tid < 64) base[tid] = ATOMIC_ADD(&gcnt[tid], hist[tid]); PAR_END
        PAR_BEGIN
            const long tl = t0 + tid;
            if (tid < NT_ && tl < TC) { const long tok = tbeg + tl; for (int i = 0; i < 6; ++i) WSP(int, B_POS)[tok * 6 + i] = base[WSP(int, B_EIDX)[tok * 6 + i]] + lr[tid * 6 + i]; }
        PAR_END
    }
}

__device__ __forceinline__ void ph_offsets(const P& p, const int layer, const int chunk) {
    if (BIDX == 0) {
    const int* gcnt = WSP(int, O_CNT) + (layer * NCH + chunk) * 64; int* ps = WSP(int, O_PADSTART); int* te = WSP(int, O_TILEE);
    PAR_BEGIN if (tid == 0) { int acc = 0; for (int e = 0; e < 64; ++e) { ps[e] = acc; acc += (gcnt[e] + 255) / 256 * 256; } ps[64] = acc; } PAR_END
    PAR_BEGIN for (int i = tid; i < MOE_TILES; i += NTHR) { const int r = i * 256; int e = -1; if (r < ps[64]) { e = 0; while (ps[e + 1] <= r) ++e; } te[i] = e; } PAR_END
    }
}
__device__ __forceinline__ void ph_clear_rows(const P& p) {
    PAR_BEGIN for (long i = (long)BIDX * NTHR + tid; i < MOE_ROWS; i += (long)GDIM_OF(p) * NTHR) { WSP(int, B_ROWTOK)[i] = 0; WSP(float, B_ROWGATE)[i] = 0.f; } PAR_END
}
__device__ __forceinline__ void ph_scatter(const P& p, const int chunk) {
    PAR_BEGIN
        const int* ps = WSP(int, O_PADSTART);
        for (long i = (long)BIDX * NTHR + tid; i < (long)TC * 6; i += (long)GDIM_OF(p) * NTHR) { const long gi = (long)chunk * TC * 6 + i;
            const int e = WSP(int, B_EIDX)[gi], dest = ps[e] + WSP(int, B_POS)[gi];
            WSP(int, B_ROWTOK)[dest] = (int)(gi / 6); WSP(float, B_ROWGATE)[dest] = WSP(float, B_GATE)[gi]; WSP(int, B_POS)[gi] = dest; }
    PAR_END
}


__device__ __forceinline__ void ph_place(const P& p, const int layer, const int chunk, unsigned char* lds) {
    const int* gcnt = WSP(int, O_CNT) + (layer * NCH + chunk) * 64; int* psl = (int*)lds;
    PAR_BEGIN if (tid == 0) { int acc = 0; for (int e = 0; e < 64; ++e) { const int c = gcnt[e]; psl[e] = acc; psl[65 + e] = c; acc += (c + 255) / 256 * 256; } psl[64] = acc; } PAR_END
    PAR_BEGIN
        for (long i = (long)BIDX * NTHR + tid; i < (long)TC * 6; i += (long)GDIM_OF(p) * NTHR) { const long gi = (long)chunk * TC * 6 + i;
            const int e = WSP(int, B_EIDX)[gi], dest = psl[e] + WSP(int, B_POS)[gi];
            WSP(int, B_ROWTOK)[dest] = (int)(gi / 6); WSP(float, B_ROWGATE)[dest] = WSP(float, B_GATE)[gi]; WSP(int, B_POS)[gi] = dest; }
        for (long i = (long)BIDX * NTHR + tid; i < 64 * 256; i += (long)GDIM_OF(p) * NTHR) { const int e = (int)(i >> 8), k = (int)(i & 255), row = psl[e] + psl[65 + e] + k;
            if (row < psl[e + 1]) { WSP(int, B_ROWTOK)[row] = 0; WSP(float, B_ROWGATE)[row] = 0.f; } }
        if (BIDX == 0) { int* ps = WSP(int, O_PADSTART); int* te = WSP(int, O_TILEE);
            for (int i = tid; i < 65; i += NTHR) ps[i] = psl[i];
            for (int i = tid; i < MOE_TILES; i += NTHR) { const int r = i * 256; int e = -1; if (r < psl[64]) { e = 0; while (psl[e + 1] <= r) ++e; } te[i] = e; } }
    PAR_END
}
struct LnJob { const float* pre; const bf16* preb; const unsigned char* y; const int* pos; const float* gate; const float* g; const float* b; bf16* obf; float* of32; unsigned char* of8; long t_beg, t_cnt; int grid, pad; };
constexpr int LN_LDS_PER = (DM + 64) * 4;
__device__ __forceinline__ void ph_ln(const LnJob j, unsigned char* lds) {
    const int per = NTHR / 256;
    for (long r0 = (long)BIDX * per; r0 < j.t_cnt; r0 += (long)GDIM_OF(j) * per) {
#define LN_SETUP const int sub = tid >> 8, lt = tid & 255; const long rl = r0 + sub; const bool act = rl < j.t_cnt; const long tok = j.t_beg + (act ? rl : 0); \
        float* vals = (float*)(lds + (size_t)sub * LN_LDS_PER); float* red = vals + DM; (void)lt; (void)tok; (void)red;
        PAR_BEGIN LN_SETUP
            if (act) for (int c = lt; c < DM; c += 256) { float v = j.preb ? bf2f(j.preb[tok * DM + c]) : j.pre[tok * DM + c]; if (j.y) { float ys = 0.f; for (int k = 0; k < 6; ++k) ys += fp82f(j.y[(long)j.pos[tok * 6 + k] * DM + c]); v += ys * Y8_INV; } vals[c] = v; }
        PAR_END
        PAR_BEGIN LN_SETUP if (act && lt < 16) { float s = 0.f; for (int c = lt * (DM / 16); c < (lt + 1) * (DM / 16); ++c) s += vals[c]; red[lt] = s; } PAR_END
        PAR_BEGIN LN_SETUP if (act && lt == 0) { float s = 0.f; for (int i = 0; i < 16; ++i) s += red[i]; red[32] = s / (float)DM; } PAR_END
        PAR_BEGIN LN_SETUP if (act && lt < 16) { const float mu = red[32]; float s = 0.f; for (int c = lt * (DM / 16); c < (lt + 1) * (DM / 16); ++c) { const float d = vals[c] - mu; s += d * d; } red[lt] = s; } PAR_END
        PAR_BEGIN LN_SETUP if (act && lt == 0) { float s = 0.f; for (int i = 0; i < 16; ++i) s += red[i]; red[33] = 1.0f / sqrtf(s / (float)DM + LN_EPS); } PAR_END
        PAR_BEGIN LN_SETUP
            if (act) { const float mu = red[32], rs = red[33];
                for (int c = lt; c < DM; c += 256) { const float o = (vals[c] - mu) * rs * j.g[c] + j.b[c]; if (j.obf) j.obf[tok * DM + c] = f2bf(o); else j.of32[tok * DM + c] = o; } }
        PAR_END
    }
}


#ifndef HOST_EMU
constexpr float W8_SCALE = 64.0f, A8_SCALE = 8.0f, F8_ACC_INV = 1.0f / (W8_SCALE * A8_SCALE);
__device__ __forceinline__ float clamp8(float x) { return __builtin_amdgcn_fmed3f(x, -448.0f, 448.0f); }
__device__ __forceinline__ unsigned pk4_fp8(float a, float b, float c, float d) { int w = __builtin_amdgcn_cvt_pk_fp8_f32(clamp8(a), clamp8(b), 0, false); w = __builtin_amdgcn_cvt_pk_fp8_f32(clamp8(c), clamp8(d), w, true); return (unsigned)w; }
__device__ __forceinline__ float wave_sum(float v) {
    v += __builtin_bit_cast(float, __builtin_amdgcn_mov_dpp(__builtin_bit_cast(int, v), 0xB1, 0xf, 0xf, true));
    v += __builtin_bit_cast(float, __builtin_amdgcn_mov_dpp(__builtin_bit_cast(int, v), 0x4E, 0xf, 0xf, true));
    v += __builtin_bit_cast(float, __builtin_amdgcn_ds_swizzle(__builtin_bit_cast(int, v), 0x101F));
    v += __builtin_bit_cast(float, __builtin_amdgcn_ds_swizzle(__builtin_bit_cast(int, v), 0x201F));
    v += __builtin_bit_cast(float, __builtin_amdgcn_ds_swizzle(__builtin_bit_cast(int, v), 0x401F));
    auto rr = __builtin_amdgcn_permlane32_swap(__float_as_uint(v), __float_as_uint(v), false, false);
    return __uint_as_float(rr[0]) + __uint_as_float(rr[1]); }
__device__ __forceinline__ void ph_ln2(const LnJob j) {
    static_assert(DM == 1024, "ln2: a lane owns 16 consecutive columns; a wave takes two adjacent rows per pass (their loads overlap)");
    int tid = threadIdx.x; asm volatile("" : "+v"(tid));
    const int lane = tid & 63, wid = __builtin_amdgcn_readfirstlane(tid >> 6);
    for (long r = ((long)blockIdx.x * 8 + wid) * 2; r < j.t_cnt; r += (long)j.grid * 16) {
        int c0 = lane * 16; asm volatile("" : "+v"(c0));
        const long tok0 = j.t_beg + r; float v[2][16]; int yrow[2][6];
#pragma unroll
        for (int u = 0; u < 2; ++u) { const long o = (tok0 + u) * DM + c0;
            if (j.y) {
#pragma unroll
                for (int k = 0; k < 6; ++k) yrow[u][k] = j.pos[(tok0 + u) * 6 + k]; }
            if (j.preb) { const f8 a = ld_bf8(j.preb + o), b = ld_bf8(j.preb + o + 8);
#pragma unroll
                for (int q = 0; q < 8; ++q) { v[u][q] = a.v[q]; v[u][8 + q] = b.v[q]; } }
            else { const f8 a = ld_f8(j.pre + o), b = ld_f8(j.pre + o + 8);
#pragma unroll
                for (int q = 0; q < 8; ++q) { v[u][q] = a.v[q]; v[u][8 + q] = b.v[q]; } } }
        if (j.y) {
#pragma unroll
            for (int kb = 0; kb < 6; kb += 3) {
                uint4 w[2][3]; float gk[2][3];
#pragma unroll
                for (int u = 0; u < 2; ++u)
#pragma unroll
                    for (int k = 0; k < 3; ++k) { w[u][k] = *(const uint4*)(j.y + (long)yrow[u][kb + k] * DM + c0); gk[u][k] = j.gate ? j.gate[(tok0 + u) * 6 + kb + k] * Y8_INV : Y8_INV; }
#pragma unroll
                for (int u = 0; u < 2; ++u)
#pragma unroll
                    for (int k = 0; k < 3; ++k) { const unsigned ww[4] = {w[u][k].x, w[u][k].y, w[u][k].z, w[u][k].w};
#pragma unroll
                        for (int q = 0; q < 4; ++q) { const auto lo = __builtin_amdgcn_cvt_pk_f32_fp8((int)ww[q], false), hi2 = __builtin_amdgcn_cvt_pk_f32_fp8((int)ww[q], true);
                            v[u][4 * q] += lo[0] * gk[u][k]; v[u][4 * q + 1] += lo[1] * gk[u][k]; v[u][4 * q + 2] += hi2[0] * gk[u][k]; v[u][4 * q + 3] += hi2[1] * gk[u][k]; } }
            }
        }
        int c0b = lane * 16; asm volatile("" : "+v"(c0b));
        const f8 g0 = ld_f8(j.g + c0b), g1 = ld_f8(j.g + c0b + 8), b0 = ld_f8(j.b + c0b), b1 = ld_f8(j.b + c0b + 8);
#pragma unroll
        for (int u = 0; u < 2; ++u) {
            float s = 0.f;
#pragma unroll
            for (int i = 0; i < 16; ++i) s += v[u][i];
            const float mu = wave_sum(s) * (1.0f / (float)DM);
            float q2 = 0.f;
#pragma unroll
            for (int i = 0; i < 16; ++i) { const float d = v[u][i] - mu; q2 += d * d; }
            const float rs = 1.0f / sqrtf(wave_sum(q2) * (1.0f / (float)DM) + LN_EPS);
            f8 o0, o1;
#pragma unroll
            for (int q = 0; q < 8; ++q) { o0.v[q] = (v[u][q] - mu) * rs * g0.v[q] + b0.v[q]; o1.v[q] = (v[u][8 + q] - mu) * rs * g1.v[q] + b1.v[q]; }
            const long o = (tok0 + u) * DM + c0;
            if (j.obf) { st_bf8(j.obf + o, o0); st_bf8(j.obf + o + 8, o1); } else { st_f8(j.of32 + o, o0); st_f8(j.of32 + o + 8, o1); }
            if (j.of8) { uint4 w8; w8.x = pk4_fp8(o0.v[0] * A8_SCALE, o0.v[1] * A8_SCALE, o0.v[2] * A8_SCALE, o0.v[3] * A8_SCALE); w8.y = pk4_fp8(o0.v[4] * A8_SCALE, o0.v[5] * A8_SCALE, o0.v[6] * A8_SCALE, o0.v[7] * A8_SCALE);
                w8.z = pk4_fp8(o1.v[0] * A8_SCALE, o1.v[1] * A8_SCALE, o1.v[2] * A8_SCALE, o1.v[3] * A8_SCALE); w8.w = pk4_fp8(o1.v[4] * A8_SCALE, o1.v[5] * A8_SCALE, o1.v[6] * A8_SCALE, o1.v[7] * A8_SCALE); *(uint4*)(j.of8 + o) = w8; }
        }
    }
}
#define ph_ln(j, lds) ph_ln2(j)
#endif

struct GemmArgs { const bf16* A; const bf16* Bt; const int* rowidx; const int* tile_e; const int* m_rt; long lda; long b_estride; int M, N, K, grid; };
constexpr int GEMM_LDS = 131072, GEMM_TE_LDS = 8192;
static_assert(MOE_TILES <= 2048, "tile table");
struct EpiProj0 { static constexpr bool HAS_LD = false; unsigned char* ws;
    __device__ __forceinline__ void oct(int row, int col, const f8& v, const f8&) const {
        if (col >= PROJ_N) return; const long b = row / S, s = row % S;
        if (col < 2048) { const int seg = col >> 9, h = (col >> 6) & 7, d = col & 63; bf16* base = (bf16*)(ws + A_QA + (size_t)seg * HB); const float sc = (seg == 3 || seg == 0) ? QSCALE : 1.0f;
            f8 o; for (int i = 0; i < 8; ++i) o.v[i] = v.v[i] * sc; st_bf8(base + ((b * 8 + h) * S + s) * 64 + d, o); }
        else if (col < 2816) { const int c2 = col - 2048, seg = c2 >> 7, g = (c2 >> 6) & 1, d = c2 & 63; bf16* base = (bf16*)(ws + A_KC + (size_t)seg * GB); st_bf8(base + ((b * 2 + g) * S + s) * 64 + d, v); }
        else st_f8((float*)(ws + A_GRAW) + (long)row * 24 + (col - 2816), v); } };
#ifndef HOST_EMU
struct EpiProj0R { static constexpr bool HAS_LD = false; unsigned char* ws; float asc;
    __device__ __forceinline__ void oct(int row, int col, const f8& v0, const f8&) const {
        if (col >= PROJ_N) return; const long b = row / S, s = row % S;
        f8 v; for (int i = 0; i < 8; ++i) v.v[i] = v0.v[i] * asc;
        f8 x = v;
        const bool rs = (col >= 1536 && col < 2048) || (col >= 2048 && col < 2816 && ((((col - 2048) >> 7) & 1) == 0));
        if (rs && (col & 32) == 0) {
            f8 pv; for (int i = 0; i < 8; ++i) pv.v[i] = __builtin_bit_cast(float, __builtin_amdgcn_ds_swizzle(__builtin_bit_cast(int, v.v[i]), 0x401F));
            if ((col & 16) == 0) { const float* cs = (const float*)(ws + O_ROPE) + s * 16; const f8 t0 = ld_f8(cs), t1 = ld_f8(cs + 8); const float sg = (col & 8) ? 1.0f : -1.0f;
                for (int jx = 0; jx < 8; ++jx) { const float c = jx < 4 ? t0.v[2 * jx] : t1.v[2 * jx - 8], sn = jx < 4 ? t0.v[2 * jx + 1] : t1.v[2 * jx - 7]; x.v[jx] = v.v[jx] * c + sg * pv.v[jx] * sn; } } }
        if (col < 2048) { const int seg = col >> 9, h = (col >> 6) & 7, d = col & 63; bf16* base = (bf16*)(ws + A_QA + (size_t)seg * HB); const float sc = (seg == 3 || seg == 0) ? QSCALE : 1.0f;
            f8 o; for (int i = 0; i < 8; ++i) o.v[i] = x.v[i] * sc; st_bf8(base + ((b * 8 + h) * S + s) * 64 + d, o); }
        else if (col < 2816) { const int c2 = col - 2048, seg = c2 >> 7, g = (c2 >> 6) & 1, d = c2 & 63; bf16* base = (bf16*)(ws + A_KC + (size_t)seg * GB); st_bf8(base + ((b * 2 + g) * S + s) * 64 + d, x); }
        else st_f8((float*)(ws + A_GRAW) + (long)row * 24 + (col - 2816), x); } };
#endif
struct EpiCmp1 { static constexpr bool HAS_LD = true; bf16* out; const float* bias;
    __device__ __forceinline__ f8 ld(int row, int col) const { return ld_f8(bias + (row >= NB * 2 * NCP ? 256 : 0) + col); }
    __device__ __forceinline__ void fin(int row, int col, const f8& v, const f8&, const f8& bv) const { f8 o; for (int i = 0; i < 8; ++i) o.v[i] = gelu_tanh(v.v[i] + bv.v[i]); st_bf8(out + (long)row * 256 + col, o); }
    __device__ __forceinline__ void oct(int row, int col, const f8& v, const f8& v2) const { fin(row, col, v, v2, ld(row, col)); } };
struct EpiCmp2 { static constexpr bool HAS_LD = false; bf16* outk; bf16* outv;
    __device__ __forceinline__ void oct(int row, int col, const f8& v, const f8&) const { if (col < 64) { bf16* o = row >= NB * 2 * NCP ? outv + (long)(row - NB * 2 * NCP) * 64 : outk + (long)row * 64; st_bf8(o + col, v); } } };
struct EpiResF32 { static constexpr bool HAS_LD = true; bf16* out; const float* res; int ld_; float sc = 1.0f;
    __device__ __forceinline__ f8 ld(int row, int col) const { return ld_f8(res + (long)row * ld_ + col); }
    __device__ __forceinline__ void fin(int row, int col, const f8& v, const f8&, const f8& r) const { f8 o; for (int i = 0; i < 8; ++i) o.v[i] = DN_ALPHA * r.v[i] + v.v[i] * sc; st_bf8(out + (long)row * ld_ + col, o); }
    __device__ __forceinline__ void oct(int row, int col, const f8& v, const f8& v2) const { fin(row, col, v, v2, ld(row, col)); } };
template <bool OUT_BF> struct EpiResBfT { static constexpr bool HAS_LD = true; float* out; bf16* outb; const bf16* res; int ld_; float sc = 1.0f;
    __device__ __forceinline__ f8 ld(int row, int col) const { return ld_bf8(res + (long)row * ld_ + col); }
    __device__ __forceinline__ void fin(int row, int col, const f8& v, const f8&, const f8& r) const { f8 o; for (int i = 0; i < 8; ++i) o.v[i] = DN_ALPHA * r.v[i] + v.v[i] * sc;
        if (OUT_BF) st_bf8(outb + (long)row * ld_ + col, o); else st_f8(out + (long)row * ld_ + col, o); }
    __device__ __forceinline__ void oct(int row, int col, const f8& v, const f8& v2) const { fin(row, col, v, v2, ld(row, col)); } };
struct EpiLogit { static constexpr bool HAS_LD = false; float* out;
    __device__ __forceinline__ void oct(int row, int col, const f8& v, const f8&) const { if (col < 64) st_f8(out + (long)row * 64 + col, v); } };
struct EpiSwiglu { static constexpr bool HAS_LD = false; bf16* out;
    __device__ __forceinline__ void oct(int row, int col, const f8& v, const f8& v2) const { if ((col & GU_IL) == 0) { f8 o; for (int i = 0; i < 8; ++i) o.v[i] = siluf_(v.v[i]) * v2.v[i];
        st_bf8(out + (long)row * 256 + (col >> 8) * GU_IL + (col & (GU_IL - 1)), o); } } };
#ifndef HOST_EMU
struct EpiSwiglu8 { static constexpr bool HAS_LD = false; unsigned char* out;
    __device__ __forceinline__ void oct(int row, int col, const f8& v, const f8& v2) const { if ((col & GU_IL) == 0) { float o[8]; for (int i = 0; i < 8; ++i) o[i] = siluf_(v.v[i] * F8_ACC_INV) * (v2.v[i] * (F8_ACC_INV * A8_SCALE));
        uint2 w; w.x = pk4_fp8(o[0], o[1], o[2], o[3]); w.y = pk4_fp8(o[4], o[5], o[6], o[7]); *(uint2*)(out + (long)row * 256 + (col >> 8) * GU_IL + (col & (GU_IL - 1))) = w; } } };
#endif
#ifndef HOST_EMU
struct EpiY8 { static constexpr bool HAS_LD = false; unsigned char* out; int ld_; float sc;
    __device__ __forceinline__ void oct(int row, int col, const f8& v, const f8&) const { const float f = Y8_SCALE * sc;
        uint2 w; w.x = pk4_fp8(v.v[0] * f, v.v[1] * f, v.v[2] * f, v.v[3] * f); w.y = pk4_fp8(v.v[4] * f, v.v[5] * f, v.v[6] * f, v.v[7] * f); *(uint2*)(out + (long)row * ld_ + col) = w; } };
#endif
struct EpiY { static constexpr bool HAS_LD = true; unsigned char* out; const float* rowgate; int ld_; float sc = 1.0f;
    __device__ __forceinline__ f8 ld(int row, int) const { f8 r; r.v[0] = rowgate[row]; for (int i = 1; i < 8; ++i) r.v[i] = 0.f; return r; }
    __device__ __forceinline__ void fin(int row, int col, const f8& v, const f8&, const f8& rg) const { const float gt = rg.v[0] * (Y8_SCALE * sc); unsigned char* o = out + (long)row * ld_ + col;
#ifdef HOST_EMU
        for (int i = 0; i < 8; ++i) o[i] = (unsigned char)f2fp8(v.v[i] * gt);
#else
        int w0 = __builtin_amdgcn_cvt_pk_fp8_f32(v.v[0] * gt, v.v[1] * gt, 0, false); w0 = __builtin_amdgcn_cvt_pk_fp8_f32(v.v[2] * gt, v.v[3] * gt, w0, true);
        int w1 = __builtin_amdgcn_cvt_pk_fp8_f32(v.v[4] * gt, v.v[5] * gt, 0, false); w1 = __builtin_amdgcn_cvt_pk_fp8_f32(v.v[6] * gt, v.v[7] * gt, w1, true);
        uint2 w; w.x = (unsigned)w0; w.y = (unsigned)w1; *(uint2*)o = w;
#endif
    }
    __device__ __forceinline__ void oct(int row, int col, const f8& v, const f8& v2) const { fin(row, col, v, v2, ld(row, col)); } };
struct EpiBf { static constexpr bool HAS_LD = false; bf16* out; int ld; float sc = 1.0f;
    __device__ __forceinline__ void oct(int row, int col, const f8& v, const f8&) const { f8 o; for (int i = 0; i < 8; ++i) o.v[i] = v.v[i] * sc; st_bf8(out + (long)row * ld + col, o); } };
#ifndef HOST_EMU
struct EpiGlu8 { static constexpr bool HAS_LD = true; unsigned char* out; const unsigned char* ys; int ld_; int pad = 0;
    __device__ __forceinline__ f8 ld(int row, int col) const { const uint2 w = *(const uint2*)(ys + (long)row * ld_ + col); f8 r;
        const auto a0 = __builtin_amdgcn_cvt_pk_f32_fp8((int)w.x, false), a1 = __builtin_amdgcn_cvt_pk_f32_fp8((int)w.x, true), a2 = __builtin_amdgcn_cvt_pk_f32_fp8((int)w.y, false), a3 = __builtin_amdgcn_cvt_pk_f32_fp8((int)w.y, true);
        r.v[0] = a0[0]; r.v[1] = a0[1]; r.v[2] = a1[0]; r.v[3] = a1[1]; r.v[4] = a2[0]; r.v[5] = a2[1]; r.v[6] = a3[0]; r.v[7] = a3[1]; return r; }
    __device__ __forceinline__ void fin(int row, int col, const f8& v, const f8&, const f8& y) const { float o[8]; for (int i = 0; i < 8; ++i) o[i] = y.v[i] * sigmoidf_(v.v[i] * F8_ACC_INV);
        uint2 w; w.x = pk4_fp8(o[0], o[1], o[2], o[3]); w.y = pk4_fp8(o[4], o[5], o[6], o[7]); *(uint2*)(out + (long)row * ld_ + col) = w; }
    __device__ __forceinline__ void oct(int row, int col, const f8& v, const f8& v2) const { fin(row, col, v, v2, ld(row, col)); } };
#endif
struct EpiGlu { static constexpr bool HAS_LD = true; bf16* out; const bf16* ys; int ld_; int pad = 0;
    __device__ __forceinline__ f8 ld(int row, int col) const { return ld_bf8(ys + (long)row * ld_ + col); }
    __device__ __forceinline__ void fin(int row, int col, const f8& v, const f8&, const f8& y) const { f8 o; for (int i = 0; i < 8; ++i) o.v[i] = y.v[i] * sigmoidf_(v.v[i]); st_bf8(out + (long)row * ld_ + col, o); }
    __device__ __forceinline__ void oct(int row, int col, const f8& v, const f8& v2) const { fin(row, col, v, v2, ld(row, col)); } };

struct Unit { int pm, pn; };
struct StaticOrder {
    int nM, nN, nwg, G, c;
    __host__ __device__ void init(int M, int N, int G_, int c_) { nM = M / 256; nN = N / 256; nwg = nM * nN; G = G_; c = c_; }
    __host__ __device__ bool next(int i, Unit& u) const {
        const long L = (long)i * G + c; if (L >= nwg) return false;
        int wgid = (int)L; { const int q = nwg / 8, r = nwg % 8, xcd = wgid % 8, off = wgid / 8; wgid = (xcd < r ? xcd * (q + 1) : r * (q + 1) + (xcd - r) * q) + off; }
        const int nig = 8 * nN, gid = wgid / nig, fm = gid * 8, gsz = (nM - fm) < 8 ? (nM - fm) : 8;
        u.pm = fm + ((wgid % nig) % gsz); u.pn = (wgid % nig) / gsz; return true;
    }
};

#ifndef HOST_EMU
typedef short bf16x8_t __attribute__((ext_vector_type(8)));
typedef float f32x4_t __attribute__((ext_vector_type(4)));
#define LAS __attribute__((address_space(3)))
constexpr int HTB = 128 * 64 * 2;
__device__ __forceinline__ int lds_byte(int r, int c) { const int st = (r >> 4) * 2 + (c >> 5), rr = r & 15, cc = c & 31, ob = rr * 64 + cc * 2; return st * 1024 + (ob ^ (((ob >> 9) & 1) << 5)); }
__device__ __forceinline__ void stage_rc(int b, int& R, int& C) { const int st = b / 1024, sb = b % 1024, swz = sb ^ (((sb >> 9) & 1) << 5); R = (st >> 1) * 16 + swz / 64; C = (st & 1) * 32 + (swz % 64) / 2; }

typedef int i32x4_t __attribute__((ext_vector_type(4)));
typedef int i32x8_t __attribute__((ext_vector_type(8)));
template <class Epi, bool F8 = false, bool TE_LDS = false>
__device__ __forceinline__ void ph_gemm(const GemmArgs g, const Epi E, unsigned char* lds_) {
    LAS unsigned char* lds = (LAS unsigned char*)lds_;
    int tid = threadIdx.x; asm volatile("" : "+v"(tid));
    const int wid = __builtin_amdgcn_readfirstlane(tid >> 6), lane = tid & 63, wr = wid >> 2, wc = wid & 3, fr = lane & 15, fq = lane >> 4;
    const int K = g.K, nt = K / 64;
    const int Mrt = g.m_rt ? __builtin_amdgcn_readfirstlane(*g.m_rt) : g.M;
    StaticOrder S; S.init(Mrt, g.N, g.grid, (int)blockIdx.x);
    int RA[2]; unsigned CA2[2], voffB[2];
#pragma unroll
    for (int i = 0; i < 2; ++i) { int R, C; stage_rc(tid * 16 + i * 8192, R, C); RA[i] = R; CA2[i] = (unsigned)C * 2u;
        const int rho = R & 31, Rb = (R & ~31) + 8 * ((rho & 15) >> 2) + 4 * (rho >> 4) + (rho & 3);
        voffB[i] = (unsigned)(Rb * K + C) * 2u; }
    const size_t kstep = 128;
    const size_t hstepB = (size_t)128 * K * 2, tstepB = 2 * hstepB;
    const unsigned lda2 = (unsigned)g.lda * 2u;
    const unsigned ldsw = (unsigned)wid * 1024u;
    const int aoff = lds_byte(wr * 64 + fr, fq * 8), boff = lds_byte(wc * 32 + fr, fq * 8);
    const char* gA = (const char*)g.A;
#define PG8_SA(b, h) (((b) * 2 + (h)) * HTB)
#define PG8_SB(b, h) ((4 + (b) * 2 + (h)) * HTB)
#define PG8_STAGE_B(bufoff, gbase) do { _Pragma("unroll") for (int _i = 0; _i < 2; ++_i) \
        __builtin_amdgcn_global_load_lds((const unsigned*)((const char*)(gbase) + voffB[_i]), (LAS unsigned*)(lds + (bufoff) + ldsw + _i * 8192), 16, 0, 0); } while (0)
#define PG8_STAGE_A(bufoff, kbase, o0, o1) do { \
        __builtin_amdgcn_global_load_lds((const unsigned*)((kbase) + (o0)), (LAS unsigned*)(lds + (bufoff) + ldsw), 16, 0, 0); \
        __builtin_amdgcn_global_load_lds((const unsigned*)((kbase) + (o1)), (LAS unsigned*)(lds + (bufoff) + ldsw + 8192), 16, 0, 0); } while (0)
#define PG8_LDA(dst, b, h) do { _Pragma("unroll") for (int m = 0; m < 4; ++m) { dst[m].lo = *(const LAS i32x4_t*)(lds + PG8_SA(b, h) + aoff + m * 2048); dst[m].hi = *(const LAS i32x4_t*)(lds + PG8_SA(b, h) + aoff + m * 2048 + 1024); } } while (0)
#define PG8_LDB(dst, b, h) do { _Pragma("unroll") for (int n = 0; n < 2; ++n) { dst[n].lo = *(const LAS i32x4_t*)(lds + PG8_SB(b, h) + boff + n * 2048); dst[n].hi = *(const LAS i32x4_t*)(lds + PG8_SB(b, h) + boff + n * 2048 + 1024); } } while (0)
#define F8_SC 0
#define PG8_MMA(ai, bj, At, Bt) do { __builtin_amdgcn_s_setprio(1); \
        if constexpr (F8) { _Pragma("unroll") for (int m = 0; m < 4; ++m) _Pragma("unroll") for (int n = 0; n < 2; ++n) \
            asm volatile("v_mfma_f32_16x16x128_f8f6f4 %0, %1, %2, %0" : "+v"(acc[ai][bj][m][n]) : "v"(Bt[n]), "v"(At[m])); } \
        else { _Pragma("unroll") for (int m = 0; m < 4; ++m) _Pragma("unroll") for (int n = 0; n < 2; ++n) _Pragma("unroll") for (int k = 0; k < 2; ++k) \
            acc[ai][bj][m][n] = __builtin_amdgcn_mfma_f32_16x16x32_bf16(__builtin_bit_cast(bf16x8_t, k ? Bt[n].hi : Bt[n].lo), __builtin_bit_cast(bf16x8_t, k ? At[m].hi : At[m].lo), acc[ai][bj][m][n], 0, 0, 0); } \
        __builtin_amdgcn_s_setprio(0); } while (0)
#define PG8_WAIT_V(n) asm volatile("s_waitcnt vmcnt(" #n ")" ::: "memory")
#define PG8_WAIT_L(n) asm volatile("s_waitcnt lgkmcnt(" #n ")" ::: "memory")
#define PG8_BAR __builtin_amdgcn_s_barrier()
#define PG8_SCHED __builtin_amdgcn_sched_barrier(0)
#define PG8_OFFS(u, o) do { _Pragma("unroll") for (int _h = 0; _h < 2; ++_h) _Pragma("unroll") for (int _i = 0; _i < 2; ++_i) { const int _row = (u).pm * 256 + _h * 128 + RA[_i]; \
        const unsigned _ri = g.rowidx ? (unsigned)g.rowidx[_row] : (unsigned)_row; o[_h][_i] = _ri * lda2 + CA2[_i]; } } while (0)
#define PG8_BBASE(u) ((const char*)g.Bt + (g.tile_e ? (size_t)__builtin_amdgcn_readfirstlane(TE_LDS ? *(const LAS int*)(lds + GEMM_LDS + 4 * (u).pm) : g.tile_e[(u).pm]) * (size_t)g.b_estride * 2 : (size_t)0) + (size_t)(u).pn * tstepB)
    Unit cur, nxt; int ui = 0;
    if (!S.next(0, cur)) return;
    f32x4_t acc[2][2][4][2];
#pragma unroll
    for (int a = 0; a < 2; ++a)
#pragma unroll
        for (int b = 0; b < 2; ++b)
#pragma unroll
            for (int m = 0; m < 4; ++m)
#pragma unroll
                for (int n = 0; n < 2; ++n) acc[a][b][m][n] = (f32x4_t){0.f, 0.f, 0.f, 0.f};
    i32x8_t At[4], B0[2], B1[2];
    unsigned oc[2][2], on[2][2];
    PG8_OFFS(cur, oc);
    const char* cB = PG8_BBASE(cur);
    PG8_STAGE_B(PG8_SB(0, 0), cB); PG8_STAGE_B(PG8_SB(0, 1), cB + hstepB); PG8_STAGE_A(PG8_SA(0, 0), gA, oc[0][0], oc[0][1]); PG8_STAGE_A(PG8_SA(0, 1), gA, oc[1][0], oc[1][1]);
    if (wr == 1) PG8_BAR;
    PG8_WAIT_V(2); PG8_BAR;
    PG8_STAGE_B(PG8_SB(1, 0), cB + kstep); PG8_STAGE_A(PG8_SA(1, 0), gA + kstep, oc[0][0], oc[0][1]); PG8_STAGE_B(PG8_SB(1, 1), cB + hstepB + kstep);
    PG8_WAIT_V(6); PG8_BAR;
    for (;;) {
        const bool has_next = S.next(ui + 1, nxt);
        const char* nB = cB;
        if (has_next) { PG8_OFFS(nxt, on); nB = PG8_BBASE(nxt); }
        else {
#pragma unroll
            for (int h = 0; h < 2; ++h)
#pragma unroll
                for (int i = 0; i < 2; ++i) on[h][i] = oc[h][i];
        }
        for (int t = 0; t < nt; t += 2) {
            const bool last = (t == nt - 2);
            const char* a1 = gA + (size_t)(t + 1) * kstep;
            const char* a2 = last ? gA : gA + (size_t)(t + 2) * kstep; const char* b2 = last ? nB : cB + (size_t)(t + 2) * kstep;
            const char* a3 = a2 + kstep; const char* b3 = b2 + kstep;
            const unsigned o00 = last ? on[0][0] : oc[0][0], o01 = last ? on[0][1] : oc[0][1], o10 = last ? on[1][0] : oc[1][0], o11 = last ? on[1][1] : oc[1][1];
            PG8_LDB(B0, 0, 0); PG8_LDB(B1, 0, 1); PG8_SCHED; PG8_LDA(At, 0, 0); PG8_STAGE_A(PG8_SA(1, 1), a1, oc[1][0], oc[1][1]);
            PG8_WAIT_V(8); PG8_WAIT_L(0); PG8_BAR; PG8_MMA(0, 0, At, B0); PG8_MMA(0, 1, At, B1); PG8_BAR; PG8_SCHED;
            PG8_LDA(At, 0, 1); PG8_STAGE_B(PG8_SB(0, 0), b2); PG8_STAGE_B(PG8_SB(0, 1), b2 + hstepB); PG8_STAGE_A(PG8_SA(0, 0), a2, o00, o01);
            PG8_WAIT_V(8); PG8_WAIT_L(0); PG8_BAR; PG8_MMA(1, 0, At, B0); PG8_MMA(1, 1, At, B1); PG8_BAR; PG8_SCHED;
            PG8_LDB(B0, 1, 0); PG8_LDB(B1, 1, 1); PG8_SCHED; PG8_LDA(At, 1, 0); PG8_STAGE_A(PG8_SA(0, 1), a2, o10, o11);
            PG8_WAIT_V(8); PG8_WAIT_L(0); PG8_BAR; PG8_MMA(0, 0, At, B0); PG8_MMA(0, 1, At, B1); PG8_BAR; PG8_SCHED;
            PG8_LDA(At, 1, 1); PG8_STAGE_B(PG8_SB(1, 0), b3); PG8_STAGE_B(PG8_SB(1, 1), b3 + hstepB); PG8_STAGE_A(PG8_SA(1, 0), a3, o00, o01);
            PG8_WAIT_V(8); PG8_WAIT_L(0); PG8_BAR; PG8_MMA(1, 0, At, B0); PG8_MMA(1, 1, At, B1); PG8_BAR; PG8_SCHED;
        }
        if (wr == 0) PG8_BAR;
        if constexpr (F8) asm volatile("s_nop 15\n\ts_nop 15" ::: "memory");
        {
            f8 raw[4], rawn[4];
#define PG8_EPI_LD(dst, ai_, mp_) do { _Pragma("unroll") for (int mm = 0; mm < 2; ++mm) _Pragma("unroll") for (int bj = 0; bj < 2; ++bj) \
                dst[mm * 2 + bj] = E.ld(cur.pm * 256 + (ai_) * 128 + wr * 64 + ((mp_) * 2 + mm) * 16 + fr, cur.pn * 256 + bj * 128 + wc * 32 + fq * 8); } while (0)
            if constexpr (Epi::HAS_LD) PG8_EPI_LD(rawn, 0, 0);
#pragma unroll
            for (int b4 = 0; b4 < 4; ++b4) { const int ai = b4 >> 1, mp = b4 & 1;
                if constexpr (Epi::HAS_LD) {
#pragma unroll
                    for (int i = 0; i < 4; ++i) raw[i] = rawn[i];
                    if (b4 < 3) PG8_EPI_LD(rawn, (b4 + 1) >> 1, (b4 + 1) & 1);
                }
#pragma unroll
                for (int mm = 0; mm < 2; ++mm) { const int m = mp * 2 + mm, row = cur.pm * 256 + ai * 128 + wr * 64 + m * 16 + fr;
#pragma unroll
                    for (int bj = 0; bj < 2; ++bj) { f8 v, v2;
#pragma unroll
                        for (int n = 0; n < 2; ++n)
#pragma unroll
                            for (int q = 0; q < 4; ++q) { v.v[4 * n + q] = acc[ai][bj][m][n][q]; v2.v[4 * n + q] = acc[ai][bj ^ 1][m][n][q]; }
                        const int col = cur.pn * 256 + bj * 128 + wc * 32 + fq * 8;
                        if constexpr (Epi::HAS_LD) E.fin(row, col, v, v2, raw[mm * 2 + bj]); else E.oct(row, col, v, v2); } }
            }
#undef PG8_EPI_LD
        }
        if (!has_next) break;
#pragma unroll
        for (int a = 0; a < 2; ++a)
#pragma unroll
            for (int b = 0; b < 2; ++b)
#pragma unroll
                for (int m = 0; m < 4; ++m)
#pragma unroll
                    for (int n = 0; n < 2; ++n) acc[a][b][m][n] = (f32x4_t){0.f, 0.f, 0.f, 0.f};
        cur = nxt; cB = nB; ++ui;
#pragma unroll
        for (int h = 0; h < 2; ++h)
#pragma unroll
            for (int i = 0; i < 2; ++i) oc[h][i] = on[h][i];
        if (wr == 1) PG8_BAR;
    }
    PG8_WAIT_V(0);
    PG8_BAR;
#undef PG8_SA
#undef PG8_SB
#undef PG8_STAGE_A
#undef PG8_STAGE_B
#undef PG8_LDA
#undef PG8_LDB
#undef PG8_MMA
#undef PG8_WAIT_V
#undef PG8_WAIT_L
#undef PG8_BAR
#undef PG8_SCHED
#undef PG8_OFFS
#undef PG8_BBASE
}
#else
template <class Epi> static void ph_gemm(const GemmArgs g, const Epi E, unsigned char*) {
    static float Ct[256][256];
    const int Mrt = g.m_rt ? *g.m_rt : g.M;
    StaticOrder S; S.init(Mrt, g.N, GDIM_OF(g), BIDX); Unit u;
    for (int i = 0; S.next(i, u); ++i) {
        const int brow = u.pm * 256, bcol = u.pn * 256; const bf16* Bg = g.Bt + (g.tile_e ? (long)g.tile_e[u.pm] * g.b_estride : 0);
        for (int r = 0; r < 256; ++r) { const long ridx = g.rowidx ? g.rowidx[brow + r] : brow + r; const bf16* a = g.A + ridx * g.lda;
            for (int c = 0; c < 256; ++c) { const bf16* bt = Bg + (long)(bcol + c) * g.K; float s = 0.f; for (int k = 0; k < g.K; ++k) s += bf2f(a[k]) * bf2f(bt[k]); Ct[r][c] = s; } }
        for (int r = 0; r < 256; ++r) for (int c = 0; c < 256; c += 8) { f8 v, v2; for (int q = 0; q < 8; ++q) { v.v[q] = Ct[r][c + q]; v2.v[q] = Ct[r][(c ^ 128) + q]; } E.oct(brow + r, bcol + c, v, v2); }
    }
}
#endif
__host__ __device__ __forceinline__ GemmArgs mk_gemm_(int grid, const bf16* A, long lda, const bf16* Bt, int M, int N, int K) {
    GemmArgs g; g.grid = grid; g.A = A; g.Bt = Bt; g.rowidx = nullptr; g.tile_e = nullptr; g.m_rt = nullptr; g.lda = lda; g.b_estride = 0; g.M = M; g.N = N; g.K = K; return g; }
#define mk_gemm(...) mk_gemm_(p.grid, __VA_ARGS__)
__host__ __device__ __forceinline__ XposeJob mk_xpose_(int grid, const float* src, bf16* dst, int K, int N, int Ncover, int il, int il2, int add, int batch, long ss, long ds) {
    XposeJob j; j.grid = grid; j.src = src; j.dst = dst; j.K = K; j.N = N; j.Ncover = Ncover; j.il = il; j.il2 = il2; j.add = add; j.batch = batch; j.sstride = ss; j.dstride = ds; j.first = 0; return j; }
#define mk_xpose(...) mk_xpose_(p.grid, __VA_ARGS__)

#ifndef HOST_EMU
#define XB_TMO      128
#define XB_XCNT(j)  (256  + 64 * (j))
#define XB_XSUB(j)  (1280 + 64 * (j))
#define XB_XGEN(j)  (2304 + 64 * (j))
#define XB_TOP      3328
#define XB_TOPGEN   3392
#define XCD_BAR_WORDS 3456
#define XB_SPIN_CAP (1u << 18)
__device__ __forceinline__ unsigned xb_ld(unsigned* p)              { return __hip_atomic_load(p, __ATOMIC_RELAXED, __HIP_MEMORY_SCOPE_AGENT); }
__device__ __forceinline__ unsigned xb_add(unsigned* p, unsigned v) { return __hip_atomic_fetch_add(p, v, __ATOMIC_RELAXED, __HIP_MEMORY_SCOPE_AGENT); }
__device__ __forceinline__ unsigned xb_xcc_id() { return (unsigned)__builtin_amdgcn_s_getreg((3 << 11) | 20) & 0xFu; }
#define XB_SPIN(cond, bar) do { unsigned _sp = 0; while (cond) { __builtin_amdgcn_s_sleep(1); \
    if ((++_sp & 255u) == 0u) { if (xb_ld(&(bar)[XB_TMO])) break; if (_sp > XB_SPIN_CAP) { atomicAdd(&(bar)[XB_TMO], 1u); break; } } } } while (0)
struct XcdBarrier { unsigned* bar; unsigned x; volatile LAS unsigned* st; unsigned G; };
__device__ __forceinline__ XcdBarrier xcd_barrier_post(unsigned* bar, volatile LAS unsigned* st, unsigned G) {
    XcdBarrier b; b.bar = bar; b.x = xb_xcc_id(); b.st = st; b.G = G;
    if (threadIdx.x == 0) (void)xb_add(&bar[XB_XCNT(b.x)], 1u);
    return b;
}
__device__ __forceinline__ void xcd_barrier_complete(unsigned* bar, unsigned x, unsigned G, unsigned& nloc, unsigned& nx) {
    unsigned sum, cnt, mine, sp = 0u;
    for (;;) {
        sum = 0u; cnt = 0u; mine = 0u;
#pragma unroll
        for (unsigned j = 0; j < 16; ++j) { const unsigned c = xb_ld(&bar[XB_XCNT(j)]); sum += c; cnt += (c > 0u) ? 1u : 0u; mine = (j == x) ? c : mine; }
        if (sum == G) break;
        __builtin_amdgcn_s_sleep(1);
        if ((++sp & 255u) == 0u) { if (xb_ld(&bar[XB_TMO])) break; if (sp > XB_SPIN_CAP) { atomicAdd(&bar[XB_TMO], 1u); break; } }
    }
    nloc = mine > 0u ? mine : 1u; nx = cnt > 0u ? cnt : 1u;
}
__device__ __forceinline__ void xcd_barrier(const XcdBarrier& b) {
    asm volatile("s_waitcnt vmcnt(0)" ::: "memory");
    __syncthreads();
    if (threadIdx.x == 0) {
        unsigned* bar = b.bar;
        __builtin_amdgcn_s_waitcnt(0);
        unsigned nloc = b.st[0], nx = b.st[1];
        if (nloc == 0u) { xcd_barrier_complete(bar, b.x, b.G, nloc, nx); b.st[0] = nloc; b.st[1] = nx; }
        const unsigned old = xb_add(&bar[XB_XSUB(b.x)], 1u);
        const unsigned gen = old / nloc;
        if (old + 1u == (gen + 1u) * nloc) {
            __builtin_amdgcn_fence(__ATOMIC_RELEASE, "agent");
            asm volatile("s_waitcnt vmcnt(0)" ::: "memory");
            const unsigned og = xb_add(&bar[XB_TOP], 1u);
            const unsigned tg = og / nx;
            if (og + 1u == (tg + 1u) * nx) xb_add(&bar[XB_TOPGEN], 1u);
            else XB_SPIN(xb_ld(&bar[XB_TOPGEN]) == tg, bar);
            __builtin_amdgcn_fence(__ATOMIC_ACQUIRE, "agent");
            xb_add(&bar[XB_XGEN(b.x)], 1u);
            asm volatile("s_waitcnt vmcnt(0)" ::: "memory");
        } else {
            XB_SPIN(xb_ld(&bar[XB_XGEN(b.x)]) == gen, bar);
            __builtin_amdgcn_fence(__ATOMIC_ACQUIRE, "agent");
            asm volatile("s_waitcnt vmcnt(0)" ::: "memory");
        }
    }
    __syncthreads();
}
#define PHASE_BEGIN {
#define PHASE_END } xcd_barrier(gbar);
#define PROGRAM_ARGS const P& p, unsigned char* lds, const XcdBarrier& gbar
#else
constexpr int EMU_GRID = 4;
#define PHASE_BEGIN for (int _b = 0; _b < EMU_GRID; ++_b) { e_blockIdx.x = _b;
#define PHASE_END }
#define PROGRAM_ARGS const P& p, unsigned char* lds, int gbar
#endif


#ifndef HOST_EMU
typedef float f32x16_t __attribute__((ext_vector_type(16)));
typedef short s16x4_t __attribute__((ext_vector_type(4)));
typedef float f32x2_t __attribute__((ext_vector_type(2)));
typedef __bf16 bf16x2_t __attribute__((ext_vector_type(2)));
typedef unsigned u32x4_t __attribute__((ext_vector_type(4)));
typedef unsigned u32x2_t __attribute__((ext_vector_type(2)));
__device__ __forceinline__ int crow(int r, int hi) { return (r & 3) + 8 * (r >> 2) + 4 * hi; }
__device__ __forceinline__ unsigned cvtpk(float lo, float hi) { f32x2_t v = {lo, hi}; bf16x2_t b = __builtin_convertvector(v, bf16x2_t); return __builtin_bit_cast(unsigned, b); }
__device__ __forceinline__ float xhalf_max(float m) { auto rr = __builtin_amdgcn_permlane32_swap(__float_as_uint(m), __float_as_uint(m), false, false); return fmaxf(__uint_as_float(rr[0]), __uint_as_float(rr[1])); }
__device__ __forceinline__ float xhalf_sum(float m) { auto rr = __builtin_amdgcn_permlane32_swap(__float_as_uint(m), __float_as_uint(m), false, false); return __uint_as_float(rr[0]) + __uint_as_float(rr[1]); }
constexpr int N2_SLOT = 16384;
constexpr int N2_IMPA = 2 * N2_SLOT, N2_IMPB = N2_IMPA + 32768, N2_IMPT = N2_IMPB + 32768, N2_SEL = N2_IMPT + 8192, N2_END = N2_SEL + 512;
static_assert(N2_END <= GEMM_LDS, "nsa lds");
__device__ __forceinline__ void n2_qk(f32x16_t& p0, f32x16_t& p1, const LAS unsigned char* Ks, const bf16x8_t (&qr)[4], int r32, int hi) {
#pragma unroll
    for (int r = 0; r < 16; ++r) { p0[r] = 0.f; p1[r] = 0.f; }
    asm volatile("" : "+v"(p0), "+v"(p1));
#pragma unroll
    for (int ks = 0; ks < 4; ++ks) { const int c = ((2 * ks + hi) ^ (r32 & 7)) * 16;
        const bf16x8_t k0 = *(const LAS bf16x8_t*)(Ks + r32 * 128 + c), k1 = *(const LAS bf16x8_t*)(Ks + (32 + r32) * 128 + c);
        p0 = __builtin_amdgcn_mfma_f32_32x32x16_bf16(k0, qr[ks], p0, 0, 0, 0); p1 = __builtin_amdgcn_mfma_f32_32x32x16_bf16(k1, qr[ks], p1, 0, 0, 0); }
}
__device__ __forceinline__ void n2_pv(f32x16_t& o0, f32x16_t& o1, const LAS unsigned char* Vs, const f32x16_t& p0, const f32x16_t& p1, int lane) {
    const int hi = lane >> 5; const LAS unsigned char* vb = Vs + (4 * hi + ((lane & 15) >> 2)) * 128 + (((lane >> 4) & 1) * 16 + (lane & 3) * 4) * 2;
#pragma unroll
    for (int s = 0; s < 4; ++s) {
        bf16x8_t pb;
        { const f32x16_t& pp = (s < 2) ? p0 : p1; const int r0 = 8 * (s & 1);
          union { unsigned u[4]; bf16x8_t v; } pk; pk.u[0] = cvtpk(pp[r0], pp[r0 + 1]); pk.u[1] = cvtpk(pp[r0 + 2], pp[r0 + 3]); pk.u[2] = cvtpk(pp[r0 + 4], pp[r0 + 5]); pk.u[3] = cvtpk(pp[r0 + 6], pp[r0 + 7]); pb = pk.v; }
#pragma unroll
        for (int d0 = 0; d0 < 2; ++d0) {
            const s16x4_t lo = __builtin_bit_cast(s16x4_t, __builtin_amdgcn_ds_read_tr16_b64_v4i16((LAS s16x4_t*)(vb + s * 2048 + d0 * 64)));
            const s16x4_t hh = __builtin_bit_cast(s16x4_t, __builtin_amdgcn_ds_read_tr16_b64_v4i16((LAS s16x4_t*)(vb + s * 2048 + 1024 + d0 * 64)));
            const bf16x8_t vf = (bf16x8_t){lo[0], lo[1], lo[2], lo[3], hh[0], hh[1], hh[2], hh[3]};
            if (d0 == 0) o0 = __builtin_amdgcn_mfma_f32_32x32x16_bf16(vf, pb, o0, 0, 0, 0); else o1 = __builtin_amdgcn_mfma_f32_32x32x16_bf16(vf, pb, o1, 0, 0, 0);
        }
    }
}
__device__ __forceinline__ void ph_nsa2(const P& p, unsigned char* lds_) {
    LAS unsigned char* lds = (LAS unsigned char*)lds_;
    int tid = threadIdx.x; asm volatile("" : "+v"(tid));
    const int lane = tid & 63, wid = __builtin_amdgcn_readfirstlane(tid >> 6), r32 = lane & 31, hi = lane >> 5;
    const int hr = wid >> 1, tsub = (wid & 1) * 32 + r32;
    const int skey = tid >> 3, sch = tid & 7;
    const unsigned soff = (unsigned)(skey * 128 + sch * 16);
    const bf16* QB = WSP(bf16, A_QB); bf16* ATT = WSP(bf16, A_ATT);
    const bf16* KCMP = WSP(bf16, A_KCMP); const bf16* VCMP = WSP(bf16, A_VCMP);
    const bf16* KS = WSP(bf16, A_KS); const bf16* VS = WSP(bf16, A_VS); const bf16* KW = WSP(bf16, A_KW); const bf16* VW = WSP(bf16, A_VW);
    LAS float* IMPA = (LAS float*)(lds + N2_IMPA); LAS float* IMPB = (LAS float*)(lds + N2_IMPB); LAS float* IMPT = (LAS float*)(lds + N2_IMPT); LAS unsigned* SEL = (LAS unsigned*)(lds + N2_SEL);
    constexpr int NQT = S / 64, NBG = NB * 2, NUNITS = NBG * NQT;
#define N2_LOAD(Kp, Vp, row0, kreg, vreg) do { const long rb_ = (long)(row0) * 128;     \
        kreg = *(const u32x4_t*)((const char*)(Kp) + rb_ + soff); vreg = *(const u32x4_t*)((const char*)(Vp) + rb_ + soff); } while (0)
#define N2_STORE(slot, kreg, vreg) do { *(LAS u32x4_t*)(lds + (slot) * N2_SLOT + skey * 128 + ((sch ^ (skey & 7)) * 16)) = kreg; *(LAS u32x4_t*)(lds + (slot) * N2_SLOT + 8192 + skey * 128 + sch * 16) = vreg; } while (0)
    for (int unit0 = blockIdx.x; unit0 < NUNITS; unit0 += p.grid) {
        int unit = unit0;
        if (p.grid % NBG == 0) { const int per = p.grid / NBG, k = unit0 / p.grid, c0 = (unit0 % p.grid) / NBG; if ((k & 1) && (k + 1) * p.grid <= NUNITS) unit = k * p.grid + (per - 1 - c0) * NBG + unit0 % NBG; }
        const int bg = unit % NBG, qt = unit / NBG, g = bg & 1, b = bg >> 1, t0 = qt * 64, t = t0 + tsub, cur = qt;
        const long kvrow = (long)bg * S;
        bf16x8_t qr[4];
        { const bf16* qrow = QB + ((long)(b * 8 + g * 4 + hr) * S + t) * 64;
#pragma unroll
          for (int ks = 0; ks < 4; ++ks) qr[ks] = *(const bf16x8_t*)(qrow + ks * 16 + hi * 8); }
        float gate[3];
        { const float* gr = WSP(float, A_GRAW) + ((long)b * S + t) * 24 + (g * 4 + hr) * 3;
#pragma unroll
          for (int i = 0; i < 3; ++i) gate[i] = sigmoidf_(gr[i]); }
        f32x16_t oa0, oa1;
#pragma unroll
        for (int r = 0; r < 16; ++r) { oa0[r] = 0.f; oa1[r] = 0.f; }
        asm volatile("" : "+v"(oa0), "+v"(oa1));
        u32x4_t kreg, vreg;
        N2_LOAD(KCMP, VCMP, (long)bg * NCP, kreg, vreg); N2_STORE(0, kreg, vreg);
        N2_LOAD(KCMP, VCMP, (long)bg * NCP + 64, kreg, vreg); N2_STORE(1, kreg, vreg);
        if (tid < 64) SEL[64 + 0] = 0u;
        __syncthreads();
        {
            f32x16_t c0, c1, c2, c3;
            n2_qk(c0, c1, lds, qr, r32, hi); n2_qk(c2, c3, lds + N2_SLOT, qr, r32, hi);
            float m = -1e30f;
            int nlim = (t >= 31) ? ((t - 31) >> 4) : -1; nlim = (nlim > NCMP - 1 ? NCMP - 1 : nlim) - 4 * hi;
            asm volatile("" : "+v"(nlim));
#pragma unroll
            for (int r = 0; r < 16; ++r) { const int nc = (r & 3) + 8 * (r >> 2);
                if (nc > nlim) c0[r] = -INFINITY;
                if (nc + 32 > nlim) c1[r] = -INFINITY;
                if (nc + 64 > nlim) c2[r] = -INFINITY;
                if (nc + 96 > nlim) c3[r] = -INFINITY;
                m = fmaxf(fmaxf(m, c0[r]), fmaxf(c1[r], fmaxf(c2[r], c3[r]))); }
            m = xhalf_max(m);
            float l = 0.f;
#pragma unroll
            for (int r = 0; r < 16; ++r) { c0[r] = __builtin_amdgcn_exp2f(c0[r] - m); c1[r] = __builtin_amdgcn_exp2f(c1[r] - m); c2[r] = __builtin_amdgcn_exp2f(c2[r] - m); c3[r] = __builtin_amdgcn_exp2f(c3[r] - m); l += (c0[r] + c1[r]) + (c2[r] + c3[r]); }
            l = xhalf_sum(l);
            const float inv = l > 0.f ? 1.0f / l : 0.f;
#pragma unroll
            for (int r = 0; r < 16; ++r) { c0[r] *= inv; c1[r] *= inv; c2[r] *= inv; c3[r] *= inv; }
            asm volatile("" : "+v"(c0), "+v"(c1), "+v"(c2), "+v"(c3));
            { LAS float* ia = IMPA + ((wid * 2 + hi) * 32 + r32) * 16; LAS float* ib = IMPB + ((wid * 2 + hi) * 32 + r32) * 16;
#pragma unroll
              for (int gi = 0; gi < 4; ++gi) {
                  ia[0 + gi] = (c0[4 * gi] + c0[4 * gi + 1]) + (c0[4 * gi + 2] + c0[4 * gi + 3]); ib[0 + gi] = c0[4 * gi + 3];
                  ia[4 + gi] = (c1[4 * gi] + c1[4 * gi + 1]) + (c1[4 * gi + 2] + c1[4 * gi + 3]); ib[4 + gi] = c1[4 * gi + 3];
                  ia[8 + gi] = (c2[4 * gi] + c2[4 * gi + 1]) + (c2[4 * gi + 2] + c2[4 * gi + 3]); ib[8 + gi] = c2[4 * gi + 3];
                  ia[12 + gi] = (c3[4 * gi] + c3[4 * gi + 1]) + (c3[4 * gi + 2] + c3[4 * gi + 3]); ib[12 + gi] = c3[4 * gi + 3]; } }
#pragma unroll
            for (int r = 0; r < 16; ++r) { c0[r] *= gate[0]; c1[r] *= gate[0]; c2[r] *= gate[0]; c3[r] *= gate[0]; }
            n2_pv(oa0, oa1, lds + 8192, c0, c1, lane); n2_pv(oa0, oa1, lds + N2_SLOT + 8192, c2, c3, lane);
        }
        __syncthreads();
        if (tid < 64) {
            const int tt = tid, th = tt >> 5, tr = tt & 31; LAS float* im = IMPT + tt * 32;
            for (int m = 0; m < 32; ++m) { float sacc = 0.f;
                if (m < NSLC) {
#pragma unroll
                    for (int r = 0; r < 4; ++r) { const int w = 2 * r + th; sacc += IMPA[((w * 2 + (m & 1)) * 32 + tr) * 16 + (m >> 1)]; if (m >= 1) sacc += IMPB[((w * 2 + ((m - 1) & 1)) * 32 + tr) * 16 + ((m - 1) >> 1)]; } }
                const bool valid = m <= cur, forced = (m == 0) || (valid && m > cur - 2);
                im[m] = (m < NSLC) ? (forced ? sacc + 1e4f : (valid ? sacc : -1e30f)) : -3.4e38f; }
            unsigned sm = 0u;
            for (int i = 0; i < 8; ++i) { int best = 0; float bv = -3.4e38f; for (int m = 0; m < NSLC; ++m) { const float v = im[m]; if (v > bv) { bv = v; best = m; } } im[best] = -3.4e38f; if (best <= cur) sm |= 1u << best; }
            SEL[tt] = sm; atomicOr((unsigned*)&SEL[64], sm);
        }
        __syncthreads();
        const unsigned mysel = SEL[tsub];
#pragma unroll
        for (int br = 0; br < 2; ++br) {
            const bf16* Kp = br == 0 ? KS : KW; const bf16* Vp = br == 0 ? VS : VW;
            unsigned bm;
            if (br == 0) bm = (unsigned)__builtin_amdgcn_readfirstlane((int)SEL[64]);
            else { const int lo = cur - 8 < 0 ? 0 : cur - 8; bm = (cur >= 31 ? 0xffffffffu : ((1u << (cur + 1)) - 1u)) & ~((1u << lo) - 1u); }
            int ja = __builtin_ctz(bm); bm &= bm - 1u; int jb = bm ? __builtin_ctz(bm) : -1; bm &= bm - 1u;
            N2_LOAD(Kp, Vp, kvrow + 64 * ja, kreg, vreg); N2_STORE(0, kreg, vreg);
            if (jb >= 0) { N2_LOAD(Kp, Vp, kvrow + 64 * jb, kreg, vreg); N2_STORE(1, kreg, vreg); }
            __syncthreads();
            int ps = 0; float m = -1e30f, l = 0.f; f32x16_t o0, o1;
#pragma unroll
            for (int r = 0; r < 16; ++r) { o0[r] = 0.f; o1[r] = 0.f; }
            asm volatile("" : "+v"(o0), "+v"(o1));
#define N2_STEP(jj, sub) do { \
                f32x16_t p0, p1; \
                n2_qk(p0, p1, lds + (sub) * N2_SLOT, qr, r32, hi); \
                const bool dead = (br == 0) && !((mysel >> (jj)) & 1u); \
                const bool diag = ((jj) == cur), tail = (br == 1) && ((jj) == cur - 8); \
                float rm = -1e30f; \
                int khi = dead ? -1000 : (diag ? tsub - 4 * hi : 1000), klo = tail ? tsub - 4 * hi : -1000;     \
                asm volatile("" : "+v"(khi), "+v"(klo)); \
                _Pragma("unroll") for (int r = 0; r < 16; ++r) { const int kc = (r & 3) + 8 * (r >> 2); \
                    if (kc > khi || kc <= klo) p0[r] = -INFINITY; \
                    if (kc + 32 > khi || kc + 32 <= klo) p1[r] = -INFINITY; \
                    rm = fmaxf(rm, fmaxf(p0[r], p1[r])); } \
                rm = xhalf_max(rm); \
                const float mn = fmaxf(m, rm), sc = __builtin_amdgcn_exp2f(m - mn); m = mn; \
                float rs = 0.f; \
                _Pragma("unroll") for (int r = 0; r < 16; ++r) { p0[r] = __builtin_amdgcn_exp2f(p0[r] - mn); p1[r] = __builtin_amdgcn_exp2f(p1[r] - mn); rs += p0[r] + p1[r]; } \
                l = l * sc + rs; \
                _Pragma("unroll") for (int r = 0; r < 16; ++r) { o0[r] *= sc; o1[r] *= sc; } \
                n2_pv(o0, o1, lds + (sub) * N2_SLOT + 8192, p0, p1, lane); } while (0)
            for (;;) {
                const int na = bm ? __builtin_ctz(bm) : -1; bm &= bm - 1u; const int nb = bm ? __builtin_ctz(bm) : -1; bm &= bm - 1u;
                if (na >= 0) N2_LOAD(Kp, Vp, kvrow + 64 * na, kreg, vreg);
                N2_STEP(ja, 2 * ps);
                if (na >= 0) N2_STORE(2 * (ps ^ 1), kreg, vreg);
                if (jb >= 0) {
                    if (nb >= 0) N2_LOAD(Kp, Vp, kvrow + 64 * nb, kreg, vreg);
                    N2_STEP(jb, 2 * ps + 1);
                    if (nb >= 0) N2_STORE(2 * (ps ^ 1) + 1, kreg, vreg); }
                __syncthreads();
                if (na < 0) break;
                ja = na; jb = nb; ps ^= 1;
            }
#undef N2_STEP
            l = xhalf_sum(l);
            const float f = (l > 0.f ? 1.0f / l : 0.f) * gate[1 + br];
#pragma unroll
            for (int r = 0; r < 16; ++r) { oa0[r] += f * o0[r]; oa1[r] += f * o1[r]; }
        }
        { unsigned char* orow = (unsigned char*)ATT + ((long)b * S + t) * 1024 + 512 + (g * 4 + hr) * 64;
#pragma unroll
          for (int gi = 0; gi < 4; ++gi) {
              *(unsigned*)(orow + 8 * gi + 4 * hi) = pk4_fp8(oa0[4 * gi] * A8_SCALE, oa0[4 * gi + 1] * A8_SCALE, oa0[4 * gi + 2] * A8_SCALE, oa0[4 * gi + 3] * A8_SCALE);
              *(unsigned*)(orow + 32 + 8 * gi + 4 * hi) = pk4_fp8(oa1[4 * gi] * A8_SCALE, oa1[4 * gi + 1] * A8_SCALE, oa1[4 * gi + 2] * A8_SCALE, oa1[4 * gi + 3] * A8_SCALE); } }
    }
#undef N2_LOAD
#undef N2_STORE
}

__device__ __forceinline__ void ph_sb2(const P& p, unsigned char* lds_) {
    LAS unsigned char* lds = (LAS unsigned char*)lds_;
    int tid = threadIdx.x; asm volatile("" : "+v"(tid));
    const int lane = tid & 63, wid = __builtin_amdgcn_readfirstlane(tid >> 6), r32 = lane & 31, hi = lane >> 5;
    const int skey = tid >> 3, sch = tid & 7;
    const unsigned soff = (unsigned)(skey * 128 + sch * 16);
    const bf16* QA = WSP(bf16, A_QA); const bf16* KA = WSP(bf16, A_KA); const bf16* VA = WSP(bf16, A_VA); bf16* ATT = WSP(bf16, A_ATT);
    LAS unsigned* FLG = (LAS unsigned*)(lds + 2 * N2_SLOT);
    constexpr int NQB = S / 256, NBH = NB * 8, NUNITS = NBH * NQB;
#define N2_LOAD(Kp, Vp, row0, kreg, vreg) do { const long rb_ = (long)(row0) * 128;     \
        kreg = *(const u32x4_t*)((const char*)(Kp) + rb_ + soff); vreg = *(const u32x4_t*)((const char*)(Vp) + rb_ + soff); } while (0)
#define N2_STORE(slot, kreg, vreg) do { *(LAS u32x4_t*)(lds + (slot) * N2_SLOT + skey * 128 + ((sch ^ (skey & 7)) * 16)) = kreg; *(LAS u32x4_t*)(lds + (slot) * N2_SLOT + 8192 + skey * 128 + sch * 16) = vreg; } while (0)
    for (int unit = blockIdx.x; unit < NUNITS; unit += p.grid) {
        const int bh = unit % NBH, qb = unit / NBH, t0 = qb * 256, tw = t0 + 32 * wid, t = tw + r32;
        const long kvrow = (long)bh * S;
        bf16x8_t qr[4];
        { const bf16* qrow = QA + (kvrow + t) * 64;
#pragma unroll
          for (int ks = 0; ks < 4; ++ks) qr[ks] = *(const bf16x8_t*)(qrow + ks * 16 + hi * 8); }
        f32x16_t o0, o1;
#pragma unroll
        for (int r = 0; r < 16; ++r) { o0[r] = 0.f; o1[r] = 0.f; }
        asm volatile("" : "+v"(o0), "+v"(o1));
        float R = 0.f;
        u32x4_t kreg, vreg;
        int j = 4 * qb + 3, slot = 0, iter = 0;
        N2_LOAD(KA, VA, kvrow + 64 * j, kreg, vreg); N2_STORE(0, kreg, vreg);
        __syncthreads();
        for (;;) {
            const int jn = j - 1;
            if (jn >= 0) N2_LOAD(KA, VA, kvrow + 64 * jn, kreg, vreg);
            if (64 * j < tw + 31 && !__all(R > 175.f)) {
                f32x16_t p0, p1, s0, s1;
                n2_qk(p0, p1, lds + slot * N2_SLOT, qr, r32, hi);
                int lim = t - 64 * j - 4 * hi;
                asm volatile("" : "+v"(lim));
#pragma unroll
                for (int r = 0; r < 16; ++r) { const int kc = (r & 3) + 8 * (r >> 2);
                    { const float z = p0[r], c = __builtin_amdgcn_logf(1.0f + __builtin_amdgcn_exp2f(-fabsf(z))); const bool ok = kc < lim; s0[r] = ok ? fmaxf(z, 0.f) + c : 0.f; p0[r] = ok ? -(fmaxf(-z, 0.f) + c) : -INFINITY; }
                    { const float z = p1[r], c = __builtin_amdgcn_logf(1.0f + __builtin_amdgcn_exp2f(-fabsf(z))); const bool ok = kc + 32 < lim; s1[r] = ok ? fmaxf(z, 0.f) + c : 0.f; p1[r] = ok ? -(fmaxf(-z, 0.f) + c) : -INFINITY; } }
                float own[8], part[8], T[8];
#pragma unroll
                for (int i = 0; i < 4; ++i) { own[i] = (s0[4 * i] + s0[4 * i + 1]) + (s0[4 * i + 2] + s0[4 * i + 3]); own[4 + i] = (s1[4 * i] + s1[4 * i + 1]) + (s1[4 * i + 2] + s1[4 * i + 3]); }
#pragma unroll
                for (int i = 0; i < 8; ++i) { auto rr = __builtin_amdgcn_permlane32_swap(__float_as_uint(own[i]), __float_as_uint(own[i]), false, false); part[i] = __uint_as_float(hi ? rr[0] : rr[1]); }
                float sp = R;
#pragma unroll
                for (int i = 7; i >= 0; --i) { T[i] = sp + (hi ? 0.f : part[i]); sp += own[i] + part[i]; }
                R = sp;
#pragma unroll
                for (int i = 0; i < 4; ++i) {
                    { const float e3 = T[i], e2 = e3 + s0[4 * i + 3], e1 = e2 + s0[4 * i + 2], e0 = e1 + s0[4 * i + 1];
                      p0[4 * i] = __builtin_amdgcn_exp2f(p0[4 * i] - e0); p0[4 * i + 1] = __builtin_amdgcn_exp2f(p0[4 * i + 1] - e1); p0[4 * i + 2] = __builtin_amdgcn_exp2f(p0[4 * i + 2] - e2); p0[4 * i + 3] = __builtin_amdgcn_exp2f(p0[4 * i + 3] - e3); }
                    { const float e3 = T[4 + i], e2 = e3 + s1[4 * i + 3], e1 = e2 + s1[4 * i + 2], e0 = e1 + s1[4 * i + 1];
                      p1[4 * i] = __builtin_amdgcn_exp2f(p1[4 * i] - e0); p1[4 * i + 1] = __builtin_amdgcn_exp2f(p1[4 * i + 1] - e1); p1[4 * i + 2] = __builtin_amdgcn_exp2f(p1[4 * i + 2] - e2); p1[4 * i + 3] = __builtin_amdgcn_exp2f(p1[4 * i + 3] - e3); } }
                n2_pv(o0, o1, lds + slot * N2_SLOT + 8192, p0, p1, lane);
            }
            if (jn >= 0) N2_STORE(slot ^ 1, kreg, vreg);
            const bool wdone = __all(R > 175.f);
            if (lane == 0) FLG[(iter & 1) * 8 + wid] = wdone ? 1u : 0u;
            __syncthreads();
            if (jn < 0) break;
            unsigned nd = 0u;
#pragma unroll
            for (int w = 0; w < 8; ++w) nd += FLG[(iter & 1) * 8 + w];
            if (__builtin_amdgcn_readfirstlane((int)nd) == 8) break;
            j = jn; slot ^= 1; ++iter;
        }
        { unsigned char* orow = (unsigned char*)ATT + ((long)(bh >> 3) * S + t) * 1024 + (bh & 7) * 64;
#pragma unroll
          for (int gi = 0; gi < 4; ++gi) {
              *(unsigned*)(orow + 8 * gi + 4 * hi) = pk4_fp8(o0[4 * gi] * A8_SCALE, o0[4 * gi + 1] * A8_SCALE, o0[4 * gi + 2] * A8_SCALE, o0[4 * gi + 3] * A8_SCALE);
              *(unsigned*)(orow + 32 + 8 * gi + 4 * hi) = pk4_fp8(o1[4 * gi] * A8_SCALE, o1[4 * gi + 1] * A8_SCALE, o1[4 * gi + 2] * A8_SCALE, o1[4 * gi + 3] * A8_SCALE); } }
    }
#undef N2_LOAD
#undef N2_STORE
}

__device__ __forceinline__ float gelu_fast(float v) { const float u = 0.7978845608028654f * (v + 0.044715f * v * v * v); return v * __builtin_amdgcn_rcpf(1.0f + __builtin_amdgcn_exp2f(-2.8853900817779268f * u)); }
__device__ __forceinline__ float xhalf_other(float v) { float a = v, b = v; asm volatile("s_nop 4\n\tv_permlane32_swap_b32 %0, %1\n\ts_nop 4" : "+v"(a), "+v"(b)); return (threadIdx.x & 32) ? a : b; }
__device__ __forceinline__ void xhalf_other8(const float (&v)[8], float (&o)[8]) {
    float a0 = v[0], a1 = v[1], a2 = v[2], a3 = v[3], a4 = v[4], a5 = v[5], a6 = v[6], a7 = v[7], b0 = a0, b1 = a1, b2 = a2, b3 = a3, b4 = a4, b5 = a5, b6 = a6, b7 = a7;
    asm volatile("s_nop 4\n\tv_permlane32_swap_b32 %0, %8\n\tv_permlane32_swap_b32 %1, %9\n\tv_permlane32_swap_b32 %2, %10\n\tv_permlane32_swap_b32 %3, %11\n\tv_permlane32_swap_b32 %4, %12\n\tv_permlane32_swap_b32 %5, %13\n\tv_permlane32_swap_b32 %6, %14\n\tv_permlane32_swap_b32 %7, %15\n\ts_nop 4"
                 : "+v"(a0), "+v"(a1), "+v"(a2), "+v"(a3), "+v"(a4), "+v"(a5), "+v"(a6), "+v"(a7), "+v"(b0), "+v"(b1), "+v"(b2), "+v"(b3), "+v"(b4), "+v"(b5), "+v"(b6), "+v"(b7));
    const bool up = (threadIdx.x & 32) != 0;
    o[0] = up ? a0 : b0; o[1] = up ? a1 : b1; o[2] = up ? a2 : b2; o[3] = up ? a3 : b3; o[4] = up ? a4 : b4; o[5] = up ? a5 : b5; o[6] = up ? a6 : b6; o[7] = up ? a7 : b7;
}
constexpr int S5B_ROW = 72, S5B_IMG = 128 * S5B_ROW, S5B_LDS_PER = S5B_IMG + 8192 + 4096 + 2048;
constexpr int S5B_SIDE = 4 * S5B_LDS_PER;
__device__ __forceinline__ float opq(float v) { asm("" : "+v"(v)); return v; }
__device__ __forceinline__ void ph_s5b(const P& p, unsigned char* lds_, bf16* YS) {
    int tid = threadIdx.x; asm volatile("" : "+v"(tid));
    const int lane = tid & 63, wid = __builtin_amdgcn_readfirstlane(tid >> 6), r32 = lane & 31, hi = lane >> 5;
    LAS unsigned char* HB = (LAS unsigned char*)lds_ + wid * S5B_LDS_PER;
    const bf16* U = WSP(bf16, C_U);
    const bf16* BT = WSP(bf16, O_S5BT); const bf16* CTB = WSP(bf16, O_S5CT); const float* APW = WSP(float, O_S5AP);
    const LAS unsigned char* hrd = HB + (8 * hi + ((lane & 15) >> 2)) * S5B_ROW + (((lane >> 4) & 1) * 16 + (lane & 3) * 4) * 2;
    for (int item = blockIdx.x * 4 + wid; wid < 4 && item < NB * NG; item += p.grid * 4) {
        const int g = item % NG; const long b = item / NG;
        const bf16* btp = BT + ((long)g * 128 + r32) * 16 + 8 * hi;
        const bf16* cfp = CTB + ((long)g * 32 + r32) * 128 + 8 * hi;
        LAS unsigned char* CF = HB + S5B_IMG + lane * 16;
#pragma unroll
        for (int ks = 0; ks < 8; ++ks) *(LAS bf16x8_t*)(CF + ks * 1024) = *(const bf16x8_t*)(cfp + 16 * ks);
#pragma unroll
        for (int ct = 0; ct < 4; ++ct) *(LAS bf16x8_t*)(CF + 8192 + ct * 1024) = *(const bf16x8_t*)(btp + ct * 512);
        *(LAS f32x4_t*)(CF + 8192 + 4096) = *(const f32x4_t*)(p.in[I_DSK] + g * 16 + 4 * hi); *(LAS f32x4_t*)(CF + 8192 + 4096 + 1024) = *(const f32x4_t*)(p.in[I_DSK] + g * 16 + 8 + 4 * hi);
        asm volatile("s_waitcnt vmcnt(0) lgkmcnt(0)" ::: "memory");
        float ap[2][8];
#pragma unroll
        for (int s = 0; s < 2; ++s)
#pragma unroll
            for (int k = 0; k < 8; ++k) ap[s][k] = APW[((long)g * 64 + 32 * s + r32) * 8 + k];
        float hs[2][2] = {{0.f, 0.f}, {0.f, 0.f}};
        const bf16* urow = U + ((long)b * S + r32) * DM + g * 16;
        bf16x8_t uf = *(const bf16x8_t*)(urow + 8 * hi);
        bf16x8_t btf[4];
#pragma unroll
        for (int ct = 0; ct < 4; ++ct) btf[ct] = *(const LAS bf16x8_t*)(CF + 8192 + ct * 1024);
        f32x16_t z16;
#pragma unroll
        for (int r = 0; r < 16; ++r) z16[r] = 0.f;
        asm volatile("" : "+v"(z16));
        f32x16_t x[4];
#pragma unroll
        for (int ct = 0; ct < 4; ++ct) x[ct] = __builtin_amdgcn_mfma_f32_32x32x16_bf16(uf, btf[ct], z16, 0, 0, 0);
        unsigned pend0 = 0u, pend1 = 0u; unsigned char* pend_row = (unsigned char*)YS;
#pragma nounroll
        for (int c = 0; c < S / 32; ++c) {
            const bf16* ucur = urow + (long)c * 32 * DM;
            const int cn = (c + 1 < S / 32) ? c + 1 : c;
            const u32x2_t uq0 = *(const u32x2_t*)(ucur + 4 * hi), uq1 = *(const u32x2_t*)(ucur + 8 + 4 * hi);
            const bf16x8_t ufn = *(const bf16x8_t*)(urow + (long)cn * 32 * DM + 8 * hi);
            if (c > 0) { *(unsigned*)(pend_row + 4 * hi) = pend0; *(unsigned*)(pend_row + 8 + 4 * hi) = pend1; }
#pragma unroll
            for (int s = 0; s < 2; ++s) {
                f32x16_t& xr = x[s]; f32x16_t& xi = x[2 + s];
                const float ar = ap[s][0], ai = ap[s][1], a4r = ap[s][6], a4i = ap[s][7];
                float er[4], ei[4], pr[4], pi[4], cgr[4], cgi[4];
#pragma unroll
                for (int gi = 0; gi < 4; ++gi) {
#pragma unroll
                    for (int k = 1; k < 4; ++k) { const float nr = opq(__builtin_fmaf(-ai, xi[4 * gi + k - 1], opq(__builtin_fmaf(ar, xr[4 * gi + k - 1], xr[4 * gi + k])))), ni = opq(__builtin_fmaf(ai, xr[4 * gi + k - 1], opq(__builtin_fmaf(ar, xi[4 * gi + k - 1], xi[4 * gi + k])))); xr[4 * gi + k] = nr; xi[4 * gi + k] = ni; }
                    er[gi] = xr[4 * gi + 3]; ei[gi] = xi[4 * gi + 3]; }
#pragma unroll
                for (int gi = 0; gi < 4; ++gi) { pr[gi] = 0.f; pi[gi] = 0.f; }
                { const float vin[8] = {er[0], er[1], er[2], er[3], ei[0], ei[1], ei[2], ei[3]}; float vout[8]; xhalf_other8(vin, vout);
#pragma unroll
                  for (int gi = 0; gi < 4; ++gi) { pr[gi] = vout[gi]; pi[gi] = vout[4 + gi]; } }
                float cr = hs[s][0], ci = hs[s][1];
#pragma unroll
                for (int gi = 0; gi < 4; ++gi) {
                    const float evr = hi ? pr[gi] : er[gi], evi = hi ? pi[gi] : ei[gi], odr = hi ? er[gi] : pr[gi], odi = hi ? ei[gi] : pi[gi];
                    const float c0r = cr, c0i = ci;
                    float nr = opq(__builtin_fmaf(-a4i, ci, opq(__builtin_fmaf(a4r, cr, evr)))), ni = opq(__builtin_fmaf(a4i, cr, opq(__builtin_fmaf(a4r, ci, evi)))); cr = nr; ci = ni;
                    cgr[gi] = hi ? cr : c0r; cgi[gi] = hi ? ci : c0i;
                    nr = opq(__builtin_fmaf(-a4i, ci, opq(__builtin_fmaf(a4r, cr, odr)))); ni = opq(__builtin_fmaf(a4i, cr, opq(__builtin_fmaf(a4r, ci, odi)))); cr = nr; ci = ni; }
                hs[s][0] = cr; hs[s][1] = ci;
#pragma unroll
                for (int gi = 0; gi < 4; ++gi)
#pragma unroll
                    for (int k = 0; k < 4; ++k) { const float pwr = ap[s][2 * k], pwi = ap[s][2 * k + 1]; xr[4 * gi + k] = opq(__builtin_fmaf(-pwi, cgi[gi], opq(__builtin_fmaf(pwr, cgr[gi], xr[4 * gi + k])))); xi[4 * gi + k] = opq(__builtin_fmaf(pwi, cgr[gi], opq(__builtin_fmaf(pwr, cgi[gi], xi[4 * gi + k])))); }
            }
#pragma unroll
            for (int ct = 0; ct < 4; ++ct)
#pragma unroll
                for (int gi = 0; gi < 4; ++gi) { u32x2_t w; w.x = cvtpk(x[ct][4 * gi], x[ct][4 * gi + 1]); w.y = cvtpk(x[ct][4 * gi + 2], x[ct][4 * gi + 3]); *(LAS u32x2_t*)(HB + (32 * ct + r32) * S5B_ROW + (8 * gi + 4 * hi) * 2) = w; }
            const f32x4_t dka = *(const LAS f32x4_t*)(CF + 8192 + 4096), dkb = *(const LAS f32x4_t*)(CF + 8192 + 4096 + 1024);
            asm volatile("s_waitcnt lgkmcnt(0)" ::: "memory");
            f32x16_t y;
#pragma unroll
            for (int ks = 0; ks < 8; ++ks) {
                const s16x4_t lo = __builtin_bit_cast(s16x4_t, __builtin_amdgcn_ds_read_tr16_b64_v4i16((LAS s16x4_t*)(hrd + (16 * ks) * S5B_ROW)));
                const s16x4_t hh = __builtin_bit_cast(s16x4_t, __builtin_amdgcn_ds_read_tr16_b64_v4i16((LAS s16x4_t*)(hrd + (16 * ks + 4) * S5B_ROW)));
                const bf16x8_t hf = (bf16x8_t){lo[0], lo[1], lo[2], lo[3], hh[0], hh[1], hh[2], hh[3]};
                const bf16x8_t cfk = *(const LAS bf16x8_t*)(CF + ks * 1024);
                y = __builtin_amdgcn_mfma_f32_32x32x16_bf16(cfk, hf, ks == 0 ? z16 : y, 0, 0, 0); }
#pragma unroll
            for (int ct = 0; ct < 4; ++ct) btf[ct] = *(const LAS bf16x8_t*)(CF + 8192 + ct * 1024);
            asm volatile("s_waitcnt lgkmcnt(0)" ::: "memory");
#pragma unroll
            for (int ct = 0; ct < 4; ++ct) x[ct] = __builtin_amdgcn_mfma_f32_32x32x16_bf16(ufn, btf[ct], z16, 0, 0, 0);
            { unsigned char* yrow = (unsigned char*)YS + ((long)b * S + c * 32 + r32) * DM + g * 16; float dk[8];
              { dk[0] = dka[0]; dk[1] = dka[1]; dk[2] = dka[2]; dk[3] = dka[3]; dk[4] = dkb[0]; dk[5] = dkb[1]; dk[6] = dkb[2]; dk[7] = dkb[3]; }
              const float u0 = bf2f((bf16)(uq0.x & 0xffffu)), u1 = bf2f((bf16)(uq0.x >> 16)), u2 = bf2f((bf16)(uq0.y & 0xffffu)), u3 = bf2f((bf16)(uq0.y >> 16));
              const float u4 = bf2f((bf16)(uq1.x & 0xffffu)), u5 = bf2f((bf16)(uq1.x >> 16)), u6 = bf2f((bf16)(uq1.y & 0xffffu)), u7 = bf2f((bf16)(uq1.y >> 16));
              pend0 = pk4_fp8(gelu_fast(y[0] + dk[0] * u0) * A8_SCALE, gelu_fast(y[1] + dk[1] * u1) * A8_SCALE, gelu_fast(y[2] + dk[2] * u2) * A8_SCALE, gelu_fast(y[3] + dk[3] * u3) * A8_SCALE);
              pend1 = pk4_fp8(gelu_fast(y[4] + dk[4] * u4) * A8_SCALE, gelu_fast(y[5] + dk[5] * u5) * A8_SCALE, gelu_fast(y[6] + dk[6] * u6) * A8_SCALE, gelu_fast(y[7] + dk[7] * u7) * A8_SCALE); pend_row = yrow; }
            uf = ufn;
        }
        *(unsigned*)(pend_row + 4 * hi) = pend0; *(unsigned*)(pend_row + 8 + 4 * hi) = pend1;
    }
}
#endif


#ifndef HOST_EMU
__device__ __forceinline__ void ph_xpose8(const XposeJob j, unsigned char* lds_, int rank = -1, int nranks = 0) {
    LAS unsigned char* tile = (LAS unsigned char*)lds_;
    int tid = threadIdx.x; asm volatile("" : "+v"(tid));
    const int tk = j.K / 64, tn = j.Ncover / 256, per = tk * tn;
    if (rank < 0) { rank = ((int)blockIdx.x - j.first + j.grid) % j.grid; nranks = j.grid; }
    for (int item = rank; item < per * j.batch; item += nranks) {
        const int bt = item / per, it = item % per, k0 = (it / tn) * 64, n0 = (it % tn) * 256;
        const float* src = j.src + (long)bt * j.sstride + (long)k0 * j.N + n0; unsigned char* dst = (unsigned char*)j.dst + (long)bt * j.dstride + k0;
#pragma unroll
        for (int i = 0; i < 2; ++i) { const int e = tid + 512 * i, k4 = (e >> 6) * 4, n4 = (e & 63) * 4;
            float4 q0 = make_float4(0.f, 0.f, 0.f, 0.f), q1 = q0, q2 = q0, q3 = q0;
            if (n0 + n4 < j.N) { q0 = *(const float4*)(src + (long)(k4 + 0) * j.N + n4); q1 = *(const float4*)(src + (long)(k4 + 1) * j.N + n4); q2 = *(const float4*)(src + (long)(k4 + 2) * j.N + n4); q3 = *(const float4*)(src + (long)(k4 + 3) * j.N + n4); }
            *(LAS unsigned*)(tile + (n4 + 0) * 80 + k4) = pk4_fp8(q0.x * W8_SCALE, q1.x * W8_SCALE, q2.x * W8_SCALE, q3.x * W8_SCALE);
            *(LAS unsigned*)(tile + (n4 + 1) * 80 + k4) = pk4_fp8(q0.y * W8_SCALE, q1.y * W8_SCALE, q2.y * W8_SCALE, q3.y * W8_SCALE);
            *(LAS unsigned*)(tile + (n4 + 2) * 80 + k4) = pk4_fp8(q0.z * W8_SCALE, q1.z * W8_SCALE, q2.z * W8_SCALE, q3.z * W8_SCALE);
            *(LAS unsigned*)(tile + (n4 + 3) * 80 + k4) = pk4_fp8(q0.w * W8_SCALE, q1.w * W8_SCALE, q2.w * W8_SCALE, q3.w * W8_SCALE); }
        __syncthreads();
#pragma unroll
        for (int i = 0; i < 2; ++i) { const int e = tid + 512 * i, nn = e >> 2, c16 = (e & 3) * 16, n = n0 + nn; const long row = (long)(n / j.il) * j.il2 + (n % j.il) + j.add;
            *(u32x4_t*)(dst + row * j.K + c16) = *(const LAS u32x4_t*)(tile + nn * 80 + c16); }
        __syncthreads();
    }
}
__device__ __forceinline__ void xpose_wave8(const XposeJob j, LAS unsigned char* tl, int wave_rank, int n_waves, int lane) {
    const int tk = j.K / 64, tn = j.Ncover / 64, per = tk * tn;
    for (int item = wave_rank; item < per * j.batch; item += n_waves) {
        const int bt = item / per, it = item % per, k0 = (it / tn) * 64, n0 = (it % tn) * 64;
        const float* src = j.src + (long)bt * j.sstride + (long)k0 * j.N + n0; unsigned char* dst = (unsigned char*)j.dst + (long)bt * j.dstride + k0;
#pragma unroll
        for (int i = 0; i < 4; ++i) { const int e = lane + 64 * i, k4 = (e >> 4) * 4, n4 = (e & 15) * 4;
            const float4 q0 = *(const float4*)(src + (long)(k4 + 0) * j.N + n4), q1 = *(const float4*)(src + (long)(k4 + 1) * j.N + n4), q2 = *(const float4*)(src + (long)(k4 + 2) * j.N + n4), q3 = *(const float4*)(src + (long)(k4 + 3) * j.N + n4);
            *(LAS unsigned*)(tl + (n4 + 0) * 80 + k4) = pk4_fp8(q0.x * W8_SCALE, q1.x * W8_SCALE, q2.x * W8_SCALE, q3.x * W8_SCALE);
            *(LAS unsigned*)(tl + (n4 + 1) * 80 + k4) = pk4_fp8(q0.y * W8_SCALE, q1.y * W8_SCALE, q2.y * W8_SCALE, q3.y * W8_SCALE);
            *(LAS unsigned*)(tl + (n4 + 2) * 80 + k4) = pk4_fp8(q0.z * W8_SCALE, q1.z * W8_SCALE, q2.z * W8_SCALE, q3.z * W8_SCALE);
            *(LAS unsigned*)(tl + (n4 + 3) * 80 + k4) = pk4_fp8(q0.w * W8_SCALE, q1.w * W8_SCALE, q2.w * W8_SCALE, q3.w * W8_SCALE); }
        asm volatile("s_waitcnt lgkmcnt(0)" ::: "memory");
#pragma unroll
        for (int i = 0; i < 4; ++i) { const int e = lane + 64 * i, nn = e >> 2, c16 = (e & 3) * 16, n = n0 + nn; const long row = (long)(n / j.il) * j.il2 + (n % j.il) + j.add;
            *(u32x4_t*)(dst + row * j.K + c16) = *(const LAS u32x4_t*)(tl + nn * 80 + c16); }
        asm volatile("s_waitcnt lgkmcnt(0)" ::: "memory");
    }
}
__device__ __forceinline__ void xpose_wave(const XposeJob j, LAS unsigned char* tl, int wave_rank, int n_waves, int lane) {
    const int tk = j.K / 64, tn = j.Ncover / 64, per = tk * tn;
    for (int item = wave_rank; item < per * j.batch; item += n_waves) {
        const int bt = item / per, it = item % per, k0 = (it / tn) * 64, n0 = (it % tn) * 64;
        const float* src = j.src + (long)bt * j.sstride + (long)k0 * j.N + n0; bf16* dst = j.dst + (long)bt * j.dstride + k0;
#pragma unroll
        for (int i = 0; i < 4; ++i) { const int e = lane + 64 * i, k4 = (e >> 4) * 4, n4 = (e & 15) * 4;
            const float4 q0 = *(const float4*)(src + (long)(k4 + 0) * j.N + n4), q1 = *(const float4*)(src + (long)(k4 + 1) * j.N + n4), q2 = *(const float4*)(src + (long)(k4 + 2) * j.N + n4), q3 = *(const float4*)(src + (long)(k4 + 3) * j.N + n4);
            u32x2_t w;
            w.x = (unsigned)f2bf(q0.x) | ((unsigned)f2bf(q1.x) << 16); w.y = (unsigned)f2bf(q2.x) | ((unsigned)f2bf(q3.x) << 16); *(LAS u32x2_t*)(tl + ((n4 + 0) * 72 + k4) * 2) = w;
            w.x = (unsigned)f2bf(q0.y) | ((unsigned)f2bf(q1.y) << 16); w.y = (unsigned)f2bf(q2.y) | ((unsigned)f2bf(q3.y) << 16); *(LAS u32x2_t*)(tl + ((n4 + 1) * 72 + k4) * 2) = w;
            w.x = (unsigned)f2bf(q0.z) | ((unsigned)f2bf(q1.z) << 16); w.y = (unsigned)f2bf(q2.z) | ((unsigned)f2bf(q3.z) << 16); *(LAS u32x2_t*)(tl + ((n4 + 2) * 72 + k4) * 2) = w;
            w.x = (unsigned)f2bf(q0.w) | ((unsigned)f2bf(q1.w) << 16); w.y = (unsigned)f2bf(q2.w) | ((unsigned)f2bf(q3.w) << 16); *(LAS u32x2_t*)(tl + ((n4 + 3) * 72 + k4) * 2) = w; }
        asm volatile("s_waitcnt lgkmcnt(0)" ::: "memory");
#pragma unroll 4
        for (int i = 0; i < 8; ++i) { const int e = lane + 64 * i, nn = e >> 3, c8 = (e & 7) * 8, n = n0 + nn; const long row = (long)(n / j.il) * j.il2 + (n % j.il) + j.add;
            *(u32x4_t*)(dst + row * j.K + c8) = *(const LAS u32x4_t*)(tl + (nn * 72 + c8) * 2); }
        asm volatile("s_waitcnt lgkmcnt(0)" ::: "memory");
    }
}
template <int L> __device__ __forceinline__ void ph_xpose_side(const P& p, unsigned char* lds_) {
    int tid = threadIdx.x; asm volatile("" : "+v"(tid));
    const int lane = tid & 63, wid = __builtin_amdgcn_readfirstlane(tid >> 6);
    if (wid < 4) return;
    LAS unsigned char* tl = (LAS unsigned char*)lds_ + S5B_SIDE + (wid - 4) * 9216;
    const int wr_ = (int)blockIdx.x * 4 + (wid - 4), nw = p.grid * 4; constexpr int mi = MOE_IN0[L];
    xpose_wave8(mk_xpose(p.in[mi + 2], WSP(bf16, O_WT_GU), DM, 256, 256, GU_IL, 2 * GU_IL, 0, 64, (long)DM * 256, (long)512 * DM), tl, wr_, nw, lane);
    xpose_wave8(mk_xpose(p.in[mi + 3], WSP(bf16, O_WT_GU), DM, 256, 256, GU_IL, 2 * GU_IL, GU_IL, 64, (long)DM * 256, (long)512 * DM), tl, wr_, nw, lane);
    xpose_wave8(mk_xpose(p.in[mi + 4], WSP(bf16, O_WT_D), 256, DM, DM, DM, 0, 0, 64, (long)256 * DM, (long)DM * 256), tl, wr_, nw, lane);
}
static_assert(S5B_SIDE + 4 * 9216 <= GEMM_LDS, "s5 side lds");
#endif
constexpr int ROUTE_LDS = 256 * 72 * 4 + 128 * 4 + 256 * 6 * 4;
constexpr int MEGA_LDS_PH = GEMM_LDS;
static_assert(MEGA_LDS_PH >= 2 * NSA_LDS_PER && MEGA_LDS_PH >= 8 * S5_LDS_PER && MEGA_LDS_PH >= 2 * LN_LDS_PER && MEGA_LDS_PH >= ROUTE_LDS && MEGA_LDS_PH >= 256 * 72 * 2, "LDS map");
constexpr int MEGA_LDS = MEGA_LDS_PH + 256 + GEMM_TE_LDS;

#ifndef HOST_EMU
__device__ __forceinline__ void ph_te_load(const int* te, unsigned char* lds_) {
    int t2 = threadIdx.x; asm volatile("" : "+v"(t2));
    for (int i = t2; i < MOE_TILES; i += NTHR) *(LAS int*)((LAS unsigned char*)lds_ + GEMM_LDS + 4 * i) = te[i];
    __syncthreads();
}
#endif
template <int L, int CH> __device__ __forceinline__ void moe_chunk(PROGRAM_ARGS) {
    bf16* const PREB = (L == 0) ? (bf16*)p.out : WSP(bf16, O_H2);
    const int mi = MOE_IN0[L]; const bf16* hin = WSP(bf16, O_H);
    PHASE_BEGIN ph_place(p, L, CH, lds); PHASE_END
#ifndef HOST_EMU
    PHASE_BEGIN { GemmArgs g = mk_gemm(WSP(bf16, B_H8), DM / 2, WSP(bf16, O_WT_GU), MOE_ROWS, 512, DM / 2); g.rowidx = WSP(int, B_ROWTOK); g.tile_e = WSP(int, O_TILEE); g.m_rt = WSP(int, O_PADSTART) + 64; g.b_estride = (long)512 * DM / 2; EpiSwiglu8 e{WSP(unsigned char, B_AEX)}; ph_te_load(WSP(int, O_TILEE), lds); ph_gemm<EpiSwiglu8, true, true>(g, e, lds); } PHASE_END
    PHASE_BEGIN { GemmArgs g = mk_gemm(WSP(bf16, B_AEX), 128, WSP(bf16, O_WT_D), MOE_ROWS, DM, 128); g.tile_e = WSP(int, O_TILEE); g.m_rt = WSP(int, O_PADSTART) + 64; g.b_estride = (long)DM * 128; EpiY8 e{WSP(unsigned char, B_Y), DM, F8_ACC_INV}; ph_gemm<EpiY8, true, true>(g, e, lds); } PHASE_END
#else
    PHASE_BEGIN { GemmArgs g = mk_gemm(hin, DM, WSP(bf16, O_WT_GU), MOE_ROWS, 512, DM); g.rowidx = WSP(int, B_ROWTOK); g.tile_e = WSP(int, O_TILEE); g.m_rt = WSP(int, O_PADSTART) + 64; g.b_estride = (long)512 * DM; EpiSwiglu e{WSP(bf16, B_AEX)}; ph_gemm(g, e, lds); } PHASE_END
    PHASE_BEGIN { GemmArgs g = mk_gemm(WSP(bf16, B_AEX), 256, WSP(bf16, O_WT_D), MOE_ROWS, DM, 256); g.tile_e = WSP(int, O_TILEE); g.m_rt = WSP(int, O_PADSTART) + 64; g.b_estride = (long)DM * 256; EpiY e{WSP(unsigned char, B_Y), WSP(float, B_ROWGATE), DM}; ph_gemm(g, e, lds); } PHASE_END
#endif
    PHASE_BEGIN
        { LnJob j; j.grid = p.grid; j.pad = 0; j.pre = p.out; j.preb = PREB; j.y = WSP(unsigned char, B_Y); j.pos = WSP(int, B_POS); j.g = p.in[mi + 8];
#ifndef HOST_EMU
          j.gate = WSP(float, B_GATE);
#else
          j.gate = nullptr;
#endif
          j.b = p.in[mi + 9]; j.t_beg = (long)CH * TC; j.t_cnt = TC;
          j.obf = (L == 0) ? WSP(bf16, O_H2) : nullptr; j.of32 = (L == 0) ? nullptr : p.out; j.of8 = (L == 0) ? WSP(unsigned char, B_H28) : nullptr; ph_ln(j, lds); }
        if (CH + 1 < NCH) ph_route(p, L, CH + 1, lds);
    PHASE_END
}
template <int L> __device__ __forceinline__ void moe_layer(PROGRAM_ARGS) {
    bf16* const PREB = (L == 0) ? (bf16*)p.out : WSP(bf16, O_H2);
    const int mi = MOE_IN0[L]; const bf16* hin = WSP(bf16, O_H);
    PHASE_BEGIN
        { GemmArgs g = mk_gemm(hin, DM, WSP(bf16, O_WT_R) + (size_t)L * 256 * DM, T, 256, DM); EpiLogit e{WSP(float, B_LOGIT)}; ph_gemm(g, e, lds); }
#ifndef HOST_EMU
        { GemmArgs g = mk_gemm(WSP(bf16, B_H8), DM / 2, (const bf16*)(WSP(unsigned char, O_WT_SGU) + (size_t)L * 512 * DM), T, 512, DM / 2); EpiSwiglu8 e{WSP(unsigned char, B_ASH)}; ph_gemm<EpiSwiglu8, true>(g, e, lds); }
#else
        { GemmArgs g = mk_gemm(hin, DM, WSP(bf16, O_WT_SGU) + (size_t)L * 512 * DM, T, 512, DM); EpiSwiglu e{WSP(bf16, B_ASH)}; ph_gemm(g, e, lds); }
#endif
    PHASE_END
    PHASE_BEGIN
#ifndef HOST_EMU
        { GemmArgs g = mk_gemm(WSP(bf16, B_ASH), 128, (const bf16*)(WSP(unsigned char, O_WT_SD) + (size_t)L * DM * 256), T, DM, 128); EpiResBfT<true> e{p.out, PREB, hin, DM}; e.sc = F8_ACC_INV; ph_gemm<EpiResBfT<true>, true>(g, e, lds); }
#else
        { GemmArgs g = mk_gemm(WSP(bf16, B_ASH), 256, WSP(bf16, O_WT_SD) + (size_t)L * DM * 256, T, DM, 256); EpiResBfT<true> e{p.out, PREB, hin, DM}; ph_gemm(g, e, lds); }
#endif
        ph_route(p, L, 0, lds);
    PHASE_END
    (void)mi;
    moe_chunk<L, 0>(p, lds, gbar);
    if constexpr (NCH == 2) moe_chunk<L, 1>(p, lds, gbar);
}
template <int L> __device__ __forceinline__ void xpose_experts(const P& p, unsigned char* lds, int rank = -1, int nranks = 0) {
    constexpr int mi = MOE_IN0[L];
#ifndef HOST_EMU
#define XPOSE_EXP(j_) ph_xpose8(j_, lds, rank, nranks)
#else
#define XPOSE_EXP(j_) ph_xpose(j_, lds)
    (void)rank; (void)nranks;
#endif
    XPOSE_EXP(mk_xpose(p.in[mi + 2], WSP(bf16, O_WT_GU), DM, 256, 256, GU_IL, 2 * GU_IL, 0, 64, (long)DM * 256, (long)512 * DM));
    XPOSE_EXP(mk_xpose(p.in[mi + 3], WSP(bf16, O_WT_GU), DM, 256, 256, GU_IL, 2 * GU_IL, GU_IL, 64, (long)DM * 256, (long)512 * DM));
    XPOSE_EXP(mk_xpose(p.in[mi + 4], WSP(bf16, O_WT_D), 256, DM, DM, DM, 0, 0, 64, (long)256 * DM, (long)DM * 256));
#undef XPOSE_EXP
}
__device__ __forceinline__ void program(PROGRAM_ARGS) {
    bf16* const PREB = (bf16*)p.out;
    PHASE_BEGIN
        int xo = 0;
#define XP(fn_, job_) do { XposeJob j_ = job_; j_.first = xo % p.grid; xo += (j_.K / 64) * ((j_.Ncover + 255) / 256) * j_.batch; fn_(j_, lds); } while (0)
#ifndef HOST_EMU
        XP(ph_xpose8, mk_xpose(p.in[I_L0_WIN], WSP(bf16, O_WT_IN0), DM, PROJ_N, PROJ_NP, PROJ_NP, 0, 0, 1, 0, 0));
        { int t8 = threadIdx.x; asm volatile("" : "+v"(t8));
          for (long i = ((long)blockIdx.x * NTHR + t8) * 8; i < (long)T * DM; i += (long)p.grid * NTHR * 8) { const f8 a = ld_f8(p.in[I_X] + i);
              uint2 w; w.x = pk4_fp8(a.v[0] * A8_SCALE, a.v[1] * A8_SCALE, a.v[2] * A8_SCALE, a.v[3] * A8_SCALE); w.y = pk4_fp8(a.v[4] * A8_SCALE, a.v[5] * A8_SCALE, a.v[6] * A8_SCALE, a.v[7] * A8_SCALE); *(uint2*)(WSP(unsigned char, O_H) + i) = w; } }
#else
        XP(ph_xpose, mk_xpose(p.in[I_L0_WIN], WSP(bf16, O_WT_IN0), DM, PROJ_N, PROJ_NP, PROJ_NP, 0, 0, 1, 0, 0));
        ph_cvt(p, p.in[I_X], WSP(bf16, O_H), (long)T * DM);
#endif
        XP(ph_xpose, mk_xpose(p.in[I_KW1], WSP(bf16, O_WT_K1), 2048, 256, 256, 256, 0, 0, 1, 0, 0));
        XP(ph_xpose, mk_xpose(p.in[I_VW1], WSP(bf16, O_WT_V1), 2048, 256, 256, 256, 0, 0, 1, 0, 0));
#ifndef HOST_EMU
        XP(ph_xpose8, mk_xpose(p.in[I_L0_WOUT], WSP(bf16, O_WT_OUT0), 1024, DM, DM, DM, 0, 0, 1, 0, 0));
#else
        XP(ph_xpose, mk_xpose(p.in[I_L0_WOUT], WSP(bf16, O_WT_OUT0), 1024, DM, DM, DM, 0, 0, 1, 0, 0));
#endif
        XP(ph_xpose, mk_xpose(p.in[I_KW2], WSP(bf16, O_WT_K2), 256, 64, 256, 256, 0, 0, 1, 0, 0));
        XP(ph_xpose, mk_xpose(p.in[I_VW2], WSP(bf16, O_WT_K2) + 256 * 256, 256, 64, 256, 256, 0, 0, 1, 0, 0));
#pragma unroll
        for (int l = 0; l < 2; ++l) { const int mi = (l == 0) ? I_L0_ROUTER : I_L1_ROUTER;
            XP(ph_xpose, mk_xpose(p.in[mi], WSP(bf16, O_WT_R) + (size_t)l * 256 * DM, DM, 64, 256, 256, 0, 0, 1, 0, 0));
#ifndef HOST_EMU
            XP(ph_xpose8, mk_xpose(p.in[mi + 5], (bf16*)(WSP(unsigned char, O_WT_SGU) + (size_t)l * 512 * DM), DM, 256, 256, GU_IL, 2 * GU_IL, 0, 1, 0, 0));
            XP(ph_xpose8, mk_xpose(p.in[mi + 6], (bf16*)(WSP(unsigned char, O_WT_SGU) + (size_t)l * 512 * DM), DM, 256, 256, GU_IL, 2 * GU_IL, GU_IL, 1, 0, 0));
            XP(ph_xpose8, mk_xpose(p.in[mi + 7], (bf16*)(WSP(unsigned char, O_WT_SD) + (size_t)l * DM * 256), 256, DM, DM, DM, 0, 0, 1, 0, 0)); }
#else
            XP(ph_xpose, mk_xpose(p.in[mi + 5], WSP(bf16, O_WT_SGU) + (size_t)l * 512 * DM, DM, 256, 256, GU_IL, 2 * GU_IL, 0, 1, 0, 0));
            XP(ph_xpose, mk_xpose(p.in[mi + 6], WSP(bf16, O_WT_SGU) + (size_t)l * 512 * DM, DM, 256, 256, GU_IL, 2 * GU_IL, GU_IL, 1, 0, 0));
            XP(ph_xpose, mk_xpose(p.in[mi + 7], WSP(bf16, O_WT_SD) + (size_t)l * DM * 256, 256, DM, DM, DM, 0, 0, 1, 0, 0)); }
#endif
#ifndef HOST_EMU
        XP(ph_xpose8, mk_xpose(p.in[I_L1_WIN], WSP(bf16, O_WT_IN1), DM, DM, DM, DM, 0, 0, 1, 0, 0));
#else
        XP(ph_xpose, mk_xpose(p.in[I_L1_WIN], WSP(bf16, O_WT_IN1), DM, DM, DM, DM, 0, 0, 1, 0, 0));
#endif
#ifndef HOST_EMU
        XP(ph_xpose8, mk_xpose(p.in[I_WGLU], WSP(bf16, O_WT_GLU), DM, DM, DM, DM, 0, 0, 1, 0, 0));
#else
        XP(ph_xpose, mk_xpose(p.in[I_WGLU], WSP(bf16, O_WT_GLU), DM, DM, DM, DM, 0, 0, 1, 0, 0));
#endif
#ifndef HOST_EMU
        XP(ph_xpose8, mk_xpose(p.in[I_L1_WOUT], WSP(bf16, O_WT_OUT1), DM, DM, DM, DM, 0, 0, 1, 0, 0));
#else
        XP(ph_xpose, mk_xpose(p.in[I_L1_WOUT], WSP(bf16, O_WT_OUT1), DM, DM, DM, DM, 0, 0, 1, 0, 0));
#endif
#undef XP
        ph_tables(p);
#ifdef HOST_EMU
        xpose_experts<0>(p, lds);
#endif
    PHASE_END
#ifndef HOST_EMU
    PHASE_BEGIN ph_bias_finish(p); { GemmArgs g = mk_gemm(WSP(bf16, O_H), DM / 2, WSP(bf16, O_WT_IN0), T, PROJ_NP, DM / 2); EpiProj0R e{p.ws, F8_ACC_INV}; ph_gemm<EpiProj0R, true>(g, e, lds); } PHASE_END
#else
    PHASE_BEGIN { GemmArgs g = mk_gemm(WSP(bf16, O_H), DM, WSP(bf16, O_WT_IN0), T, PROJ_NP, DM); EpiProj0 e{p.ws}; ph_gemm(g, e, lds); } PHASE_END
    PHASE_BEGIN ph_rope(p); ph_bias_finish(p); PHASE_END
#endif
    PHASE_BEGIN
        static_assert(A_VC == A_KC + (size_t)NB * 2 * NCP * 1024 * 2 && O_WT_V1 == O_WT_K1 + (size_t)256 * 2048 * 2 && O_BIASV == O_BIASK + 1024 && (NB * 2 * NCP) % 256 == 0, "batched cmp GEMM: k then v, contiguous");
        { GemmArgs g = mk_gemm(WSP(bf16, A_KC), 1024, WSP(bf16, O_WT_K1), 2 * NB * 2 * NCP, 256, 2048); g.tile_e = WSP(int, O_CMPTE); g.b_estride = (long)256 * 2048; EpiCmp1 e{WSP(bf16, A_HCK), WSP(float, O_BIASK)}; ph_gemm(g, e, lds); }
        { GemmArgs g = mk_gemm(WSP(bf16, A_HCK), 256, WSP(bf16, O_WT_K2), 2 * NB * 2 * NCP, 256, 256); g.tile_e = WSP(int, O_CMPTE); g.b_estride = (long)256 * 256; EpiCmp2 e{WSP(bf16, A_KCMP), WSP(bf16, A_VCMP)}; ph_gemm(g, e, lds); }
#ifndef HOST_EMU
        { constexpr int NCW = 2 * NB * 2 * NCP / 256; if (p.grid > NCW) { if ((int)blockIdx.x >= NCW) xpose_experts<0>(p, lds, (int)blockIdx.x - NCW, p.grid - NCW); } else xpose_experts<0>(p, lds); }
#endif
    PHASE_END
#ifdef HOST_EMU
    PHASE_BEGIN ph_nsa(p, lds); ph_sb(p); PHASE_END
#else
    PHASE_BEGIN ph_nsa2(p, lds); ph_sb2(p, lds); PHASE_END
#endif
#ifndef HOST_EMU
    PHASE_BEGIN { GemmArgs g = mk_gemm(WSP(bf16, A_ATT), 512, WSP(bf16, O_WT_OUT0), T, DM, 512); EpiResF32 e{PREB, p.in[I_X], DM}; e.sc = F8_ACC_INV; ph_gemm<EpiResF32, true>(g, e, lds); } PHASE_END
#else
    PHASE_BEGIN { GemmArgs g = mk_gemm(WSP(bf16, A_ATT), 1024, WSP(bf16, O_WT_OUT0), T, DM, 1024); EpiResF32 e{PREB, p.in[I_X], DM}; ph_gemm(g, e, lds); } PHASE_END
#endif
    PHASE_BEGIN { LnJob j; j.grid = p.grid; j.pad = 0; j.pre = p.out; j.preb = PREB; j.y = nullptr; j.pos = nullptr; j.gate = nullptr; j.g = p.in[I_L0_LN1G]; j.b = p.in[I_L0_LN1B]; j.obf = WSP(bf16, O_H); j.of32 = nullptr; j.of8 = WSP(unsigned char, B_H8); j.t_beg = 0; j.t_cnt = T; ph_ln(j, lds); } PHASE_END
    moe_layer<0>(p, lds, gbar);
    PHASE_BEGIN
#ifndef HOST_EMU
        { GemmArgs g = mk_gemm(WSP(bf16, B_H28), DM / 2, WSP(bf16, O_WT_IN1), T, DM, DM / 2); EpiBf e{WSP(bf16, C_U), DM}; e.sc = F8_ACC_INV; ph_gemm<EpiBf, true>(g, e, lds); }
#else
        { GemmArgs g = mk_gemm(WSP(bf16, O_H2), DM, WSP(bf16, O_WT_IN1), T, DM, DM); EpiBf e{WSP(bf16, C_U), DM}; ph_gemm(g, e, lds); }
#endif
#ifdef HOST_EMU
        xpose_experts<1>(p, lds);
#endif
    PHASE_END
#ifdef HOST_EMU
    PHASE_BEGIN ph_s5(p, lds); PHASE_END
#else
    PHASE_BEGIN ph_s5b(p, lds, WSP(bf16, C_YS)); ph_xpose_side<1>(p, lds); PHASE_END
#endif
#ifndef HOST_EMU
    PHASE_BEGIN { GemmArgs g = mk_gemm(WSP(bf16, C_YS), DM / 2, WSP(bf16, O_WT_GLU), T, DM, DM / 2); EpiGlu8 e{WSP(unsigned char, C_Y2), WSP(unsigned char, C_YS), DM}; ph_gemm<EpiGlu8, true>(g, e, lds); } PHASE_END
    PHASE_BEGIN { GemmArgs g = mk_gemm(WSP(bf16, C_Y2), DM / 2, WSP(bf16, O_WT_OUT1), T, DM, DM / 2); EpiResBfT<true> e{p.out, PREB, WSP(bf16, O_H2), DM}; e.sc = F8_ACC_INV; ph_gemm<EpiResBfT<true>, true>(g, e, lds); } PHASE_END
#else
    PHASE_BEGIN { GemmArgs g = mk_gemm(WSP(bf16, C_YS), DM, WSP(bf16, O_WT_GLU), T, DM, DM); EpiGlu e{WSP(bf16, C_Y2), WSP(bf16, C_YS), DM}; ph_gemm(g, e, lds); } PHASE_END
    PHASE_BEGIN { GemmArgs g = mk_gemm(WSP(bf16, C_Y2), DM, WSP(bf16, O_WT_OUT1), T, DM, DM); EpiResBfT<true> e{p.out, PREB, WSP(bf16, O_H2), DM}; ph_gemm(g, e, lds); } PHASE_END
#endif
    PHASE_BEGIN { LnJob j; j.grid = p.grid; j.pad = 0; j.pre = p.out; j.preb = PREB; j.y = nullptr; j.pos = nullptr; j.gate = nullptr; j.g = p.in[I_L1_LN1G]; j.b = p.in[I_L1_LN1B]; j.obf = WSP(bf16, O_H); j.of32 = nullptr; j.of8 = WSP(unsigned char, B_H8); j.t_beg = 0; j.t_cnt = T; ph_ln(j, lds); } PHASE_END
    moe_layer<1>(p, lds, gbar);
}

#ifndef HOST_EMU
__global__ void __launch_bounds__(512, 2) mega(const P p) {
    LDS_DECL;
    if (threadIdx.x == 0) *(uint4*)lds = make_uint4(0u, 0u, 0u, 0u);
    __syncthreads();
    const XcdBarrier gbar = xcd_barrier_post((unsigned*)(p.ws + O_CTL), (volatile LAS unsigned*)lds, (unsigned)p.grid);
    program(p, lds + 256, gbar);
}
#else
static int hipMemsetAsync(void* p, int v, size_t n, hipStream_t) { memset(p, v, n); return 0; }
#endif

extern "C" void kernel_launch(void* const* d_in, const int* in_sizes, int n_in, void* d_out, int out_size, void* d_ws, size_t ws_size, hipStream_t stream) {
    (void)in_sizes; (void)out_size;
    if (n_in < 44 || ws_size < WS_NEED) return;
    P p; memset(&p, 0, sizeof(p));
    for (int i = 0; i < 44; ++i) p.in[i] = (const float*)d_in[i];
    p.out = (float*)d_out; p.ws = (unsigned char*)d_ws;
    (void)hipMemsetAsync(p.ws + O_CTL, 0, CTL_BYTES, stream);
#ifndef HOST_EMU
    static int grid = 0;
    if (!grid) {
        int dev = 0, cus = 0, per_cu = 0;
        (void)hipGetDevice(&dev);
        (void)hipDeviceGetAttribute(&cus, hipDeviceAttributeMultiprocessorCount, dev);
        (void)hipFuncSetAttribute((const void*)mega, hipFuncAttributeMaxDynamicSharedMemorySize, MEGA_LDS);
        (void)hipOccupancyMaxActiveBlocksPerMultiprocessor(&per_cu, mega, 512, MEGA_LDS);
        grid = cus * (per_cu < 1 ? per_cu : 1);
    }
    p.grid = grid;
    if (grid > 0) mega<<<grid, 512, MEGA_LDS, stream>>>(p);
#else
    e_gridDim.x = EMU_GRID; e_blockDim.x = 512; p.grid = EMU_GRID;
    program(p, g_emu_lds, 0);
#endif
}
```
